# Optimizing an MI355X kernel written in HIP

```python
import math
import jax, jax.numpy as jnp
from jax import lax
import numpy as np


D_MODEL = 1024
BATCH = 4
SEQ = 8192
DEPTH = 2

A_HEADS = 4
A_HEAD_DIM = 64
A_V_DIM = 2 * A_HEAD_DIM
A_WIDTH = A_HEADS * A_V_DIM
A_COLS = 3 * A_WIDTH
R_HEAD = 64
R_WIDTH = D_MODEL - A_WIDTH
R_HEADS = R_WIDTH // R_HEAD
N_DIR = 2
DECAY_LORA = 64
ICL_LORA = 64
GATE_LORA = 128
R_COLS = 3 * R_WIDTH + N_DIR * (DECAY_LORA + ICL_LORA) + GATE_LORA
R_SPLITS = (R_WIDTH, 2 * R_WIDTH, 3 * R_WIDTH,
            3 * R_WIDTH + N_DIR * DECAY_LORA,
            3 * R_WIDTH + N_DIR * (DECAY_LORA + ICL_LORA))
IN_COLS = A_COLS + R_COLS
D_FF = 4 * D_MODEL
ROPE_THETA = 10000.0
Q_BLOCK = 128
NORM_EPS = 1e-6
SUBLN_EPS = 1e-5
GN_EPS = 64e-5
N_MOD = 6

kernel_name = 'hybrid_diffattn_rwkv7_adaln_encoder'


def rmsnorm(x, g, eps=NORM_EPS):
    x32 = x.astype(jnp.float32)
    y = x32 * lax.rsqrt(jnp.mean(x32 * x32, axis=-1, keepdims=True) + eps)
    return (y * g.astype(jnp.float32)).astype(x.dtype)


def rope_tables(seq, dim):
    inv = 1.0 / (ROPE_THETA ** (jnp.arange(0, dim, 2, dtype=jnp.float32) / dim))
    ang = jnp.arange(seq, dtype=jnp.float32)[:, None] * inv[None, :]
    return jnp.cos(ang), jnp.sin(ang)


def apply_rope(t, cos, sin):
    t32 = t.astype(jnp.float32)
    half = t.shape[-1] // 2
    t1, t2 = t32[..., :half], t32[..., half:]
    c = cos[None, :, None, None, :]
    s = sin[None, :, None, None, :]
    return jnp.concatenate([t1 * c - t2 * s, t1 * s + t2 * c], axis=-1).astype(t.dtype)


def diff_attention(zq, zk, zv, lam_q1, lam_k1, lam_q2, lam_k2, subln_w, lam_init):
    f32 = jnp.float32
    B, S, _ = zq.shape
    q = zq.reshape(B, S, A_HEADS, 2, A_HEAD_DIM)
    k = zk.reshape(B, S, A_HEADS, 2, A_HEAD_DIM)
    v = zv.reshape(B, S, A_HEADS, A_V_DIM)
    cos, sin = rope_tables(S, A_HEAD_DIM)
    q = apply_rope(q, cos, sin)
    k = apply_rope(k, cos, sin)
    lam = (jnp.exp(jnp.sum(lam_q1.astype(f32) * lam_k1.astype(f32)))
           - jnp.exp(jnp.sum(lam_q2.astype(f32) * lam_k2.astype(f32))) + lam_init)
    n_blocks = S // Q_BLOCK
    qb = q.reshape(B, n_blocks, Q_BLOCK, A_HEADS, 2, A_HEAD_DIM).swapaxes(0, 1)
    scale = A_HEAD_DIM ** -0.5

    def block(q_blk):
        s = jnp.einsum('bqhcd,bkhcd->bhcqk', q_blk, k).astype(f32) * scale
        p = jax.nn.softmax(s, axis=-1)
        w = p[:, :, 0] - lam * p[:, :, 1]
        return jnp.einsum('bhqk,bkhe->bqhe', w.astype(v.dtype), v)

    o = lax.map(block, qb)
    o = o.swapaxes(0, 1).reshape(B, S, A_HEADS, A_V_DIM).astype(f32)
    o = o * lax.rsqrt(jnp.mean(o * o, axis=-1, keepdims=True) + SUBLN_EPS)
    o = o * subln_w.astype(f32) * (1.0 - lam_init)
    return o.reshape(B, S, A_WIDTH).astype(zq.dtype)


def centred_shift_mix(z, mu):
    zp = jnp.pad(z, ((0, 0), (1, 1), (0, 0)))
    nb = 0.5 * (zp[:, :-2] + zp[:, 2:])
    return z + mu.astype(z.dtype) * (nb - z)


def rwkv7_step(state, inp):
    r_t, w_t, k_t, v_t, kk_t, a_t = inp
    sa = jnp.einsum('dbhvk,dbhk->dbhv', state, kk_t)
    state = (state * w_t[..., None, :]
             - sa[..., :, None] * (kk_t * a_t)[..., None, :]
             + v_t[..., :, None] * k_t[..., None, :])
    y = jnp.einsum('dbhvk,dbhk->dbhv', state, r_t)
    return state, y


def rwkv7_bidirectional(z, mu, w0, w2, a0, a2, g2, k_k, k_a, r_k, lnx_w, lnx_b):
    f32 = jnp.float32
    B, S, _ = z.shape
    z = centred_shift_mix(z, mu)
    r, k, v, zd, za, zg = jnp.split(z.astype(f32), R_SPLITS, axis=-1)
    zd = zd.reshape(B, S, N_DIR, DECAY_LORA)
    za = za.reshape(B, S, N_DIR, ICL_LORA)
    wl = w0.astype(f32) + jnp.einsum('bsdr,drc->bsdc', jnp.tanh(zd), w2.astype(f32))
    wl = -jax.nn.softplus(-wl) - 0.5
    decay = jnp.exp(-jnp.exp(wl))
    a = jax.nn.sigmoid(a0.astype(f32) + jnp.einsum('bsdr,drc->bsdc', za, a2.astype(f32)))
    g = jnp.einsum('bsr,rc->bsc', jax.nn.sigmoid(zg), g2.astype(f32))
    heads = lambda t: t.reshape(t.shape[:-1] + (R_HEADS, R_HEAD))
    kk = heads(k * k_k.astype(f32))
    kk = kk / jnp.maximum(jnp.sqrt(jnp.sum(kk * kk, axis=-1, keepdims=True)), 1e-12)
    kd = k[:, :, None, :] * (1.0 + (a - 1.0) * k_a.astype(f32))
    rh, vh = heads(r), heads(v)
    decay_h, a_h, kd_h = heads(decay), heads(a), heads(kd)

    def dir_shared(t):
        return jnp.stack([t, jnp.flip(t, 1)], 0).transpose(2, 0, 1, 3, 4)

    def dir_own(t):
        return jnp.stack([t[:, :, 0], jnp.flip(t[:, :, 1], 1)], 0).transpose(2, 0, 1, 3, 4)

    xs = (dir_shared(rh), dir_own(decay_h), dir_own(kd_h),
          dir_shared(vh), dir_shared(kk), dir_own(a_h))
    state0 = jnp.zeros((N_DIR, B, R_HEADS, R_HEAD, R_HEAD), f32)
    _, ys = lax.scan(rwkv7_step, state0, xs)
    y = (ys[:, 0] + jnp.flip(ys[:, 1], 0)).transpose(1, 0, 2, 3)
    mean = jnp.mean(y, axis=-1, keepdims=True)
    var = jnp.mean(jnp.square(y - mean), axis=-1, keepdims=True)
    y = ((y - mean) * lax.rsqrt(var + GN_EPS)).reshape(B, S, R_WIDTH)
    y = y * lnx_w.astype(f32) + lnx_b.astype(f32)
    bonus = jnp.sum(rh[:, :, None] * kd_h * r_k.astype(f32), axis=-1, keepdims=True) * vh[:, :, None]
    y = y + jnp.sum(bonus, axis=2).reshape(B, S, R_WIDTH)
    return (y * g).astype(z.dtype)


def setup_inputs(seed: int = 0) -> dict:
    key = jax.random.key(seed)
    ks = iter(jax.random.split(key, 32))
    L, D, f32 = DEPTH, D_MODEL, jnp.float32

    def nrm(shape, scale):
        return jax.random.normal(next(ks), shape, f32) * scale

    x = nrm((BATCH, SEQ, D), 1.0)
    c = nrm((BATCH, D), 1.0)
    w_ada = nrm((L, D, N_MOD * D), 0.5 * D ** -0.5)
    b_ada = nrm((L, N_MOD * D), 0.02)
    norm1 = 1.0 + nrm((L, D), 0.02)
    norm2 = 1.0 + nrm((L, D), 0.02)
    w_in = nrm((L, D, IN_COLS), D ** -0.5)
    w_out = nrm((L, D, D), D ** -0.5)
    lam_q1 = nrm((L, A_HEAD_DIM), 0.1)
    lam_k1 = nrm((L, A_HEAD_DIM), 0.1)
    lam_q2 = nrm((L, A_HEAD_DIM), 0.1)
    lam_k2 = nrm((L, A_HEAD_DIM), 0.1)
    subln_w = 1.0 + nrm((L, A_V_DIM), 0.02)
    tshift_mu = jax.random.uniform(next(ks), (L, R_COLS), f32)
    ramp = (jnp.arange(R_WIDTH, dtype=f32) / (R_WIDTH - 1)) ** 0.9
    decay_w0 = (-6.0 + 5.0 * ramp + 0.5)[None, None, :] + nrm((L, N_DIR, R_WIDTH), 0.3)
    decay_w2 = nrm((L, N_DIR, DECAY_LORA, R_WIDTH), 0.5 * DECAY_LORA ** -0.5)
    icl_a0 = nrm((L, N_DIR, R_WIDTH), 0.3)
    icl_a2 = nrm((L, N_DIR, ICL_LORA, R_WIDTH), ICL_LORA ** -0.5)
    gate_g2 = nrm((L, GATE_LORA, R_WIDTH), GATE_LORA ** -0.5)
    k_k = 0.85 + nrm((L, R_WIDTH), 0.05)
    k_a = 1.0 + nrm((L, R_WIDTH), 0.05)
    r_k = nrm((L, R_HEADS, R_HEAD), 0.1)
    lnx_w = 1.0 + nrm((L, R_WIDTH), 0.02)
    lnx_b = nrm((L, R_WIDTH), 0.02)
    w_up = nrm((L, D, D_FF), D ** -0.5)
    w_down = nrm((L, D_FF, D), D_FF ** -0.5)
    norm_f = 1.0 + nrm((D,), 0.02)
    return {'x': x, 'c': c, 'w_ada': w_ada, 'b_ada': b_ada, 'norm1': norm1, 'norm2': norm2,
            'w_in': w_in, 'w_out': w_out, 'lam_q1': lam_q1, 'lam_k1': lam_k1,
            'lam_q2': lam_q2, 'lam_k2': lam_k2, 'subln_w': subln_w, 'tshift_mu': tshift_mu,
            'decay_w0': decay_w0, 'decay_w2': decay_w2, 'icl_a0': icl_a0, 'icl_a2': icl_a2,
            'gate_g2': gate_g2, 'k_k': k_k, 'k_a': k_a, 'r_k': r_k, 'lnx_w': lnx_w,
            'lnx_b': lnx_b, 'w_up': w_up, 'w_down': w_down, 'norm_f': norm_f}


def reference(x, c, w_ada, b_ada, norm1, norm2, w_in, w_out, lam_q1, lam_k1, lam_q2, lam_k2,
              subln_w, tshift_mu, decay_w0, decay_w2, icl_a0, icl_a2, gate_g2, k_k, k_a, r_k,
              lnx_w, lnx_b, w_up, w_down, norm_f):
    for l in range(DEPTH):
        lam_init = 0.8 - 0.6 * math.exp(-0.3 * l)
        mod = jax.nn.silu(c) @ w_ada[l] + b_ada[l]
        sh1, sc1, gt1, sh2, sc2, gt2 = [m[:, None, :] for m in jnp.split(mod, N_MOD, axis=-1)]
        h = rmsnorm(x, norm1[l]) * (1.0 + sc1) + sh1
        proj = jnp.einsum('bsd,dc->bsc', h, w_in[l])
        zq = proj[..., :A_WIDTH]
        zk = proj[..., A_WIDTH:2 * A_WIDTH]
        zv = proj[..., 2 * A_WIDTH:A_COLS]
        zr = proj[..., A_COLS:]
        att = diff_attention(zq, zk, zv, lam_q1[l], lam_k1[l], lam_q2[l], lam_k2[l],
                             subln_w[l], lam_init)
        rec = rwkv7_bidirectional(zr, tshift_mu[l], decay_w0[l], decay_w2[l], icl_a0[l],
                                  icl_a2[l], gate_g2[l], k_k[l], k_a[l], r_k[l],
                                  lnx_w[l], lnx_b[l])
        mix = jnp.einsum('bsd,de->bse', jnp.concatenate([att, rec], axis=-1), w_out[l])
        x = x + gt1 * mix
        h = rmsnorm(x, norm2[l]) * (1.0 + sc2) + sh2
        u = jnp.square(jax.nn.relu(jnp.einsum('bsd,df->bsf', h, w_up[l])))
        x = x + gt2 * jnp.einsum('bsf,fd->bsd', u, w_down[l])
    return rmsnorm(x, norm_f)
```

```cpp
#include <hip/hip_runtime.h>
#include <hip/hip_bf16.h>
#include <hip/hip_cooperative_groups.h>
#include <cstdio>
#include <cmath>
namespace cg = cooperative_groups;

#define DEVI __device__ __forceinline__
using bf16 = __hip_bfloat16;
typedef short bf16x8 __attribute__((ext_vector_type(8)));
typedef short s16x4 __attribute__((ext_vector_type(4)));
typedef float f32x16 __attribute__((ext_vector_type(16)));
typedef float f32x4 __attribute__((ext_vector_type(4)));
typedef unsigned u32x4 __attribute__((ext_vector_type(4)));
typedef unsigned u32x2 __attribute__((ext_vector_type(2)));

constexpr int NTOK = 32768, SEQ = 8192, DM = 1024, LDP = 3456, DFF = 4096;
constexpr int NTHR = 512;
constexpr size_t MiB = 1024 * 1024;
constexpr size_t OFF_WT_IN = 0;
constexpr size_t OFF_WT_OUT = OFF_WT_IN + (size_t)3456 * 1024 * 2;
constexpr size_t OFF_WT_UP = OFF_WT_OUT + (size_t)1024 * 1024 * 2;
constexpr size_t OFF_WT_DOWN = OFF_WT_UP + (size_t)4096 * 1024 * 2;
constexpr size_t OFF_W2T = OFF_WT_DOWN + (size_t)4096 * 1024 * 2;
constexpr size_t OFF_A2T = OFF_W2T + (size_t)2 * 512 * 64 * 2;
constexpr size_t OFF_G2T = OFF_A2T + (size_t)2 * 512 * 64 * 2;
constexpr size_t OFF_U = 26 * MiB;
constexpr size_t OFF_ZL = OFF_U + 216 * MiB;
constexpr size_t OFF_H = OFF_U + 256 * MiB;
constexpr size_t OFF_OMW = OFF_H + 64 * MiB;
constexpr size_t OFF_A = OFF_OMW + 64 * MiB;
constexpr size_t OFF_G = OFF_A + 64 * MiB;
constexpr size_t OFF_MOD = OFF_G + 32 * MiB;
constexpr size_t OFF_COS = OFF_MOD + 1 * MiB;
constexpr size_t OFF_SIN = OFF_COS + 1 * MiB;
constexpr size_t OFF_BAR = OFF_SIN + 1 * MiB;
constexpr size_t WS_NEED = OFF_BAR + 1 * MiB;
constexpr int LDS_BYTES = 98304;

struct Params {
  const float *x, *c, *w_ada, *b_ada, *norm1, *norm2, *w_in, *w_out, *lam_q1, *lam_k1, *lam_q2, *lam_k2, *subln_w, *tshift_mu,
      *decay_w0, *decay_w2, *icl_a0, *icl_a2, *gate_g2, *k_k, *k_a, *r_k, *lnx_w, *lnx_b, *w_up, *w_down, *norm_f;
  float* out;
  char* ws;
  float inv_freq[32];
};

DEVI void grid_barrier(unsigned* bar, unsigned& target) {
  asm volatile("s_waitcnt vmcnt(0) lgkmcnt(0)" ::: "memory");
  __syncthreads();
  target += gridDim.x;
  if (threadIdx.x == 0) {
    __builtin_amdgcn_fence(__ATOMIC_RELEASE, "agent");
    asm volatile("s_waitcnt vmcnt(0)" ::: "memory");
    __hip_atomic_fetch_add(bar, 1u, __ATOMIC_RELAXED, __HIP_MEMORY_SCOPE_AGENT);
    while (__hip_atomic_load(bar, __ATOMIC_RELAXED, __HIP_MEMORY_SCOPE_AGENT) < target) __builtin_amdgcn_s_sleep(2);
    __builtin_amdgcn_fence(__ATOMIC_ACQUIRE, "agent");
    asm volatile("s_waitcnt vmcnt(0)" ::: "memory");
  }
  __syncthreads();
}
#define GSYNC() grid_barrier(gbar, gtarget)
DEVI int tid_opaque() { int t = threadIdx.x; asm volatile("" : "+v"(t)); return t; }
DEVI int crow(int r, int hi) { return (r & 3) + 8 * (r >> 2) + 4 * hi; }
DEVI unsigned cvtpk(float lo, float hi) {
  unsigned r; asm volatile("v_cvt_pk_bf16_f32 %0, %1, %2" : "=v"(r) : "v"(lo), "v"(hi)); return r;
}
DEVI unsigned short f2bf(float x) { return (unsigned short)(cvtpk(x, 0.f) & 0xffffu); }
DEVI float bf2f(unsigned short u) { return __uint_as_float(((unsigned)u) << 16); }
DEVI float bflo(unsigned u) { return __uint_as_float(u << 16); }
DEVI float bfhi(unsigned u) { return __uint_as_float(u & 0xffff0000u); }
template <int CTRL> DEVI float dppf(float x) {
  return __builtin_bit_cast(float, __builtin_amdgcn_mov_dpp(__builtin_bit_cast(int, x), CTRL, 0xf, 0xf, true));
}
DEVI float red8(float x) { x += dppf<0xB1>(x); x += dppf<0x4E>(x); x += dppf<0x141>(x); return x; }
DEVI float red16(float x) { x = red8(x); x += dppf<0x128>(x); return x; }
DEVI float red64(float x) { x = red16(x); x += __shfl_xor(x, 16); x += __shfl_xor(x, 32); return x; }
DEVI float sigmoidf_(float x) { return 1.f / (1.f + __expf(-x)); }
DEVI void unpack8(u32x4 v, float* f) {
  f[0] = bflo(v[0]); f[1] = bfhi(v[0]); f[2] = bflo(v[1]); f[3] = bfhi(v[1]);
  f[4] = bflo(v[2]); f[5] = bfhi(v[2]); f[6] = bflo(v[3]); f[7] = bfhi(v[3]);
}
DEVI u32x4 pack8(const float* f) {
  u32x4 w = {cvtpk(f[0], f[1]), cvtpk(f[2], f[3]), cvtpk(f[4], f[5]), cvtpk(f[6], f[7])}; return w;
}

DEVI void phase_mod(const Params& p, char* lds) {
  float* sc = (float*)lds;
  float* red = sc + 4096;
  const int tid = tid_opaque(), w = tid >> 6, lane = tid & 63;
  for (int i = tid; i < 4096; i += NTHR) { float v = p.c[i]; sc[i] = v / (1.f + expf(-v)); }
  __syncthreads();
  float* mod = (float*)(p.ws + OFF_MOD);
  for (int it = blockIdx.x; it < 192; it += gridDim.x) {
    const int l = it / 96, col = (it % 96) * 64 + lane;
    const float* W = p.w_ada + (size_t)l * 1024 * 6144 + col;
    float a0 = 0, a1 = 0, a2 = 0, a3 = 0;
    for (int k = w * 128; k < w * 128 + 128; ++k) {
      float wv = W[(size_t)k * 6144];
      a0 += sc[k] * wv; a1 += sc[1024 + k] * wv; a2 += sc[2048 + k] * wv; a3 += sc[3072 + k] * wv;
    }
    red[(w * 4 + 0) * 64 + lane] = a0; red[(w * 4 + 1) * 64 + lane] = a1;
    red[(w * 4 + 2) * 64 + lane] = a2; red[(w * 4 + 3) * 64 + lane] = a3;
    __syncthreads();
    if (tid < 256) {
      const int bb = tid >> 6; float s = 0;
      for (int ww = 0; ww < 8; ++ww) s += red[(ww * 4 + bb) * 64 + lane];
      mod[(l * 4 + bb) * 6144 + col] = s + p.b_ada[l * 6144 + col];
    }
    __syncthreads();
  }
}

DEVI void phase_rope(const Params& p) {
  float* cosT = (float*)(p.ws + OFF_COS); float* sinT = (float*)(p.ws + OFF_SIN);
  for (int idx = blockIdx.x * NTHR + tid_opaque(); idx < SEQ * 32; idx += gridDim.x * NTHR) {
    const int pos = idx >> 5, i = idx & 31;
    const float ang = (float)pos * p.inv_freq[i];
    double q = (double)ang * 0.15915494309189533577; q -= floor(q);
    const float f = (float)q;
    cosT[idx] = __builtin_amdgcn_cosf(f); sinT[idx] = __builtin_amdgcn_sinf(f);
  }
}

DEVI void conv_tile(const float* __restrict__ src, int ldsrc, bf16* __restrict__ dst, int lddst, int k0, int n0, float* tile) {
  const int tid = tid_opaque();
#pragma unroll
  for (int ps = 0; ps < 2; ++ps) {
    const int k = ps * 32 + (tid >> 4), n = (tid & 15) * 4;
    const f32x4 v = *(const f32x4*)&src[(size_t)(k0 + k) * ldsrc + n0 + n];
    tile[k * 65 + n + 0] = v[0]; tile[k * 65 + n + 1] = v[1]; tile[k * 65 + n + 2] = v[2]; tile[k * 65 + n + 3] = v[3];
  }
  __syncthreads();
  {
    const int n = tid >> 3, kc = (tid & 7) * 8; float f[8];
#pragma unroll
    for (int j = 0; j < 8; ++j) f[j] = tile[(kc + j) * 65 + n];
    *(u32x4*)&dst[(size_t)(n0 + n) * lddst + k0 + kc] = pack8(f);
  }
  __syncthreads();
}
DEVI void phase_conv(const Params& p, int l, char* lds) {
  float* tile = (float*)lds;
  for (int it = blockIdx.x; it < 3216; it += gridDim.x) {
    const float* src; bf16* dst; int K, N, t = it;
    char* wsb = p.ws; asm volatile("" : "+v"(wsb));
    if (t < 864) { src = p.w_in + (size_t)l * 1024 * 3456; dst = (bf16*)(wsb + OFF_WT_IN); K = 1024; N = 3456; }
    else if ((t -= 864) < 256) { src = p.w_out + (size_t)l * 1024 * 1024; dst = (bf16*)(wsb + OFF_WT_OUT); K = 1024; N = 1024; }
    else if ((t -= 256) < 1024) { src = p.w_up + (size_t)l * 1024 * 4096; dst = (bf16*)(wsb + OFF_WT_UP); K = 1024; N = 4096; }
    else if ((t -= 1024) < 1024) { src = p.w_down + (size_t)l * 4096 * 1024; dst = (bf16*)(wsb + OFF_WT_DOWN); K = 4096; N = 1024; }
    else if ((t -= 1024) < 16) { const int d = t >> 3; t &= 7; src = p.decay_w2 + (size_t)(l * 2 + d) * 64 * 512; dst = (bf16*)(wsb + OFF_W2T) + d * 512 * 64; K = 64; N = 512; }
    else if ((t -= 16) < 16) { const int d = t >> 3; t &= 7; src = p.icl_a2 + (size_t)(l * 2 + d) * 64 * 512; dst = (bf16*)(wsb + OFF_A2T) + d * 512 * 64; K = 64; N = 512; }
    else { t -= 16; src = p.gate_g2 + (size_t)l * 128 * 512; dst = (bf16*)(wsb + OFF_G2T); K = 128; N = 512; }
    const int nt = N / 64; const int kt = t / nt, ntile = t % nt;
    conv_tile(src, N, dst, K, kt * 64, ntile * 64, tile);
  }
}

DEVI void phase_norm(const float* __restrict__ xin, const float* __restrict__ g, const float* __restrict__ modl, int shoff, int scoff,
                     bf16* __restrict__ H) {
  const int tid = tid_opaque(), w = tid >> 6, lane = tid & 63;
  for (int row = blockIdx.x * 8 + w; row < NTOK; row += gridDim.x * 8) {
    const int b = row >> 13; f32x4 v[4]; float ss = 0;
#pragma unroll
    for (int j = 0; j < 4; ++j) { v[j] = *(const f32x4*)&xin[(size_t)row * DM + j * 256 + lane * 4]; ss += v[j][0] * v[j][0] + v[j][1] * v[j][1] + v[j][2] * v[j][2] + v[j][3] * v[j][3]; }
    ss = red64(ss);
    const float rstd = rsqrtf(ss * (1.f / 1024.f) + 1e-6f);
#pragma unroll
    for (int j = 0; j < 4; ++j) {
      const int col = j * 256 + lane * 4;
      const f32x4 g4 = *(const f32x4*)&g[col];
      const f32x4 sc4 = *(const f32x4*)&modl[b * 6144 + scoff + col];
      const f32x4 sh4 = *(const f32x4*)&modl[b * 6144 + shoff + col];
      float o[4];
#pragma unroll
      for (int e = 0; e < 4; ++e) o[e] = v[j][e] * rstd * g4[e] * (1.f + sc4[e]) + sh4[e];
      u32x2 pk = {cvtpk(o[0], o[1]), cvtpk(o[2], o[3])};
      *(u32x2*)&H[(size_t)row * DM + col] = pk;
    }
  }
}
DEVI void phase_final_norm(float* __restrict__ x, const float* __restrict__ g) {
  const int tid = tid_opaque(), w = tid >> 6, lane = tid & 63;
  for (int row = blockIdx.x * 8 + w; row < NTOK; row += gridDim.x * 8) {
    f32x4 v[4]; float ss = 0;
#pragma unroll
    for (int j = 0; j < 4; ++j) { v[j] = *(const f32x4*)&x[(size_t)row * DM + j * 256 + lane * 4]; ss += v[j][0] * v[j][0] + v[j][1] * v[j][1] + v[j][2] * v[j][2] + v[j][3] * v[j][3]; }
    ss = red64(ss);
    const float rstd = rsqrtf(ss * (1.f / 1024.f) + 1e-6f);
#pragma unroll
    for (int j = 0; j < 4; ++j) {
      const int col = j * 256 + lane * 4;
      const f32x4 g4 = *(const f32x4*)&g[col];
      f32x4 o = {v[j][0] * rstd * g4[0], v[j][1] * rstd * g4[1], v[j][2] * rstd * g4[2], v[j][3] * rstd * g4[3]};
#ifdef SANITIZE
      for (int e = 0; e < 4; ++e) if (!(fabsf(o[e]) < 1e30f)) o[e] = 0.f;
#endif
      *(f32x4*)&x[(size_t)row * DM + col] = o;
    }
  }
}

template <class Epi>
DEVI void gemm_tile(const bf16* __restrict__ A, int lda, const bf16* __restrict__ Bt, int ldb, int K, int m0, int n0, char* lds, Epi&& epi) {
  const int tid = tid_opaque(), wid = tid >> 6, lane = tid & 63, r32 = lane & 31, hi = lane >> 5;
  const int wm = wid >> 1, wn = wid & 1;
  char* As = lds; char* Bs = lds + 65536;
  f32x16 acc00 = {}, acc01 = {}, acc10 = {}, acc11 = {};
  const int lrow = tid >> 3, lch = tid & 7;
  const bf16* Ag = A + (size_t)(m0 + lrow) * lda + lch * 8;
  const bf16* Bg = Bt + (size_t)(n0 + lrow) * ldb + lch * 8;
  const int wsw = lrow * 128 + ((lch ^ ((lrow >> 1) & 7)) * 16);
  bf16x8 ra0, ra1, ra2, ra3, rb0, rb1;
#define GLOAD(k0) do { ra0 = *(const bf16x8*)(Ag + (k0)); ra1 = *(const bf16x8*)(Ag + (size_t)64 * lda + (k0)); \
    ra2 = *(const bf16x8*)(Ag + (size_t)128 * lda + (k0)); ra3 = *(const bf16x8*)(Ag + (size_t)192 * lda + (k0)); \
    rb0 = *(const bf16x8*)(Bg + (k0)); rb1 = *(const bf16x8*)(Bg + (size_t)64 * ldb + (k0)); } while (0)
#define LWRITE(buf) do { char* a_ = As + (buf) * 32768 + wsw; char* b_ = Bs + (buf) * 16384 + wsw; \
    *(bf16x8*)(a_) = ra0; *(bf16x8*)(a_ + 64 * 128) = ra1; *(bf16x8*)(a_ + 128 * 128) = ra2; *(bf16x8*)(a_ + 192 * 128) = ra3; \
    *(bf16x8*)(b_) = rb0; *(bf16x8*)(b_ + 64 * 128) = rb1; } while (0)
  const int KT = K >> 6;
  const int arow0 = wm * 64 + r32, arow1 = arow0 + 32, brow0 = wn * 64 + r32, brow1 = brow0 + 32;
  const int asw0 = (arow0 >> 1) & 7, asw1 = (arow1 >> 1) & 7, bsw0 = (brow0 >> 1) & 7, bsw1 = (brow1 >> 1) & 7;
  GLOAD(0); LWRITE(0); __syncthreads();
#pragma unroll 2
  for (int kt = 0; kt < KT; ++kt) {
    if (kt + 1 < KT) GLOAD((kt + 1) * 64);
    const char* Ab = As + (kt & 1) * 32768; const char* Bb = Bs + (kt & 1) * 16384;
#pragma unroll
    for (int kk = 0; kk < 4; ++kk) {
      const int ch = kk * 2 + hi;
      const bf16x8 a0 = *(const bf16x8*)(Ab + arow0 * 128 + ((ch ^ asw0) * 16));
      const bf16x8 a1 = *(const bf16x8*)(Ab + arow1 * 128 + ((ch ^ asw1) * 16));
      const bf16x8 b0 = *(const bf16x8*)(Bb + brow0 * 128 + ((ch ^ bsw0) * 16));
      const bf16x8 b1 = *(const bf16x8*)(Bb + brow1 * 128 + ((ch ^ bsw1) * 16));
      acc00 = __builtin_amdgcn_mfma_f32_32x32x16_bf16(a0, b0, acc00, 0, 0, 0);
      acc01 = __builtin_amdgcn_mfma_f32_32x32x16_bf16(a0, b1, acc01, 0, 0, 0);
      acc10 = __builtin_amdgcn_mfma_f32_32x32x16_bf16(a1, b0, acc10, 0, 0, 0);
      acc11 = __builtin_amdgcn_mfma_f32_32x32x16_bf16(a1, b1, acc11, 0, 0, 0);
    }
    if (kt + 1 < KT) LWRITE((kt + 1) & 1);
    __syncthreads();
  }
#undef GLOAD
#undef LWRITE
  const int mw = m0 + wm * 64, nw = n0 + wn * 64;
  epi(acc00, acc01, mw, nw, r32, hi);
  epi(acc10, acc11, mw + 32, nw, r32, hi);
}

constexpr float ATT_SCALE = 0.125f;
constexpr float ATT_THR = 8.f;
constexpr int SHM_V = 64 * 128 * 2, SHM_K = 64 * 128 * 2;
#define KSWZ(row, colB) ((row) * 256 + ((colB) ^ (((row) & 7) << 4)))
#define SBAR() __builtin_amdgcn_sched_barrier(0)
DEVI void partialSM(f32x16& p0, f32x16& p1, float& m_reg, float& mn, float& alpha) {
  constexpr float C = ATT_SCALE * 1.4426950408889634f;
  float pmax = p0[0];
#pragma unroll
  for (int r = 1; r < 16; ++r) pmax = fmaxf(pmax, p0[r]);
#pragma unroll
  for (int r = 0; r < 16; ++r) pmax = fmaxf(pmax, p1[r]);
  { auto rr = __builtin_amdgcn_permlane32_swap(__float_as_uint(pmax), __float_as_uint(pmax), false, false);
    pmax = fmaxf(__uint_as_float(rr[0]), __uint_as_float(rr[1])); }
  if (__builtin_expect(__all(pmax - m_reg <= ATT_THR / ATT_SCALE), 1)) { mn = m_reg; alpha = 1.f; }
  else { mn = fmaxf(m_reg, pmax); alpha = __builtin_amdgcn_exp2f((m_reg - mn) * C); m_reg = mn; }
  const float mnC = -mn * C;
#pragma unroll
  for (int r = 0; r < 16; ++r) p0[r] = __builtin_amdgcn_exp2f(fmaf(p0[r], C, mnC));
#pragma unroll
  for (int r = 0; r < 16; ++r) p1[r] = __builtin_amdgcn_exp2f(fmaf(p1[r], C, mnC));
}
DEVI void finishSM(f32x16& p0, f32x16& p1, float alpha, float& l_reg, bf16x8& pa0, bf16x8& pa1, bf16x8& pa2, bf16x8& pa3) {
  float ps = 0;
#pragma unroll
  for (int r = 0; r < 16; ++r) ps += p0[r];
#pragma unroll
  for (int r = 0; r < 16; ++r) ps += p1[r];
  { auto rr = __builtin_amdgcn_permlane32_swap(__float_as_uint(ps), __float_as_uint(ps), false, false);
    ps = __uint_as_float(rr[0]) + __uint_as_float(rr[1]); }
  l_reg = l_reg * alpha + ps;
#define PK4(P, BASE, OUT) do { unsigned a0 = cvtpk(P[BASE + 0], P[BASE + 1]), a1 = cvtpk(P[BASE + 2], P[BASE + 3]);   \
    unsigned b0 = cvtpk(P[BASE + 4], P[BASE + 5]), b1 = cvtpk(P[BASE + 6], P[BASE + 7]);                              \
    auto r0 = __builtin_amdgcn_permlane32_swap(a0, b0, false, false); auto r1 = __builtin_amdgcn_permlane32_swap(a1, b1, false, false); \
    u32x4 w = {r0[0], r1[0], r0[1], r1[1]}; OUT = *reinterpret_cast<bf16x8*>(&w); } while (0)
  PK4(p0, 0, pa0); PK4(p0, 8, pa1); PK4(p1, 0, pa2); PK4(p1, 8, pa3);
#undef PK4
}
DEVI int v_st(int k, int c) { const int kk = (k & ~0xC) | ((k & 4) << 1) | ((k & 8) >> 1); return ((kk >> 3) * 4 + (c >> 5)) * 512 + ((kk & 7) * 32 + (c & 31)) * 2; }
DEVI int v_rd_base(int lane) { return ((lane & 3) << 3) | (((lane >> 2) & 3) << 6) | (((lane >> 4) & 1) << 5) | (((lane >> 5) & 1) << 8); }
constexpr int v_rd_off(int d0, int ks, int half) { return d0 * 512 + ks * 4096 + half * 2048; }
template <int OFF> DEVI s16x4 tr_read(int vb) {
  s16x4 r; asm volatile("ds_read_b64_tr_b16 %0, %1 offset:%2" : "=&v"(r) : "v"(vb), "i"(OFF) : "memory"); return r;
}
template <int D0> DEVI void pv_one(f32x16& od, int vb, bf16x8 pa0, bf16x8 pa1, bf16x8 pa2, bf16x8 pa3) {
  const s16x4 l0 = tr_read<v_rd_off(D0, 0, 0)>(vb), h0 = tr_read<v_rd_off(D0, 0, 1)>(vb), l1 = tr_read<v_rd_off(D0, 1, 0)>(vb), h1 = tr_read<v_rd_off(D0, 1, 1)>(vb);
  const s16x4 l2 = tr_read<v_rd_off(D0, 2, 0)>(vb), h2 = tr_read<v_rd_off(D0, 2, 1)>(vb), l3 = tr_read<v_rd_off(D0, 3, 0)>(vb), h3 = tr_read<v_rd_off(D0, 3, 1)>(vb);
  asm volatile("s_waitcnt lgkmcnt(0)" ::: "memory"); SBAR();
#define PK(L, H) (bf16x8){L[0], L[1], L[2], L[3], H[0], H[1], H[2], H[3]}
  od = __builtin_amdgcn_mfma_f32_32x32x16_bf16(pa0, PK(l0, h0), od, 0, 0, 0);
  od = __builtin_amdgcn_mfma_f32_32x32x16_bf16(pa1, PK(l1, h1), od, 0, 0, 0);
  od = __builtin_amdgcn_mfma_f32_32x32x16_bf16(pa2, PK(l2, h2), od, 0, 0, 0);
  od = __builtin_amdgcn_mfma_f32_32x32x16_bf16(pa3, PK(l3, h3), od, 0, 0, 0);
#undef PK
}
DEVI void pv_d0(f32x16* o, int vb, bf16x8 pa0, bf16x8 pa1, bf16x8 pa2, bf16x8 pa3) {
  pv_one<0>(o[0], vb, pa0, pa1, pa2, pa3); pv_one<1>(o[1], vb, pa0, pa1, pa2, pa3); pv_one<2>(o[2], vb, pa0, pa1, pa2, pa3); pv_one<3>(o[3], vb, pa0, pa1, pa2, pa3);
}

DEVI void attn_item(bf16* __restrict__ PJ, int b, int h, int qb, float lam, float one_m_li, const float* __restrict__ subw, char* lds) {
  const int tid = tid_opaque(), wid = tid >> 6, lane = tid & 63, r32 = lane & 31, hi = lane >> 5;
  const int cmp = wid & 1, wq = wid >> 1;
  char* V_lds = lds; char* K_lds = lds + 2 * SHM_V;
  float* wsl = (float*)(lds + 2 * SHM_V + 2 * SHM_K) + wid * 64; float* li_l = wsl; float* al_l = wsl + 32;
  const size_t rowQ = (size_t)b * SEQ + (size_t)qb * 128 + wq * 32;
  const bf16* Kh = PJ + (size_t)b * SEQ * LDP + 512 + h * 128;
  float m1 = -1e30f, l1 = 0; f32x16 o1[4] = {}; bf16x8 qr[4];
  { const bf16* Qw = PJ + (rowQ + r32) * LDP + h * 128 + cmp * 64 + hi * 8;
#pragma unroll
    for (int d0 = 0; d0 < 4; ++d0) qr[d0] = *(const bf16x8*)(Qw + d0 * 16); }
  const int sr = tid >> 4, sc = (tid & 15) * 8, vst0 = v_st(sr, sc), vst1 = v_st(32 + sr, sc);
  const int vb0 = (int)(uintptr_t)V_lds + v_rd_base(lane);
  int kof0[4], kof1[4];
#pragma unroll
  for (int d0 = 0; d0 < 4; ++d0) { const int cb = ((cmp * 4 + d0) * 16 + hi * 8) * 2; kof0[d0] = KSWZ(r32, cb); kof1[d0] = KSWZ(32 + r32, cb); }
  bf16x8 vs0, vs1, ks0, ks1;
  const bf16* kpA = Kh + (size_t)sr * LDP + sc; const bf16* kpB = kpA + (size_t)32 * LDP;
  asm volatile("" : "+v"(kpA), "+v"(kpB));
#define SLOAD() do { vs0 = *(const bf16x8*)(kpA + 512); vs1 = *(const bf16x8*)(kpB + 512); ks0 = *(const bf16x8*)(kpA); ks1 = *(const bf16x8*)(kpB); \
    kpA += (size_t)64 * LDP; kpB += (size_t)64 * LDP; } while (0)
#define SWRITE(bb) do { *(bf16x8*)(V_lds + (bb) * SHM_V + vst0) = vs0; *(bf16x8*)(V_lds + (bb) * SHM_V + vst1) = vs1; const int kc = sc * 2; \
    *(bf16x8*)(K_lds + (bb) * SHM_K + KSWZ(sr, kc)) = ks0; *(bf16x8*)(K_lds + (bb) * SHM_K + KSWZ(32 + sr, kc)) = ks1; } while (0)
#define RESC(a, o) do { if (__any((a) < 1.f)) { if (hi == 0) al_l[r32] = (a); asm volatile("s_waitcnt lgkmcnt(0)" ::: "memory"); \
    _Pragma("unroll") for (int d = 0; d < 4; ++d) _Pragma("unroll") for (int r = 0; r < 16; ++r) o[d][r] *= al_l[crow(r, hi)]; } } while (0)
  constexpr int NT = SEQ / 64;
  SLOAD(); SWRITE(0); __syncthreads();
  for (int j = 0; j < NT; ++j) {
    if (j + 1 < NT) SLOAD();
    const char* Kb = K_lds + (j & 1) * SHM_K; const int vb = vb0 + (j & 1) * SHM_V;
    f32x16 p0 = {}, p1 = {}; float mn, al; bf16x8 pa0, pa1, pa2, pa3;
#pragma unroll
    for (int d0 = 0; d0 < 4; ++d0) {
      const bf16x8 b0 = *reinterpret_cast<const bf16x8*>(Kb + kof0[d0]);
      const bf16x8 b1 = *reinterpret_cast<const bf16x8*>(Kb + kof1[d0]);
      p0 = __builtin_amdgcn_mfma_f32_32x32x16_bf16(b0, qr[d0], p0, 0, 0, 0);
      p1 = __builtin_amdgcn_mfma_f32_32x32x16_bf16(b1, qr[d0], p1, 0, 0, 0);
    }
    partialSM(p0, p1, m1, mn, al);
    RESC(al, o1);
    finishSM(p0, p1, al, l1, pa0, pa1, pa2, pa3); SBAR();
    pv_d0(o1, vb, pa0, pa1, pa2, pa3);
    if (j + 1 < NT) SWRITE((j + 1) & 1);
    __syncthreads();
  }
#undef SLOAD
#undef SWRITE
#undef RESC
  if (hi == 0) li_l[r32] = (cmp ? lam : 1.f) / l1;
  asm volatile("s_waitcnt lgkmcnt(0)" ::: "memory");
#pragma unroll
  for (int r = 0; r < 16; ++r) { const float c1 = li_l[crow(r, hi)];
#pragma unroll
    for (int d = 0; d < 4; ++d) o1[d][r] *= c1; }
  float* X = (float*)lds + wq * 4096 + lane;
  if (cmp == 1) {
#pragma unroll
    for (int d = 0; d < 4; ++d)
#pragma unroll
      for (int r = 0; r < 16; ++r) X[(d * 16 + r) * 64] = o1[d][r];
  }
  __syncthreads();
  if (cmp == 0) {
    float sw[4];
#pragma unroll
    for (int d = 0; d < 4; ++d) sw[d] = subw[d * 32 + r32] * one_m_li;
    bf16* Ow = PJ + (rowQ + 4 * hi) * LDP + h * 128 + r32;
#pragma unroll
    for (int r = 0; r < 16; ++r) {
      float s = 0;
#pragma unroll
      for (int d = 0; d < 4; ++d) { const float v = o1[d][r] - X[(d * 16 + r) * 64]; o1[d][r] = v; s += v * v; }
      s = red16(s); s += __shfl_xor(s, 16);
      const float rs = rsqrtf(s * (1.f / 128.f) + 1e-5f);
      bf16* orp = Ow + (size_t)((r & 3) + 8 * (r >> 2)) * LDP; asm volatile("" : "+v"(orp));
#pragma unroll
      for (int d = 0; d < 4; ++d) *(unsigned short*)&orp[d * 32] = f2bf(o1[d][r] * rs * sw[d]);
    }
  }
  __syncthreads();
}

DEVI void shiftmix8(const bf16* __restrict__ PJ, size_t R, int pos, int col, const float* __restrict__ mu, float* z) {
  float zc[8], zp[8], zn[8];
  unpack8(*(const u32x4*)&PJ[R * LDP + col], zc);
  if (pos > 0) unpack8(*(const u32x4*)&PJ[(R - 1) * LDP + col], zp); else { for (int j = 0; j < 8; ++j) zp[j] = 0.f; }
  if (pos < SEQ - 1) unpack8(*(const u32x4*)&PJ[(R + 1) * LDP + col], zn); else { for (int j = 0; j < 8; ++j) zn[j] = 0.f; }
#pragma unroll
  for (int j = 0; j < 8; ++j) z[j] = zc[j] + mu[j] * (0.5f * (zp[j] + zn[j]) - zc[j]);
}
DEVI void phase_zl(const Params& p, int l) {
  const bf16* PJ = (const bf16*)(p.ws + OFF_U); bf16* ZL = (bf16*)(p.ws + OFF_ZL);
  const float* mu = p.tshift_mu + (size_t)l * 1920 + 1536;
  for (int idx = blockIdx.x * NTHR + tid_opaque(); idx < NTOK * 48; idx += gridDim.x * NTHR) {
    const int R = idx / 48, ch = idx % 48, j0 = ch * 8, pos = R & (SEQ - 1);
    float m8[8], z[8];
#pragma unroll
    for (int j = 0; j < 8; ++j) m8[j] = mu[j0 + j];
    shiftmix8(PJ, R, pos, 3072 + j0, m8, z);
    if (j0 < 128) { for (int j = 0; j < 8; ++j) z[j] = tanhf(z[j]); }
    else if (j0 >= 256) { for (int j = 0; j < 8; ++j) z[j] = sigmoidf_(z[j]); }
    *(u32x4*)&ZL[(size_t)R * 384 + j0] = pack8(z);
  }
}

DEVI void phase_scan(const Params& p, int l, char* lds) {
  const bf16* PJ = (const bf16*)(p.ws + OFF_U);
  const bf16* Aa = (const bf16*)(p.ws + OFF_A);
  const _Float16* OM = (const _Float16*)(p.ws + OFF_OMW);
  float* Y = (float*)(p.ws + OFF_H);
  constexpr int DSTR = 5 * 2048 + 1024;
  const int tid = tid_opaque(), wid = tid >> 6, lane = tid & 63, l16 = lane & 15;
  const int wdir = wid >> 2, rowl = (wid & 3) * 4 + (lane >> 4);
  const int si = (tid >> 4) & 31, sn = (tid & 15) * 4;
  float* cw = (float*)lds + wdir * DSTR;
  for (int it = blockIdx.x; it < 128; it += gridDim.x) {
    const int q = it & 3, h = (it >> 2) & 7, b = it >> 5;
    const int cbase = h * 64 + sn;
    float mur[4], muk[4], muv[4], kk4[4], ka4[4];
#pragma unroll
    for (int j = 0; j < 4; ++j) {
      mur[j] = p.tshift_mu[l * 1920 + cbase + j]; muk[j] = p.tshift_mu[l * 1920 + 512 + cbase + j]; muv[j] = p.tshift_mu[l * 1920 + 1024 + cbase + j];
      kk4[j] = p.k_k[l * 512 + cbase + j]; ka4[j] = p.k_a[l * 512 + cbase + j];
    }
    float S0 = 0.f, S1 = 0.f, S2 = 0.f, S3 = 0.f;
#pragma unroll 1
    for (int chk = 0; chk < SEQ / 32; ++chk) {
#pragma unroll 1
      for (int d = 0; d < 2; ++d) {
        float* sd = (float*)lds + d * DSTR;
        const int s = chk * 32 + si; const int pos = d ? (SEQ - 1 - s) : s; const size_t R = (size_t)b * SEQ + pos;
        float rc[4], kc[4], vc[4];
        {
          const bf16* base = PJ + R * LDP + 1536 + cbase;
          u32x2 c0 = *(const u32x2*)(base), c1 = *(const u32x2*)(base + 512), c2 = *(const u32x2*)(base + 1024);
          u32x2 p0 = {0, 0}, p1 = {0, 0}, p2 = {0, 0}, n0 = {0, 0}, n1 = {0, 0}, n2 = {0, 0};
          if (pos > 0) { p0 = *(const u32x2*)(base - LDP); p1 = *(const u32x2*)(base - LDP + 512); p2 = *(const u32x2*)(base - LDP + 1024); }
          if (pos < SEQ - 1) { n0 = *(const u32x2*)(base + LDP); n1 = *(const u32x2*)(base + LDP + 512); n2 = *(const u32x2*)(base + LDP + 1024); }
#define MIX(dst, c, pp, nn, mu) do { float zc_[4] = {bflo(c[0]), bfhi(c[0]), bflo(c[1]), bfhi(c[1])}; float zp_[4] = {bflo(pp[0]), bfhi(pp[0]), bflo(pp[1]), bfhi(pp[1])}; \
    float zn_[4] = {bflo(nn[0]), bfhi(nn[0]), bflo(nn[1]), bfhi(nn[1])}; _Pragma("unroll") for (int j = 0; j < 4; ++j) dst[j] = zc_[j] + mu[j] * (0.5f * (zp_[j] + zn_[j]) - zc_[j]); } while (0)
          MIX(rc, c0, p0, n0, mur); MIX(kc, c1, p1, n1, muk); MIX(vc, c2, p2, n2, muv);
#undef MIX
        }
        const u32x2 au = *(const u32x2*)&Aa[(R * 2 + d) * 512 + cbase];
        const float a4[4] = {bflo(au[0]), bfhi(au[0]), bflo(au[1]), bfhi(au[1])};
        typedef _Float16 h4 __attribute__((ext_vector_type(4)));
        const h4 om = *(const h4*)&OM[(R * 2 + d) * 512 + cbase];
        float kq[4], ssq = 0.f;
#pragma unroll
        for (int j = 0; j < 4; ++j) { kq[j] = kc[j] * kk4[j]; ssq += kq[j] * kq[j]; }
        ssq = red16(ssq);
        const float inv = 1.f / fmaxf(sqrtf(ssq), 1e-12f);
        f32x4 w4, k4, b4, kd4, r4;
#pragma unroll
        for (int j = 0; j < 4; ++j) {
          const float kap = kq[j] * inv;
          w4[j] = 1.f - (float)om[j]; k4[j] = kap; b4[j] = kap * a4[j];
          kd4[j] = kc[j] * (1.f + (a4[j] - 1.f) * ka4[j]); r4[j] = rc[j];
        }
        const int o = si * 64 + sn;
        *(f32x4*)&sd[o] = w4; *(f32x4*)&sd[2048 + o] = k4; *(f32x4*)&sd[4096 + o] = b4; *(f32x4*)&sd[6144 + o] = kd4; *(f32x4*)&sd[8192 + o] = r4;
        if ((sn >> 4) == q) { f32x4 v4 = {vc[0], vc[1], vc[2], vc[3]}; *(f32x4*)&sd[10240 + si * 16 + (sn & 15)] = v4; }
      }
      __syncthreads();
#pragma unroll 4
      for (int i = 0; i < 32; ++i) {
        const int o = i * 64 + l16 * 4;
        const f32x4 w4 = *(const f32x4*)&cw[o]; const f32x4 k4 = *(const f32x4*)&cw[2048 + o]; const f32x4 b4 = *(const f32x4*)&cw[4096 + o];
        const f32x4 kd4 = *(const f32x4*)&cw[6144 + o]; const f32x4 r4 = *(const f32x4*)&cw[8192 + o];
        const float vv = cw[10240 + i * 16 + rowl];
        float sa = S0 * k4[0] + S1 * k4[1] + S2 * k4[2] + S3 * k4[3];
        sa = red16(sa);
        S0 = S0 * w4[0] + (vv * kd4[0] - sa * b4[0]);
        S1 = S1 * w4[1] + (vv * kd4[1] - sa * b4[1]);
        S2 = S2 * w4[2] + (vv * kd4[2] - sa * b4[2]);
        S3 = S3 * w4[3] + (vv * kd4[3] - sa * b4[3]);
        float y = S0 * r4[0] + S1 * r4[1] + S2 * r4[2] + S3 * r4[3];
        y = red16(y);
        if (l16 == 0) cw[10752 + i * 16 + rowl] = y;
      }
      __syncthreads();
      {
        const int i = tid >> 4, rl = tid & 15;
        const float vf = ((float*)lds)[10752 + i * 16 + rl];
        const float vb = ((float*)lds)[DSTR + 10752 + (31 - i) * 16 + rl];
        float* yf = &Y[((size_t)b * SEQ + chk * 32 + i) * 512 + h * 64 + q * 16 + rl];
        float* yb = &Y[((size_t)b * SEQ + (SEQ - 32 - chk * 32) + i) * 512 + h * 64 + q * 16 + rl];
        if (chk < SEQ / 64) { *yf = vf; *yb = vb; }
        else { *yf = *yf + vf; *yb = *yb + vb; }
      }
    }
    __syncthreads();
  }
}

DEVI void phase_post(const Params& p, int l) {
  bf16* PJ = (bf16*)(p.ws + OFF_U);
  const bf16* Aa = (const bf16*)(p.ws + OFF_A);
  const bf16* G = (const bf16*)(p.ws + OFF_G);
  const float* Y = (const float*)(p.ws + OFF_H);
  const int tid = tid_opaque(), wid = tid >> 6, lane = tid & 63, c0 = lane * 8;
  float mur[8], muk[8], muv[8], ka[8], rk[8], lw[8], lb[8];
#pragma unroll
  for (int j = 0; j < 8; ++j) {
    mur[j] = p.tshift_mu[l * 1920 + c0 + j]; muk[j] = p.tshift_mu[l * 1920 + 512 + c0 + j]; muv[j] = p.tshift_mu[l * 1920 + 1024 + c0 + j];
    ka[j] = p.k_a[l * 512 + c0 + j]; rk[j] = p.r_k[l * 512 + c0 + j]; lw[j] = p.lnx_w[l * 512 + c0 + j]; lb[j] = p.lnx_b[l * 512 + c0 + j];
  }
  for (int R = blockIdx.x * 8 + wid; R < NTOK; R += gridDim.x * 8) {
    const int pos = R & (SEQ - 1);
    float y[8];
    { const f32x4 y0 = *(const f32x4*)&Y[(size_t)R * 512 + c0], y1 = *(const f32x4*)&Y[(size_t)R * 512 + c0 + 4];
      y[0] = y0[0]; y[1] = y0[1]; y[2] = y0[2]; y[3] = y0[3]; y[4] = y1[0]; y[5] = y1[1]; y[6] = y1[2]; y[7] = y1[3]; }
    float s1 = 0;
#pragma unroll
    for (int j = 0; j < 8; ++j) s1 += y[j];
    const float mean = red8(s1) * (1.f / 64.f);
    float s2 = 0;
#pragma unroll
    for (int j = 0; j < 8; ++j) { y[j] -= mean; s2 += y[j] * y[j]; }
    const float rstd = rsqrtf(red8(s2) * (1.f / 64.f) + 64e-5f);
    float rr[8], kk[8], vv[8], a0[8], a1[8], g8[8];
    shiftmix8(PJ, R, pos, 1536 + c0, mur, rr);
    shiftmix8(PJ, R, pos, 2048 + c0, muk, kk);
    shiftmix8(PJ, R, pos, 2560 + c0, muv, vv);
    unpack8(*(const u32x4*)&Aa[((size_t)R * 2 + 0) * 512 + c0], a0);
    unpack8(*(const u32x4*)&Aa[((size_t)R * 2 + 1) * 512 + c0], a1);
    unpack8(*(const u32x4*)&G[(size_t)R * 512 + c0], g8);
#ifdef NAIVE_G
    { const bf16* ZLp = (const bf16*)(p.ws + OFF_ZL) + (size_t)R * 384 + 256; const float* g2 = p.gate_g2 + (size_t)l * 128 * 512 + c0;
      for (int j = 0; j < 8; ++j) g8[j] = 0.f;
      for (int k = 0; k < 128; ++k) { const float sv = bf2f(*(const unsigned short*)&ZLp[k]);
        for (int j = 0; j < 8; ++j) g8[j] += sv * g2[(size_t)k * 512 + j]; } }
#endif
#ifdef NAIVE_G2T
    { const bf16* ZLp = (const bf16*)(p.ws + OFF_ZL) + (size_t)R * 384 + 256; const bf16* g2t = (const bf16*)(p.ws + OFF_G2T) + (size_t)c0 * 128;
      for (int j = 0; j < 8; ++j) g8[j] = 0.f;
      for (int k = 0; k < 128; ++k) { const float sv = bf2f(*(const unsigned short*)&ZLp[k]);
        for (int j = 0; j < 8; ++j) g8[j] += sv * bf2f(*(const unsigned short*)&g2t[(size_t)j * 128 + k]); } }
#endif
#define FIN(x) (fabsf(x) < 1e30f)
#ifdef IGN_Y
    for (int j = 0; j < 8; ++j) y[j] = 0.01f * j;
#endif
#ifdef IGN_A
    for (int j = 0; j < 8; ++j) { a0[j] = 0.5f; a1[j] = 0.5f; }
#endif
#ifdef IGN_G
    for (int j = 0; j < 8; ++j) { g8[j] = 1.f; }
#endif
#ifdef IGN_RKV
    for (int j = 0; j < 8; ++j) { rr[j] = 0.1f; kk[j] = 0.1f; vv[j] = 0.1f; }
#endif
#ifdef SAN_Y
    for (int j = 0; j < 8; ++j) if (!FIN(y[j])) y[j] = 0.f;
#endif
#ifdef SAN_A
    for (int j = 0; j < 8; ++j) { if (!FIN(a0[j])) a0[j] = 0.f; if (!FIN(a1[j])) a1[j] = 0.f; }
#endif
#ifdef SAN_G
    for (int j = 0; j < 8; ++j) if (!FIN(g8[j])) g8[j] = 0.f;
#endif
#ifdef SAN_RKV
    for (int j = 0; j < 8; ++j) { if (!FIN(rr[j])) rr[j] = 0.f; if (!FIN(kk[j])) kk[j] = 0.f; if (!FIN(vv[j])) vv[j] = 0.f; }
#endif
    float bs = 0;
#pragma unroll
    for (int j = 0; j < 8; ++j) {
      const float kds = kk[j] * ((1.f + (a0[j] - 1.f) * ka[j]) + (1.f + (a1[j] - 1.f) * ka[j]));
      bs += rr[j] * kds * rk[j];
    }
    bs = red8(bs);
    float o[8];
#pragma unroll
    for (int j = 0; j < 8; ++j) o[j] = (y[j] * rstd * lw[j] + lb[j] + bs * vv[j]) * g8[j];
    *(u32x4*)&PJ[(size_t)R * LDP + 512 + c0] = pack8(o);
  }
}

__global__ void __launch_bounds__(NTHR) fwd_megakernel(Params p) {
  extern __shared__ __attribute__((aligned(16))) char lds[];
  cg::grid_group grid = cg::this_grid();
  const int nb = gridDim.x, bid = blockIdx.x;
  unsigned* gbar = (unsigned*)(p.ws + OFF_BAR); unsigned gtarget = 0;
  grid.sync();
  bf16* WT_IN = (bf16*)(p.ws + OFF_WT_IN); bf16* WT_OUT = (bf16*)(p.ws + OFF_WT_OUT);
  bf16* WT_UP = (bf16*)(p.ws + OFF_WT_UP); bf16* WT_DOWN = (bf16*)(p.ws + OFF_WT_DOWN);
  bf16* W2T = (bf16*)(p.ws + OFF_W2T); bf16* A2T = (bf16*)(p.ws + OFF_A2T); bf16* G2T = (bf16*)(p.ws + OFF_G2T);
  bf16* PJ = (bf16*)(p.ws + OFF_U); bf16* U = PJ; bf16* ZL = (bf16*)(p.ws + OFF_ZL); bf16* H = (bf16*)(p.ws + OFF_H);
  _Float16* OMW = (_Float16*)(p.ws + OFF_OMW); bf16* AA = (bf16*)(p.ws + OFF_A); bf16* GG = (bf16*)(p.ws + OFF_G);
  const float* mod = (const float*)(p.ws + OFF_MOD);
  const float* cosT = (const float*)(p.ws + OFF_COS); const float* sinT = (const float*)(p.ws + OFF_SIN);

  phase_mod(p, lds);
  phase_rope(p);
  phase_conv(p, 0, lds);
  GSYNC();

  for (int l = 0; l < 2; ++l) {
    const float* xin = (l == 0) ? p.x : p.out;
    const float* modl = mod + (size_t)l * 4 * 6144;
    if (l > 0) phase_conv(p, l, lds);
    phase_norm(xin, p.norm1 + l * DM, modl, 0, 1024, H);
    GSYNC();
    for (int it = bid; it < 128 * 27; it += nb) {
      const int mt = it / 27, nt = it % 27;
      gemm_tile(H, DM, WT_IN, DM, DM, mt * 256, nt * 128, lds,
        [&](f32x16& c0, f32x16& c1, int mw, int nw, int r32, int hi) {
          if (nw < 1024) {
#pragma unroll
            for (int r = 0; r < 16; ++r) {
              const int row = mw + crow(r, hi); const int pos = row & (SEQ - 1);
              const float cs = cosT[pos * 32 + r32], sn = sinT[pos * 32 + r32];
              const float t1 = c0[r], t2 = c1[r];
              *(unsigned short*)&PJ[(size_t)row * LDP + nw + r32] = f2bf(t1 * cs - t2 * sn);
              *(unsigned short*)&PJ[(size_t)row * LDP + nw + 32 + r32] = f2bf(t1 * sn + t2 * cs);
            }
          } else {
#pragma unroll
            for (int r = 0; r < 16; ++r) {
              const int row = mw + crow(r, hi);
              *(unsigned short*)&PJ[(size_t)row * LDP + nw + r32] = f2bf(c0[r]);
              *(unsigned short*)&PJ[(size_t)row * LDP + nw + 32 + r32] = f2bf(c1[r]);
            }
          }
        });
    }
    GSYNC();
    phase_zl(p, l);
    {
      float s1 = 0, s2 = 0;
      for (int i = 0; i < 64; ++i) { s1 += p.lam_q1[l * 64 + i] * p.lam_k1[l * 64 + i]; s2 += p.lam_q2[l * 64 + i] * p.lam_k2[l * 64 + i]; }
      const float lam_init = 0.8f - 0.6f * expf(-0.3f * (float)l);
      const float lam = expf(s1) - expf(s2) + lam_init;
#ifndef SKIP_ATT
      if (nb == 256) {
        const int xcd = bid & 7, jj = bid >> 3;
#pragma unroll 1
        for (int i4 = 0; i4 < 4; ++i4) {
          {
            const int bh = xcd + 8 * (i4 >> 1), qb = jj + 32 * (i4 & 1);
            attn_item(PJ, bh >> 2, bh & 3, qb, lam, 1.f - lam_init, p.subln_w + l * 128, lds);
          }
        }
      } else {
#pragma unroll 1
        for (int it = bid; it < 1024; it += nb) attn_item(PJ, it >> 8, (it >> 6) & 3, it & 63, lam, 1.f - lam_init, p.subln_w + l * 128, lds);
      }
#endif
    }
    GSYNC();
    for (int it = bid; it < 5 * 512; it += nb) {
      const int g = it / 512, t = it % 512, mt = t >> 2, nt = t & 3, d = g & 1;
      const bf16* Ap; const bf16* Bp; int ldb, KK;
      if (g < 2) { Ap = ZL + d * 64; Bp = W2T + d * 512 * 64; ldb = 64; KK = 64; }
      else if (g < 4) { Ap = ZL + 128 + d * 64; Bp = A2T + d * 512 * 64; ldb = 64; KK = 64; }
      else { Ap = ZL + 256; Bp = G2T; ldb = 128; KK = 128; }
      const float* w0 = p.decay_w0 + (size_t)(l * 2 + d) * 512; const float* a0 = p.icl_a0 + (size_t)(l * 2 + d) * 512;
      gemm_tile(Ap, 384, Bp, ldb, KK, mt * 256, nt * 128, lds,
        [&](f32x16& c0, f32x16& c1, int mw, int nw, int r32, int hi) {
#pragma unroll
          for (int jj = 0; jj < 2; ++jj) {
            const int col = nw + jj * 32 + r32;
            if (g < 2) {
              const float w0c = w0[col];
#pragma unroll
              for (int r = 0; r < 16; ++r) {
                const int row = mw + crow(r, hi);
                const float xv = (jj ? c1[r] : c0[r]) + w0c;
                const float nx = -xv;
                const float sp = fmaxf(nx, 0.f) + log1pf(expf(-fabsf(nx)));
                const float wl = -sp - 0.5f;
                const float e = expf(wl);
                OMW[((size_t)row * 2 + d) * 512 + col] = (_Float16)(-expm1f(-e));
              }
            } else if (g < 4) {
              const float a0c = a0[col];
#pragma unroll
              for (int r = 0; r < 16; ++r) {
                const int row = mw + crow(r, hi);
                const float xv = (jj ? c1[r] : c0[r]) + a0c;
                *(unsigned short*)&AA[((size_t)row * 2 + d) * 512 + col] = f2bf(1.f / (1.f + expf(-xv)));
              }
            } else {
#pragma unroll
              for (int r = 0; r < 16; ++r) {
                const int row = mw + crow(r, hi);
                *(unsigned short*)&GG[(size_t)row * 512 + col] = f2bf(jj ? c1[r] : c0[r]);
              }
            }
          }
        });
    }
    GSYNC();
#ifndef SKIP_SCAN
    phase_scan(p, l, lds);
#endif
    GSYNC();
#ifndef SKIP_POST
    phase_post(p, l);
#endif
    GSYNC();
    for (int it = bid; it < 128 * 8; it += nb) {
      const int mt = it >> 3, nt = it & 7;
      gemm_tile(PJ, LDP, WT_OUT, DM, DM, mt * 256, nt * 128, lds,
        [&](f32x16& c0, f32x16& c1, int mw, int nw, int r32, int hi) {
#pragma unroll
          for (int r = 0; r < 16; ++r) {
            const int row = mw + crow(r, hi); const int b = row >> 13;
            const size_t o0 = (size_t)row * DM + nw + r32;
            p.out[o0] = xin[o0] + modl[b * 6144 + 2048 + nw + r32] * c0[r];
            p.out[o0 + 32] = xin[o0 + 32] + modl[b * 6144 + 2048 + nw + 32 + r32] * c1[r];
          }
        });
    }
    GSYNC();
    phase_norm(p.out, p.norm2 + l * DM, modl, 3072, 4096, H);
    GSYNC();
    for (int it = bid; it < 128 * 32; it += nb) {
      const int mt = it >> 5, nt = it & 31;
      gemm_tile(H, DM, WT_UP, DM, DM, mt * 256, nt * 128, lds,
        [&](f32x16& c0, f32x16& c1, int mw, int nw, int r32, int hi) {
#pragma unroll
          for (int r = 0; r < 16; ++r) {
            const int row = mw + crow(r, hi);
            const float u0 = fmaxf(c0[r], 0.f), u1 = fmaxf(c1[r], 0.f);
            *(unsigned short*)&U[(size_t)row * DFF + nw + r32] = f2bf(u0 * u0);
            *(unsigned short*)&U[(size_t)row * DFF + nw + 32 + r32] = f2bf(u1 * u1);
          }
        });
    }
    GSYNC();
    for (int it = bid; it < 128 * 8; it += nb) {
      const int mt = it >> 3, nt = it & 7;
      gemm_tile(U, DFF, WT_DOWN, DFF, DFF, mt * 256, nt * 128, lds,
        [&](f32x16& c0, f32x16& c1, int mw, int nw, int r32, int hi) {
#pragma unroll
          for (int r = 0; r < 16; ++r) {
            const int row = mw + crow(r, hi); const int b = row >> 13;
            const size_t o0 = (size_t)row * DM + nw + r32;
            p.out[o0] = p.out[o0] + modl[b * 6144 + 5120 + nw + r32] * c0[r];
            p.out[o0 + 32] = p.out[o0 + 32] + modl[b * 6144 + 5120 + nw + 32 + r32] * c1[r];
          }
        });
    }
    GSYNC();
  }
  phase_final_norm(p.out, p.norm_f);
}

extern "C" void kernel_launch(void* const* d_in, const int* in_sizes, int n_in, void* d_out, int out_size, void* d_ws, size_t ws_size,
                              hipStream_t stream) {
  static int grid_blocks = 0;
  if (n_in != 27 || ws_size < WS_NEED) { fprintf(stderr, "kernel_launch: bad n_in %d or ws_size %zu (< %zu)\n", n_in, ws_size, (size_t)WS_NEED); return; }
  if (!grid_blocks) {
    int dev = 0, cus = 0, per_cu = 0;
    hipGetDevice(&dev);
    hipDeviceGetAttribute(&cus, hipDeviceAttributeMultiprocessorCount, dev);
    hipFuncSetAttribute((const void*)fwd_megakernel, hipFuncAttributeMaxDynamicSharedMemorySize, LDS_BYTES);
    hipOccupancyMaxActiveBlocksPerMultiprocessor(&per_cu, fwd_megakernel, NTHR, LDS_BYTES);
    if (per_cu < 1) per_cu = 1;
    if (per_cu > 1) per_cu = 1;
    grid_blocks = cus * per_cu;
  }
  Params p{};
  const float** pp = (const float**)&p;
  for (int i = 0; i < 27; ++i) pp[i] = (const float*)d_in[i];
  p.out = (float*)d_out; p.ws = (char*)d_ws;
  for (int i = 0; i < 32; ++i) p.inv_freq[i] = 1.0f / powf(10000.0f, (float)(2 * i) / 64.0f);
  hipMemsetAsync((char*)d_ws + OFF_BAR, 0, 256, stream);
  void* args[] = {&p};
  hipError_t e = hipLaunchCooperativeKernel((void*)fwd_megakernel, dim3(grid_blocks), dim3(NTHR), args, LDS_BYTES, stream);
  if (e != hipSuccess) fprintf(stderr, "cooperative launch failed: %s (grid %d)\n", hipGetErrorString(e), grid_blocks);
}
```

```cpp
#include <hip/hip_runtime.h>
#include <hip/hip_bf16.h>
#include <hip/hip_cooperative_groups.h>
#include <cstdio>
#include <cmath>
namespace cg = cooperative_groups;

#define DEVI __device__ __forceinline__
using bf16 = __hip_bfloat16;
typedef short bf16x8 __attribute__((ext_vector_type(8)));
typedef short s16x4 __attribute__((ext_vector_type(4)));
typedef float f32x16 __attribute__((ext_vector_type(16)));
typedef float f32x4 __attribute__((ext_vector_type(4)));
typedef unsigned u32x4 __attribute__((ext_vector_type(4)));
typedef unsigned u32x2 __attribute__((ext_vector_type(2)));

constexpr int NTOK = 32768, SEQ = 8192, DM = 1024, LDP = 3456, DFF = 4096;
constexpr int NTHR = 512;
constexpr size_t MiB = 1024 * 1024;
constexpr size_t OFF_WT_IN = 0;
constexpr size_t OFF_WT_OUT = OFF_WT_IN + (size_t)3456 * 1024 * 2;
constexpr size_t OFF_WT_UP = OFF_WT_OUT + (size_t)1024 * 1024 * 2;
constexpr size_t OFF_WT_DOWN = OFF_WT_UP + (size_t)4096 * 1024 * 2;
constexpr size_t OFF_W2T = OFF_WT_DOWN + (size_t)4096 * 1024 * 2;
constexpr size_t OFF_A2T = OFF_W2T + (size_t)2 * 512 * 64 * 2;
constexpr size_t OFF_G2T = OFF_A2T + (size_t)2 * 512 * 64 * 2;
constexpr size_t OFF_U = 26 * MiB;
constexpr size_t OFF_ZL = OFF_U + 216 * MiB;
constexpr size_t OFF_H = OFF_U + 256 * MiB;
constexpr size_t OFF_OMW = OFF_H + 64 * MiB;
constexpr size_t OFF_A = OFF_OMW + 64 * MiB;
constexpr size_t OFF_G = OFF_A + 64 * MiB;
constexpr size_t OFF_MOD = OFF_G + 32 * MiB;
constexpr size_t OFF_COS = OFF_MOD + 1 * MiB;
constexpr size_t OFF_SIN = OFF_COS + 1 * MiB;
constexpr size_t OFF_BAR = OFF_SIN + 1 * MiB;
constexpr size_t WS_NEED = OFF_BAR + 1 * MiB;
constexpr int LDS_BYTES = 131072;

struct Params {
  const float *x, *c, *w_ada, *b_ada, *norm1, *norm2, *w_in, *w_out, *lam_q1, *lam_k1, *lam_q2, *lam_k2, *subln_w, *tshift_mu,
      *decay_w0, *decay_w2, *icl_a0, *icl_a2, *gate_g2, *k_k, *k_a, *r_k, *lnx_w, *lnx_b, *w_up, *w_down, *norm_f;
  float* out;
  char* ws;
  float inv_freq[32];
};

DEVI void grid_barrier(unsigned* bar, unsigned& target) {
  asm volatile("s_waitcnt vmcnt(0) lgkmcnt(0)" ::: "memory");
  __syncthreads();
  target += gridDim.x;
  if (threadIdx.x == 0) {
    __builtin_amdgcn_fence(__ATOMIC_RELEASE, "agent");
    asm volatile("s_waitcnt vmcnt(0)" ::: "memory");
    __hip_atomic_fetch_add(bar, 1u, __ATOMIC_RELAXED, __HIP_MEMORY_SCOPE_AGENT);
    while (__hip_atomic_load(bar, __ATOMIC_RELAXED, __HIP_MEMORY_SCOPE_AGENT) < target) __builtin_amdgcn_s_sleep(2);
    __builtin_amdgcn_fence(__ATOMIC_ACQUIRE, "agent");
    asm volatile("s_waitcnt vmcnt(0)" ::: "memory");
  }
  __syncthreads();
}
#define GSYNC() grid_barrier(gbar, gtarget)
struct Params;
DEVI char* ws_launder(char* w) { asm volatile("" : "+v"(w)); return w; }
#define WSV(p) ws_launder((p).ws)
DEVI int tid_opaque() { int t = threadIdx.x; asm volatile("" : "+v"(t)); return t; }
DEVI int crow(int r, int hi) { return (r & 3) + 8 * (r >> 2) + 4 * hi; }
DEVI unsigned cvtpk(float lo, float hi) {
  unsigned r; asm volatile("v_cvt_pk_bf16_f32 %0, %1, %2" : "=v"(r) : "v"(lo), "v"(hi)); return r;
}
DEVI unsigned short f2bf(float x) { return (unsigned short)(cvtpk(x, 0.f) & 0xffffu); }
DEVI float bf2f(unsigned short u) { return __uint_as_float(((unsigned)u) << 16); }
DEVI float bflo(unsigned u) { return __uint_as_float(u << 16); }
DEVI float bfhi(unsigned u) { return __uint_as_float(u & 0xffff0000u); }
template <int CTRL> DEVI float dppf(float x) {
  return __builtin_bit_cast(float, __builtin_amdgcn_mov_dpp(__builtin_bit_cast(int, x), CTRL, 0xf, 0xf, true));
}
DEVI float red8(float x) { x += dppf<0xB1>(x); x += dppf<0x4E>(x); x += dppf<0x141>(x); return x; }
DEVI float red16(float x) { x = red8(x); x += dppf<0x128>(x); return x; }
DEVI float red64(float x) { x = red16(x); x += __shfl_xor(x, 16); x += __shfl_xor(x, 32); return x; }
DEVI float sigmoidf_(float x) { return 1.f / (1.f + __expf(-x)); }
DEVI void unpack8(u32x4 v, float* f) {
  f[0] = bflo(v[0]); f[1] = bfhi(v[0]); f[2] = bflo(v[1]); f[3] = bfhi(v[1]);
  f[4] = bflo(v[2]); f[5] = bfhi(v[2]); f[6] = bflo(v[3]); f[7] = bfhi(v[3]);
}
DEVI u32x4 pack8(const float* f) {
  u32x4 w = {cvtpk(f[0], f[1]), cvtpk(f[2], f[3]), cvtpk(f[4], f[5]), cvtpk(f[6], f[7])}; return w;
}

DEVI void phase_mod(const Params& p, char* lds) {
  float* sc = (float*)lds;
  float* red = sc + 4096;
  const int tid = tid_opaque(), w = tid >> 6, lane = tid & 63;
  for (int i = tid; i < 4096; i += NTHR) { float v = p.c[i]; sc[i] = v / (1.f + expf(-v)); }
  __syncthreads();
  float* mod = (float*)(WSV(p) + OFF_MOD);
  for (int it = blockIdx.x; it < 192; it += gridDim.x) {
    const int l = it / 96, col = (it % 96) * 64 + lane;
    const float* W = p.w_ada + (size_t)l * 1024 * 6144 + col;
    float a0 = 0, a1 = 0, a2 = 0, a3 = 0;
    for (int k = w * 128; k < w * 128 + 128; ++k) {
      float wv = W[(size_t)k * 6144];
      a0 += sc[k] * wv; a1 += sc[1024 + k] * wv; a2 += sc[2048 + k] * wv; a3 += sc[3072 + k] * wv;
    }
    red[(w * 4 + 0) * 64 + lane] = a0; red[(w * 4 + 1) * 64 + lane] = a1;
    red[(w * 4 + 2) * 64 + lane] = a2; red[(w * 4 + 3) * 64 + lane] = a3;
    __syncthreads();
    if (tid < 256) {
      const int bb = tid >> 6; float s = 0;
      for (int ww = 0; ww < 8; ++ww) s += red[(ww * 4 + bb) * 64 + lane];
      mod[(l * 4 + bb) * 6144 + col] = s + p.b_ada[l * 6144 + col];
    }
    __syncthreads();
  }
}

DEVI void phase_rope(const Params& p) {
  float* cosT = (float*)(WSV(p) + OFF_COS); float* sinT = (float*)(WSV(p) + OFF_SIN);
  for (int idx = blockIdx.x * NTHR + tid_opaque(); idx < SEQ * 32; idx += gridDim.x * NTHR) {
    const int pos = idx >> 5, i = idx & 31;
    const float ang = (float)pos * p.inv_freq[i];
    double q = (double)ang * 0.15915494309189533577; q -= floor(q);
    const float f = (float)q;
    cosT[idx] = __builtin_amdgcn_cosf(f); sinT[idx] = __builtin_amdgcn_sinf(f);
  }
}

DEVI void conv_tile(const float* __restrict__ src, int ldsrc, bf16* __restrict__ dst, int lddst, int k0, int n0, float* tile) {
  const int tid = tid_opaque();
#pragma unroll
  for (int ps = 0; ps < 2; ++ps) {
    const int k = ps * 32 + (tid >> 4), n = (tid & 15) * 4;
    const f32x4 v = *(const f32x4*)&src[(size_t)(k0 + k) * ldsrc + n0 + n];
    tile[k * 65 + n + 0] = v[0]; tile[k * 65 + n + 1] = v[1]; tile[k * 65 + n + 2] = v[2]; tile[k * 65 + n + 3] = v[3];
  }
  __syncthreads();
  {
    const int n = tid >> 3, kc = (tid & 7) * 8; float f[8];
#pragma unroll
    for (int j = 0; j < 8; ++j) f[j] = tile[(kc + j) * 65 + n];
    *(u32x4*)&dst[(size_t)(n0 + n) * lddst + k0 + kc] = pack8(f);
  }
  __syncthreads();
}
DEVI void phase_conv(const Params& p, int l, char* lds) {
  float* tile = (float*)lds;
  for (int it = blockIdx.x; it < 3216; it += gridDim.x) {
    const float* src; bf16* dst; int K, N, t = it;
    char* wsb = p.ws; asm volatile("" : "+v"(wsb));
    if (t < 864) { src = p.w_in + (size_t)l * 1024 * 3456; dst = (bf16*)(wsb + OFF_WT_IN); K = 1024; N = 3456; }
    else if ((t -= 864) < 256) { src = p.w_out + (size_t)l * 1024 * 1024; dst = (bf16*)(wsb + OFF_WT_OUT); K = 1024; N = 1024; }
    else if ((t -= 256) < 1024) { src = p.w_up + (size_t)l * 1024 * 4096; dst = (bf16*)(wsb + OFF_WT_UP); K = 1024; N = 4096; }
    else if ((t -= 1024) < 1024) { src = p.w_down + (size_t)l * 4096 * 1024; dst = (bf16*)(wsb + OFF_WT_DOWN); K = 4096; N = 1024; }
    else if ((t -= 1024) < 16) { const int d = t >> 3; t &= 7; src = p.decay_w2 + (size_t)(l * 2 + d) * 64 * 512; dst = (bf16*)(wsb + OFF_W2T) + d * 512 * 64; K = 64; N = 512; }
    else if ((t -= 16) < 16) { const int d = t >> 3; t &= 7; src = p.icl_a2 + (size_t)(l * 2 + d) * 64 * 512; dst = (bf16*)(wsb + OFF_A2T) + d * 512 * 64; K = 64; N = 512; }
    else { t -= 16; src = p.gate_g2 + (size_t)l * 128 * 512; dst = (bf16*)(wsb + OFF_G2T); K = 128; N = 512; }
    const int nt = N / 64; const int kt = t / nt, ntile = t % nt;
    conv_tile(src, N, dst, K, kt * 64, ntile * 64, tile);
  }
}

DEVI void phase_norm(const float* __restrict__ xin, const float* __restrict__ g, const float* __restrict__ modl, int shoff, int scoff,
                     bf16* __restrict__ H) {
  const int tid = tid_opaque(), w = tid >> 6, lane = tid & 63;
  for (int row = blockIdx.x * 8 + w; row < NTOK; row += gridDim.x * 8) {
    const int b = row >> 13; f32x4 v[4]; float ss = 0;
#pragma unroll
    for (int j = 0; j < 4; ++j) { v[j] = *(const f32x4*)&xin[(size_t)row * DM + j * 256 + lane * 4]; ss += v[j][0] * v[j][0] + v[j][1] * v[j][1] + v[j][2] * v[j][2] + v[j][3] * v[j][3]; }
    ss = red64(ss);
    const float rstd = rsqrtf(ss * (1.f / 1024.f) + 1e-6f);
#pragma unroll
    for (int j = 0; j < 4; ++j) {
      const int col = j * 256 + lane * 4;
      const f32x4 g4 = *(const f32x4*)&g[col];
      const f32x4 sc4 = *(const f32x4*)&modl[b * 6144 + scoff + col];
      const f32x4 sh4 = *(const f32x4*)&modl[b * 6144 + shoff + col];
      float o[4];
#pragma unroll
      for (int e = 0; e < 4; ++e) o[e] = v[j][e] * rstd * g4[e] * (1.f + sc4[e]) + sh4[e];
      u32x2 pk = {cvtpk(o[0], o[1]), cvtpk(o[2], o[3])};
      *(u32x2*)&H[(size_t)row * DM + col] = pk;
    }
  }
}
DEVI void phase_final_norm(float* __restrict__ x, const float* __restrict__ g) {
  const int tid = tid_opaque(), w = tid >> 6, lane = tid & 63;
  for (int row = blockIdx.x * 8 + w; row < NTOK; row += gridDim.x * 8) {
    f32x4 v[4]; float ss = 0;
#pragma unroll
    for (int j = 0; j < 4; ++j) { v[j] = *(const f32x4*)&x[(size_t)row * DM + j * 256 + lane * 4]; ss += v[j][0] * v[j][0] + v[j][1] * v[j][1] + v[j][2] * v[j][2] + v[j][3] * v[j][3]; }
    ss = red64(ss);
    const float rstd = rsqrtf(ss * (1.f / 1024.f) + 1e-6f);
#pragma unroll
    for (int j = 0; j < 4; ++j) {
      const int col = j * 256 + lane * 4;
      const f32x4 g4 = *(const f32x4*)&g[col];
      f32x4 o = {v[j][0] * rstd * g4[0], v[j][1] * rstd * g4[1], v[j][2] * rstd * g4[2], v[j][3] * rstd * g4[3]};
#ifdef SANITIZE
      for (int e = 0; e < 4; ++e) if (!(fabsf(o[e]) < 1e30f)) o[e] = 0.f;
#endif
      *(f32x4*)&x[(size_t)row * DM + col] = o;
    }
  }
}

template <class Epi>
DEVI void gemm_tile(const bf16* __restrict__ A, int lda, const bf16* __restrict__ Bt, int ldb, int K, int m0, int n0, char* lds, Epi&& epi) {
  const int tid = tid_opaque(), wid = tid >> 6, lane = tid & 63, r32 = lane & 31, hi = lane >> 5;
  const int wm = wid >> 1, wn = wid & 1;
  char* As = lds; char* Bs = lds + 65536;
  f32x16 acc00 = {}, acc01 = {}, acc02 = {}, acc03 = {}, acc10 = {}, acc11 = {}, acc12 = {}, acc13 = {};
  const int lrow = tid >> 3, lch = tid & 7;
  const bf16* Ag = A + (size_t)(m0 + lrow) * lda + lch * 8;
  const bf16* Bg = Bt + (size_t)(n0 + lrow) * ldb + lch * 8;
  const int wsw = lrow * 128 + ((lch ^ ((lrow >> 1) & 7)) * 16);
  bf16x8 ra0, ra1, ra2, ra3, rb0, rb1, rb2, rb3;
#define GLOAD(k0) do { ra0 = *(const bf16x8*)(Ag + (k0)); ra1 = *(const bf16x8*)(Ag + (size_t)64 * lda + (k0)); \
    ra2 = *(const bf16x8*)(Ag + (size_t)128 * lda + (k0)); ra3 = *(const bf16x8*)(Ag + (size_t)192 * lda + (k0)); \
    rb0 = *(const bf16x8*)(Bg + (k0)); rb1 = *(const bf16x8*)(Bg + (size_t)64 * ldb + (k0)); \
    rb2 = *(const bf16x8*)(Bg + (size_t)128 * ldb + (k0)); rb3 = *(const bf16x8*)(Bg + (size_t)192 * ldb + (k0)); } while (0)
#define LWRITE(buf) do { char* a_ = As + (buf) * 32768 + wsw; char* b_ = Bs + (buf) * 32768 + wsw; \
    *(bf16x8*)(a_) = ra0; *(bf16x8*)(a_ + 64 * 128) = ra1; *(bf16x8*)(a_ + 128 * 128) = ra2; *(bf16x8*)(a_ + 192 * 128) = ra3; \
    *(bf16x8*)(b_) = rb0; *(bf16x8*)(b_ + 64 * 128) = rb1; *(bf16x8*)(b_ + 128 * 128) = rb2; *(bf16x8*)(b_ + 192 * 128) = rb3; } while (0)
  const int KT = K >> 6;
  const int arow0 = wm * 64 + r32, arow1 = arow0 + 32, brow0 = wn * 128 + r32;
  const int asw = (arow0 >> 1) & 7;
  const int bsw = (brow0 >> 1) & 7;
  GLOAD(0); LWRITE(0); __syncthreads();
#pragma unroll 2
  for (int kt = 0; kt < KT; ++kt) {
    if (kt + 1 < KT) GLOAD((kt + 1) * 64);
    const char* Ab = As + (kt & 1) * 32768; const char* Bb = Bs + (kt & 1) * 32768;
#pragma unroll
    for (int kk = 0; kk < 4; ++kk) {
      const int ch = kk * 2 + hi;
      const bf16x8 a0 = *(const bf16x8*)(Ab + arow0 * 128 + ((ch ^ asw) * 16));
      const bf16x8 a1 = *(const bf16x8*)(Ab + arow1 * 128 + ((ch ^ asw) * 16));
      const bf16x8 b0 = *(const bf16x8*)(Bb + brow0 * 128 + ((ch ^ bsw) * 16));
      const bf16x8 b1 = *(const bf16x8*)(Bb + (brow0 + 32) * 128 + ((ch ^ bsw) * 16));
      const bf16x8 b2 = *(const bf16x8*)(Bb + (brow0 + 64) * 128 + ((ch ^ bsw) * 16));
      const bf16x8 b3 = *(const bf16x8*)(Bb + (brow0 + 96) * 128 + ((ch ^ bsw) * 16));
      acc00 = __builtin_amdgcn_mfma_f32_32x32x16_bf16(b0, a0, acc00, 0, 0, 0);
      acc01 = __builtin_amdgcn_mfma_f32_32x32x16_bf16(b1, a0, acc01, 0, 0, 0);
      acc02 = __builtin_amdgcn_mfma_f32_32x32x16_bf16(b2, a0, acc02, 0, 0, 0);
      acc03 = __builtin_amdgcn_mfma_f32_32x32x16_bf16(b3, a0, acc03, 0, 0, 0);
      acc10 = __builtin_amdgcn_mfma_f32_32x32x16_bf16(b0, a1, acc10, 0, 0, 0);
      acc11 = __builtin_amdgcn_mfma_f32_32x32x16_bf16(b1, a1, acc11, 0, 0, 0);
      acc12 = __builtin_amdgcn_mfma_f32_32x32x16_bf16(b2, a1, acc12, 0, 0, 0);
      acc13 = __builtin_amdgcn_mfma_f32_32x32x16_bf16(b3, a1, acc13, 0, 0, 0);
    }
    if (kt + 1 < KT) LWRITE((kt + 1) & 1);
    __syncthreads();
  }
#undef GLOAD
#undef LWRITE
  const int mw = m0 + wm * 64 + r32, nw = n0 + wn * 128;
  epi(acc00, acc01, acc02, acc03, mw, nw, hi);
  epi(acc10, acc11, acc12, acc13, mw + 32, nw, hi);
}
DEVI u32x2 pk4(float a, float b, float c, float d) { u32x2 r = {cvtpk(a, b), cvtpk(c, d)}; return r; }

constexpr float ATT_SCALE = 0.125f;
constexpr float ATT_THR = 8.f;
constexpr int SHM_V = 64 * 128 * 2, SHM_K = 64 * 128 * 2;
#define KSWZ(row, colB) ((row) * 256 + ((colB) ^ (((row) & 7) << 4)))
#define SBAR() __builtin_amdgcn_sched_barrier(0)
DEVI void partialSM(f32x16& p0, f32x16& p1, float& m_reg, float& mn, float& alpha) {
  constexpr float C = ATT_SCALE * 1.4426950408889634f;
  float pmax = p0[0];
#pragma unroll
  for (int r = 1; r < 16; ++r) pmax = fmaxf(pmax, p0[r]);
#pragma unroll
  for (int r = 0; r < 16; ++r) pmax = fmaxf(pmax, p1[r]);
  { auto rr = __builtin_amdgcn_permlane32_swap(__float_as_uint(pmax), __float_as_uint(pmax), false, false);
    pmax = fmaxf(__uint_as_float(rr[0]), __uint_as_float(rr[1])); }
  if (__builtin_expect(__all(pmax - m_reg <= ATT_THR / ATT_SCALE), 1)) { mn = m_reg; alpha = 1.f; }
  else { mn = fmaxf(m_reg, pmax); alpha = __builtin_amdgcn_exp2f((m_reg - mn) * C); m_reg = mn; }
  const float mnC = -mn * C;
#pragma unroll
  for (int r = 0; r < 16; ++r) p0[r] = __builtin_amdgcn_exp2f(fmaf(p0[r], C, mnC));
#pragma unroll
  for (int r = 0; r < 16; ++r) p1[r] = __builtin_amdgcn_exp2f(fmaf(p1[r], C, mnC));
}
DEVI void finishSM(f32x16& p0, f32x16& p1, float alpha, float& l_reg, bf16x8& pa0, bf16x8& pa1, bf16x8& pa2, bf16x8& pa3) {
  float ps = 0;
#pragma unroll
  for (int r = 0; r < 16; ++r) ps += p0[r];
#pragma unroll
  for (int r = 0; r < 16; ++r) ps += p1[r];
  { auto rr = __builtin_amdgcn_permlane32_swap(__float_as_uint(ps), __float_as_uint(ps), false, false);
    ps = __uint_as_float(rr[0]) + __uint_as_float(rr[1]); }
  l_reg = l_reg * alpha + ps;
#define PK4(P, BASE, OUT) do { unsigned a0 = cvtpk(P[BASE + 0], P[BASE + 1]), a1 = cvtpk(P[BASE + 2], P[BASE + 3]);   \
    unsigned b0 = cvtpk(P[BASE + 4], P[BASE + 5]), b1 = cvtpk(P[BASE + 6], P[BASE + 7]);                              \
    auto r0 = __builtin_amdgcn_permlane32_swap(a0, b0, false, false); auto r1 = __builtin_amdgcn_permlane32_swap(a1, b1, false, false); \
    u32x4 w = {r0[0], r1[0], r0[1], r1[1]}; OUT = *reinterpret_cast<bf16x8*>(&w); } while (0)
  PK4(p0, 0, pa0); PK4(p0, 8, pa1); PK4(p1, 0, pa2); PK4(p1, 8, pa3);
#undef PK4
}
DEVI int v_st(int k, int c) { const int kk = (k & ~0xC) | ((k & 4) << 1) | ((k & 8) >> 1); return ((kk >> 3) * 4 + (c >> 5)) * 512 + ((kk & 7) * 32 + (c & 31)) * 2; }
DEVI int v_rd_base(int lane) { return ((lane & 3) << 3) | (((lane >> 2) & 3) << 6) | (((lane >> 4) & 1) << 5) | (((lane >> 5) & 1) << 8); }
constexpr int v_rd_off(int d0, int ks, int half) { return d0 * 512 + ks * 4096 + half * 2048; }
template <int OFF> DEVI s16x4 tr_read(int vb) {
  s16x4 r; asm volatile("ds_read_b64_tr_b16 %0, %1 offset:%2" : "=&v"(r) : "v"(vb), "i"(OFF) : "memory"); return r;
}
template <int D0> DEVI void pv_one(f32x16& od, int vb, bf16x8 pa0, bf16x8 pa1, bf16x8 pa2, bf16x8 pa3) {
  const s16x4 l0 = tr_read<v_rd_off(D0, 0, 0)>(vb), h0 = tr_read<v_rd_off(D0, 0, 1)>(vb), l1 = tr_read<v_rd_off(D0, 1, 0)>(vb), h1 = tr_read<v_rd_off(D0, 1, 1)>(vb);
  const s16x4 l2 = tr_read<v_rd_off(D0, 2, 0)>(vb), h2 = tr_read<v_rd_off(D0, 2, 1)>(vb), l3 = tr_read<v_rd_off(D0, 3, 0)>(vb), h3 = tr_read<v_rd_off(D0, 3, 1)>(vb);
  asm volatile("s_waitcnt lgkmcnt(0)" ::: "memory"); SBAR();
#define PK(L, H) (bf16x8){L[0], L[1], L[2], L[3], H[0], H[1], H[2], H[3]}
  od = __builtin_amdgcn_mfma_f32_32x32x16_bf16(pa0, PK(l0, h0), od, 0, 0, 0);
  od = __builtin_amdgcn_mfma_f32_32x32x16_bf16(pa1, PK(l1, h1), od, 0, 0, 0);
  od = __builtin_amdgcn_mfma_f32_32x32x16_bf16(pa2, PK(l2, h2), od, 0, 0, 0);
  od = __builtin_amdgcn_mfma_f32_32x32x16_bf16(pa3, PK(l3, h3), od, 0, 0, 0);
#undef PK
}
DEVI void pv_d0(f32x16* o, int vb, bf16x8 pa0, bf16x8 pa1, bf16x8 pa2, bf16x8 pa3) {
  pv_one<0>(o[0], vb, pa0, pa1, pa2, pa3); pv_one<1>(o[1], vb, pa0, pa1, pa2, pa3); pv_one<2>(o[2], vb, pa0, pa1, pa2, pa3); pv_one<3>(o[3], vb, pa0, pa1, pa2, pa3);
}

DEVI void attn_item(bf16* __restrict__ PJ, int b, int h, int qb, float lam, float one_m_li, const float* __restrict__ subw, char* lds, bool do_store = true) {
  const int tid = tid_opaque(), wid = tid >> 6, lane = tid & 63, r32 = lane & 31, hi = lane >> 5;
  const int cmp = wid & 1, wq = wid >> 1;
  char* V_lds = lds; char* K_lds = lds + 2 * SHM_V;
  float* wsl = (float*)(lds + 2 * SHM_V + 2 * SHM_K) + wid * 64; float* li_l = wsl; float* al_l = wsl + 32;
  const size_t rowQ = (size_t)b * SEQ + (size_t)qb * 128 + wq * 32;
  const bf16* Kh = PJ + (size_t)b * SEQ * LDP + 512 + h * 128;
  float m1 = -1e30f, l1 = 0; f32x16 o1[4] = {}; bf16x8 qr[4];
  { const bf16* Qw = PJ + (rowQ + r32) * LDP + h * 128 + cmp * 64 + hi * 8;
#pragma unroll
    for (int d0 = 0; d0 < 4; ++d0) qr[d0] = *(const bf16x8*)(Qw + d0 * 16); }
  const int sr = tid >> 4, sc = (tid & 15) * 8, vst0 = v_st(sr, sc), vst1 = v_st(32 + sr, sc);
  const int vb0 = (int)(uintptr_t)V_lds + v_rd_base(lane);
  int kof0[4], kof1[4];
#pragma unroll
  for (int d0 = 0; d0 < 4; ++d0) { const int cb = ((cmp * 4 + d0) * 16 + hi * 8) * 2; kof0[d0] = KSWZ(r32, cb); kof1[d0] = KSWZ(32 + r32, cb); }
  bf16x8 vs0, vs1, ks0, ks1;
  const bf16* kpA = Kh + (size_t)sr * LDP + sc; const bf16* kpB = kpA + (size_t)32 * LDP;
  asm volatile("" : "+v"(kpA), "+v"(kpB));
#define SLOAD() do { vs0 = *(const bf16x8*)(kpA + 512); vs1 = *(const bf16x8*)(kpB + 512); ks0 = *(const bf16x8*)(kpA); ks1 = *(const bf16x8*)(kpB); \
    kpA += (size_t)64 * LDP; kpB += (size_t)64 * LDP; } while (0)
#define SWRITE(bb) do { *(bf16x8*)(V_lds + (bb) * SHM_V + vst0) = vs0; *(bf16x8*)(V_lds + (bb) * SHM_V + vst1) = vs1; const int kc = sc * 2; \
    *(bf16x8*)(K_lds + (bb) * SHM_K + KSWZ(sr, kc)) = ks0; *(bf16x8*)(K_lds + (bb) * SHM_K + KSWZ(32 + sr, kc)) = ks1; } while (0)
#define RESC(a, o) do { if (__any((a) < 1.f)) { if (hi == 0) al_l[r32] = (a); asm volatile("s_waitcnt lgkmcnt(0)" ::: "memory"); \
    _Pragma("unroll") for (int d = 0; d < 4; ++d) _Pragma("unroll") for (int r = 0; r < 16; ++r) o[d][r] *= al_l[crow(r, hi)]; } } while (0)
  constexpr int NT = SEQ / 64;
  SLOAD(); SWRITE(0); __syncthreads();
  for (int j = 0; j < NT; ++j) {
    if (j + 1 < NT) SLOAD();
    const char* Kb = K_lds + (j & 1) * SHM_K; const int vb = vb0 + (j & 1) * SHM_V;
    f32x16 p0 = {}, p1 = {}; float mn, al; bf16x8 pa0, pa1, pa2, pa3;
#pragma unroll
    for (int d0 = 0; d0 < 4; ++d0) {
      const bf16x8 b0 = *reinterpret_cast<const bf16x8*>(Kb + kof0[d0]);
      const bf16x8 b1 = *reinterpret_cast<const bf16x8*>(Kb + kof1[d0]);
      p0 = __builtin_amdgcn_mfma_f32_32x32x16_bf16(b0, qr[d0], p0, 0, 0, 0);
      p1 = __builtin_amdgcn_mfma_f32_32x32x16_bf16(b1, qr[d0], p1, 0, 0, 0);
    }
    partialSM(p0, p1, m1, mn, al);
    RESC(al, o1);
    finishSM(p0, p1, al, l1, pa0, pa1, pa2, pa3); SBAR();
    pv_d0(o1, vb, pa0, pa1, pa2, pa3);
    if (j + 1 < NT) SWRITE((j + 1) & 1);
    __syncthreads();
  }
#undef SLOAD
#undef SWRITE
#undef RESC
  if (hi == 0) li_l[r32] = (cmp ? lam : 1.f) / l1;
  asm volatile("s_waitcnt lgkmcnt(0)" ::: "memory");
#pragma unroll
  for (int r = 0; r < 16; ++r) { const float c1 = li_l[crow(r, hi)];
#pragma unroll
    for (int d = 0; d < 4; ++d) o1[d][r] *= c1; }
  float* X = (float*)lds + wq * 4096 + lane;
  if (cmp == 1) {
#pragma unroll
    for (int d = 0; d < 4; ++d)
#pragma unroll
      for (int r = 0; r < 16; ++r) X[(d * 16 + r) * 64] = o1[d][r];
  }
  __syncthreads();
  if (cmp == 0 && do_store) {
    float sw[4];
#pragma unroll
    for (int d = 0; d < 4; ++d) sw[d] = subw[d * 32 + r32] * one_m_li;
    bf16* Ow = PJ + (rowQ + 4 * hi) * LDP + h * 128 + r32;
#pragma unroll
    for (int r = 0; r < 16; ++r) {
      float s = 0;
#pragma unroll
      for (int d = 0; d < 4; ++d) { const float v = o1[d][r] - X[(d * 16 + r) * 64]; o1[d][r] = v; s += v * v; }
      s = red16(s); s += __shfl_xor(s, 16);
      const float rs = rsqrtf(s * (1.f / 128.f) + 1e-5f);
      bf16* orp = Ow + (size_t)((r & 3) + 8 * (r >> 2)) * LDP; asm volatile("" : "+v"(orp));
#pragma unroll
      for (int d = 0; d < 4; ++d) *(unsigned short*)&orp[d * 32] = f2bf(o1[d][r] * rs * sw[d]);
    }
  }
  __syncthreads();
}

DEVI void shiftmix8(const bf16* __restrict__ PJ, size_t R, int pos, int col, const float* __restrict__ mu, float* z) {
  float zc[8], zp[8], zn[8];
  unpack8(*(const u32x4*)&PJ[R * LDP + col], zc);
  if (pos > 0) unpack8(*(const u32x4*)&PJ[(R - 1) * LDP + col], zp); else { for (int j = 0; j < 8; ++j) zp[j] = 0.f; }
  if (pos < SEQ - 1) unpack8(*(const u32x4*)&PJ[(R + 1) * LDP + col], zn); else { for (int j = 0; j < 8; ++j) zn[j] = 0.f; }
#pragma unroll
  for (int j = 0; j < 8; ++j) z[j] = zc[j] + mu[j] * (0.5f * (zp[j] + zn[j]) - zc[j]);
}
DEVI void phase_zl(const Params& p, int l) {
  const bf16* PJ = (const bf16*)(WSV(p) + OFF_U); bf16* ZL = (bf16*)(WSV(p) + OFF_ZL);
  const float* mu = p.tshift_mu + (size_t)l * 1920 + 1536;
  for (int idx = blockIdx.x * NTHR + tid_opaque(); idx < NTOK * 48; idx += gridDim.x * NTHR) {
    const int R = idx / 48, ch = idx % 48, j0 = ch * 8, pos = R & (SEQ - 1);
    float m8[8], z[8];
#pragma unroll
    for (int j = 0; j < 8; ++j) m8[j] = mu[j0 + j];
    shiftmix8(PJ, R, pos, 3072 + j0, m8, z);
    if (j0 < 128) { for (int j = 0; j < 8; ++j) z[j] = tanhf(z[j]); }
    else if (j0 >= 256) { for (int j = 0; j < 8; ++j) z[j] = sigmoidf_(z[j]); }
    *(u32x4*)&ZL[(size_t)R * 384 + j0] = pack8(z);
  }
}

constexpr int SC_T = 16;
constexpr int SC_DIR = 5 * SC_T * 64 + SC_T * 8;
constexpr int SC_BUF = 2 * SC_DIR;
constexpr int SC_SY = 2 * SC_BUF;
struct ScRaw { u32x2 c0, c1, c2, p0, p1, p2, n0, n1, n2, au, om; };
#define SC_BAR() asm volatile("s_waitcnt lgkmcnt(0)\n\ts_barrier" ::: "memory")
DEVI void phase_scan(const Params& p, int l, char* lds) {
  const bf16* PJ = (const bf16*)(WSV(p) + OFF_U);
  const bf16* Aa = (const bf16*)(WSV(p) + OFF_A);
  const _Float16* OM = (const _Float16*)(WSV(p) + OFF_OMW);
  _Float16* YH = (_Float16*)(WSV(p) + OFF_H);
  float* L = (float*)lds;
  const int tid = tid_opaque(), wid = tid >> 6, lane = tid & 63, l16 = lane & 15;
  const bool producer = wid >= 4;
  const int stid = tid & 255;
  const int wdir = (wid >> 1) & 1, rowl = (wid & 1) * 4 + (lane >> 4);
  const int si = stid >> 4, sn = (stid & 15) * 4;
  constexpr int NCH = SEQ / SC_T;
  for (int it = blockIdx.x; it < 256; it += gridDim.x) {
    const int q8 = it & 7, h = (it >> 3) & 7, b = it >> 6;
    const int cbase = h * 64 + sn;
    float mur[4], muk[4], muv[4], kk4[4], ka4[4];
#pragma unroll
    for (int j = 0; j < 4; ++j) {
      mur[j] = p.tshift_mu[l * 1920 + cbase + j]; muk[j] = p.tshift_mu[l * 1920 + 512 + cbase + j]; muv[j] = p.tshift_mu[l * 1920 + 1024 + cbase + j];
      kk4[j] = p.k_k[l * 512 + cbase + j]; ka4[j] = p.k_a[l * 512 + cbase + j];
    }
    float S0 = 0.f, S1 = 0.f, S2 = 0.f, S3 = 0.f;
    ScRaw xa0, xb0, xa1, xb1;
#define SC_LOAD(chk_, d_, RW) do { const int s = (chk_) * SC_T + si; const int pos = (d_) ? (SEQ - 1 - s) : s; const size_t R = (size_t)b * SEQ + pos; \
      const bf16* base = PJ + R * LDP + 1536 + cbase; const u32x2 z2 = {0u, 0u}; \
      RW.c0 = *(const u32x2*)(base); RW.c1 = *(const u32x2*)(base + 512); RW.c2 = *(const u32x2*)(base + 1024); \
      RW.p0 = z2; RW.p1 = z2; RW.p2 = z2; RW.n0 = z2; RW.n1 = z2; RW.n2 = z2; \
      if (pos > 0) { RW.p0 = *(const u32x2*)(base - LDP); RW.p1 = *(const u32x2*)(base - LDP + 512); RW.p2 = *(const u32x2*)(base - LDP + 1024); } \
      if (pos < SEQ - 1) { RW.n0 = *(const u32x2*)(base + LDP); RW.n1 = *(const u32x2*)(base + LDP + 512); RW.n2 = *(const u32x2*)(base + LDP + 1024); } \
      RW.au = *(const u32x2*)&Aa[(R * 2 + (d_)) * 512 + cbase]; RW.om = *(const u32x2*)&OM[(R * 2 + (d_)) * 512 + cbase]; } while (0)
#define SC_MIX(dst, c, pp, nn, mu) do { float zc_[4] = {bflo(c[0]), bfhi(c[0]), bflo(c[1]), bfhi(c[1])}; float zp_[4] = {bflo(pp[0]), bfhi(pp[0]), bflo(pp[1]), bfhi(pp[1])}; \
    float zn_[4] = {bflo(nn[0]), bfhi(nn[0]), bflo(nn[1]), bfhi(nn[1])}; _Pragma("unroll") for (int j = 0; j < 4; ++j) dst[j] = zc_[j] + mu[j] * (0.5f * (zp_[j] + zn_[j]) - zc_[j]); } while (0)
#define SC_PROC(buf_, d_, RW) do { float* sd = L + (buf_) * SC_BUF + (d_) * SC_DIR; float rc[4], kc[4], vc[4]; \
      SC_MIX(rc, RW.c0, RW.p0, RW.n0, mur); SC_MIX(kc, RW.c1, RW.p1, RW.n1, muk); SC_MIX(vc, RW.c2, RW.p2, RW.n2, muv); \
      const float a4[4] = {bflo(RW.au[0]), bfhi(RW.au[0]), bflo(RW.au[1]), bfhi(RW.au[1])}; \
      typedef _Float16 h4 __attribute__((ext_vector_type(4))); const h4 om = __builtin_bit_cast(h4, RW.om); \
      float kq[4], ssq = 0.f; \
      _Pragma("unroll") for (int j = 0; j < 4; ++j) { kq[j] = kc[j] * kk4[j]; ssq += kq[j] * kq[j]; } \
      ssq = red16(ssq); \
      const float inv = 1.f / fmaxf(sqrtf(ssq), 1e-12f); \
      f32x4 w4, k4, b4, kd4, r4; \
      _Pragma("unroll") for (int j = 0; j < 4; ++j) { const float kap = kq[j] * inv; \
        w4[j] = 1.f - (float)om[j]; k4[j] = kap; b4[j] = kap * a4[j]; kd4[j] = kc[j] * (1.f + (a4[j] - 1.f) * ka4[j]); r4[j] = rc[j]; } \
      const int o = si * 64 + sn; \
      *(f32x4*)&sd[o] = w4; *(f32x4*)&sd[SC_T * 64 + o] = k4; *(f32x4*)&sd[2 * SC_T * 64 + o] = b4; \
      *(f32x4*)&sd[3 * SC_T * 64 + o] = kd4; *(f32x4*)&sd[4 * SC_T * 64 + o] = r4; \
      if ((sn >> 3) == q8) { f32x4 v4 = {vc[0], vc[1], vc[2], vc[3]}; *(f32x4*)&sd[5 * SC_T * 64 + si * 8 + (sn & 7)] = v4; } } while (0)
#define SC_WRITEOUT(chk_) do { const int e = stid >> 7, u = stid & 127, i = u >> 3, rl = u & 7; const float* sy = L + SC_SY + ((chk_) & 1) * (2 * SC_T * 8) + e * (SC_T * 8); \
      const int s = (chk_) * SC_T + i; const int pos = e ? (SEQ - 1 - s) : s; \
      YH[((size_t)e * NTOK + (size_t)b * SEQ + pos) * 512 + h * 64 + q8 * 8 + rl] = (_Float16)(sy[i * 8 + rl] * 0.0625f); } while (0)
    if (producer) {
      SC_LOAD(0, 0, xa0); SC_LOAD(0, 1, xb0); SC_PROC(0, 0, xa0); SC_PROC(0, 1, xb0);
      SC_LOAD(1, 0, xa0); SC_LOAD(1, 1, xb0); SC_LOAD(2, 0, xa1); SC_LOAD(2, 1, xb1);
      SC_BAR();
#pragma unroll 1
      for (int chk = 0; chk < NCH; chk += 2) {
        if (chk + 1 < NCH) { SC_PROC(1, 0, xa0); SC_PROC(1, 1, xb0); }
        if (chk + 3 < NCH) { SC_LOAD(chk + 3, 0, xa0); SC_LOAD(chk + 3, 1, xb0); }
        if (chk > 0) SC_WRITEOUT(chk - 1);
        SC_BAR();
        if (chk + 2 < NCH) { SC_PROC(0, 0, xa1); SC_PROC(0, 1, xb1); }
        if (chk + 4 < NCH) { SC_LOAD(chk + 4, 0, xa1); SC_LOAD(chk + 4, 1, xb1); }
        SC_WRITEOUT(chk);
        SC_BAR();
      }
      SC_WRITEOUT(NCH - 1);
    } else {
      SC_BAR();
      __builtin_amdgcn_s_setprio(3);
#pragma unroll 1
      for (int chk = 0; chk < NCH; ++chk) {
        const float* cw = L + (chk & 1) * SC_BUF + wdir * SC_DIR;
        float* sy = L + SC_SY + (chk & 1) * (2 * SC_T * 8) + wdir * (SC_T * 8);
        const float* cl = cw + l16 * 4; const float* cv = cw + 5 * SC_T * 64 + rowl;
        f32x4 w4 = *(const f32x4*)&cl[0], k4 = *(const f32x4*)&cl[SC_T * 64], b4 = *(const f32x4*)&cl[2 * SC_T * 64],
              kd4 = *(const f32x4*)&cl[3 * SC_T * 64], r4 = *(const f32x4*)&cl[4 * SC_T * 64];
        float vv = cv[0], ykeep = 0.f;
#pragma unroll 4
        for (int i = 0; i < SC_T; ++i) {
          f32x4 w4n = w4, k4n = k4, b4n = b4, kd4n = kd4, r4n = r4; float vvn = vv;
          if (i + 1 < SC_T) {
            const int o = (i + 1) * 64;
            w4n = *(const f32x4*)&cl[o]; k4n = *(const f32x4*)&cl[SC_T * 64 + o]; b4n = *(const f32x4*)&cl[2 * SC_T * 64 + o];
            kd4n = *(const f32x4*)&cl[3 * SC_T * 64 + o]; r4n = *(const f32x4*)&cl[4 * SC_T * 64 + o]; vvn = cv[(i + 1) * 8];
          }
          float sa = S0 * k4[0] + S1 * k4[1] + S2 * k4[2] + S3 * k4[3];
          sa = red16(sa);
          S0 = S0 * w4[0] + (vv * kd4[0] - sa * b4[0]);
          S1 = S1 * w4[1] + (vv * kd4[1] - sa * b4[1]);
          S2 = S2 * w4[2] + (vv * kd4[2] - sa * b4[2]);
          S3 = S3 * w4[3] + (vv * kd4[3] - sa * b4[3]);
          float y = S0 * r4[0] + S1 * r4[1] + S2 * r4[2] + S3 * r4[3];
          y = red16(y);
          ykeep = (l16 == i) ? y : ykeep;
          w4 = w4n; k4 = k4n; b4 = b4n; kd4 = kd4n; r4 = r4n; vv = vvn;
          __builtin_amdgcn_sched_barrier(0);
        }
        sy[l16 * 8 + rowl] = ykeep;
        SC_BAR();
      }
      __builtin_amdgcn_s_setprio(0);
    }
    __syncthreads();
#undef SC_LOAD
#undef SC_PROC
#undef SC_MIX
#undef SC_WRITEOUT
  }
}

DEVI void phase_post(const Params& p, int l) {
  bf16* PJ = (bf16*)(WSV(p) + OFF_U);
  const bf16* Aa = (const bf16*)(WSV(p) + OFF_A);
  const bf16* G = (const bf16*)(WSV(p) + OFF_G);
  const _Float16* YH = (const _Float16*)(WSV(p) + OFF_H);
  const int tid = tid_opaque(), wid = tid >> 6, lane = tid & 63, c0 = lane * 8;
  float mur[8], muk[8], muv[8], ka[8], rk[8], lw[8], lb[8];
#pragma unroll
  for (int j = 0; j < 8; ++j) {
    mur[j] = p.tshift_mu[l * 1920 + c0 + j]; muk[j] = p.tshift_mu[l * 1920 + 512 + c0 + j]; muv[j] = p.tshift_mu[l * 1920 + 1024 + c0 + j];
    ka[j] = p.k_a[l * 512 + c0 + j]; rk[j] = p.r_k[l * 512 + c0 + j]; lw[j] = p.lnx_w[l * 512 + c0 + j]; lb[j] = p.lnx_b[l * 512 + c0 + j];
  }
  for (int R = blockIdx.x * 8 + wid; R < NTOK; R += gridDim.x * 8) {
    const int pos = R & (SEQ - 1);
    float y[8];
    { typedef _Float16 h8 __attribute__((ext_vector_type(8)));
      const h8 yf = *(const h8*)&YH[(size_t)R * 512 + c0], yb = *(const h8*)&YH[((size_t)NTOK + R) * 512 + c0];
#pragma unroll
      for (int j = 0; j < 8; ++j) y[j] = ((float)yf[j] + (float)yb[j]) * 16.f; }
    float s1 = 0;
#pragma unroll
    for (int j = 0; j < 8; ++j) s1 += y[j];
    const float mean = red8(s1) * (1.f / 64.f);
    float s2 = 0;
#pragma unroll
    for (int j = 0; j < 8; ++j) { y[j] -= mean; s2 += y[j] * y[j]; }
    const float rstd = rsqrtf(red8(s2) * (1.f / 64.f) + 64e-5f);
    float rr[8], kk[8], vv[8], a0[8], a1[8], g8[8];
    shiftmix8(PJ, R, pos, 1536 + c0, mur, rr);
    shiftmix8(PJ, R, pos, 2048 + c0, muk, kk);
    shiftmix8(PJ, R, pos, 2560 + c0, muv, vv);
    unpack8(*(const u32x4*)&Aa[((size_t)R * 2 + 0) * 512 + c0], a0);
    unpack8(*(const u32x4*)&Aa[((size_t)R * 2 + 1) * 512 + c0], a1);
    unpack8(*(const u32x4*)&G[(size_t)R * 512 + c0], g8);
#ifdef NAIVE_G
    { const bf16* ZLp = (const bf16*)(WSV(p) + OFF_ZL) + (size_t)R * 384 + 256; const float* g2 = p.gate_g2 + (size_t)l * 128 * 512 + c0;
      for (int j = 0; j < 8; ++j) g8[j] = 0.f;
      for (int k = 0; k < 128; ++k) { const float sv = bf2f(*(const unsigned short*)&ZLp[k]);
        for (int j = 0; j < 8; ++j) g8[j] += sv * g2[(size_t)k * 512 + j]; } }
#endif
#ifdef NAIVE_G2T
    { const bf16* ZLp = (const bf16*)(WSV(p) + OFF_ZL) + (size_t)R * 384 + 256; const bf16* g2t = (const bf16*)(WSV(p) + OFF_G2T) + (size_t)c0 * 128;
      for (int j = 0; j < 8; ++j) g8[j] = 0.f;
      for (int k = 0; k < 128; ++k) { const float sv = bf2f(*(const unsigned short*)&ZLp[k]);
        for (int j = 0; j < 8; ++j) g8[j] += sv * bf2f(*(const unsigned short*)&g2t[(size_t)j * 128 + k]); } }
#endif
#define FIN(x) (fabsf(x) < 1e30f)
#ifdef IGN_Y
    for (int j = 0; j < 8; ++j) y[j] = 0.01f * j;
#endif
#ifdef IGN_A
    for (int j = 0; j < 8; ++j) { a0[j] = 0.5f; a1[j] = 0.5f; }
#endif
#ifdef IGN_G
    for (int j = 0; j < 8; ++j) { g8[j] = 1.f; }
#endif
#ifdef IGN_RKV
    for (int j = 0; j < 8; ++j) { rr[j] = 0.1f; kk[j] = 0.1f; vv[j] = 0.1f; }
#endif
#ifdef SAN_Y
    for (int j = 0; j < 8; ++j) if (!FIN(y[j])) y[j] = 0.f;
#endif
#ifdef SAN_A
    for (int j = 0; j < 8; ++j) { if (!FIN(a0[j])) a0[j] = 0.f; if (!FIN(a1[j])) a1[j] = 0.f; }
#endif
#ifdef SAN_G
    for (int j = 0; j < 8; ++j) if (!FIN(g8[j])) g8[j] = 0.f;
#endif
#ifdef SAN_RKV
    for (int j = 0; j < 8; ++j) { if (!FIN(rr[j])) rr[j] = 0.f; if (!FIN(kk[j])) kk[j] = 0.f; if (!FIN(vv[j])) vv[j] = 0.f; }
#endif
    float bs = 0;
#pragma unroll
    for (int j = 0; j < 8; ++j) {
      const float kds = kk[j] * ((1.f + (a0[j] - 1.f) * ka[j]) + (1.f + (a1[j] - 1.f) * ka[j]));
      bs += rr[j] * kds * rk[j];
    }
    bs = red8(bs);
    float o[8];
#pragma unroll
    for (int j = 0; j < 8; ++j) o[j] = (y[j] * rstd * lw[j] + lb[j] + bs * vv[j]) * g8[j];
    *(u32x4*)&PJ[(size_t)R * LDP + 512 + c0] = pack8(o);
  }
}

#define WT_IN ((bf16*)(WSV(p) + OFF_WT_IN))
#define WT_OUT ((bf16*)(WSV(p) + OFF_WT_OUT))
#define WT_UP ((bf16*)(WSV(p) + OFF_WT_UP))
#define WT_DOWN ((bf16*)(WSV(p) + OFF_WT_DOWN))
#define W2T ((bf16*)(WSV(p) + OFF_W2T))
#define A2T ((bf16*)(WSV(p) + OFF_A2T))
#define G2T ((bf16*)(WSV(p) + OFF_G2T))
#define PJ ((bf16*)(WSV(p) + OFF_U))
#define U PJ
#define ZL ((bf16*)(WSV(p) + OFF_ZL))
#define H ((bf16*)(WSV(p) + OFF_H))
#define OMW ((_Float16*)(WSV(p) + OFF_OMW))
#define AA ((bf16*)(WSV(p) + OFF_A))
#define GG ((bf16*)(WSV(p) + OFF_G))
#define MODP ((const float*)(WSV(p) + OFF_MOD))
#define cosT ((const float*)(WSV(p) + OFF_COS))
#define sinT ((const float*)(WSV(p) + OFF_SIN))
__global__ void __launch_bounds__(NTHR) fwd_megakernel(Params p) {
  extern __shared__ __attribute__((aligned(16))) char lds[];
  cg::grid_group grid = cg::this_grid();
  const int nb = gridDim.x, bid = blockIdx.x;
  unsigned* gbar = (unsigned*)(p.ws + OFF_BAR); unsigned gtarget = 0;
  grid.sync();
  phase_mod(p, lds);
  phase_rope(p);
  phase_conv(p, 0, lds);
  GSYNC();

  for (int l = 0; l < 2; ++l) {
    const float* xin = (l == 0) ? p.x : p.out;
    const float* modl = MODP + (size_t)l * 4 * 6144; asm volatile("" : "+v"(modl));
    if (l > 0) phase_conv(p, l, lds);
    phase_norm(xin, p.norm1 + l * DM, modl, 0, 1024, H);
    GSYNC();
#ifdef REP_G1
    for (int rep = 0; rep < 2; ++rep)
#endif
    for (int it = bid; it < 128 * 14; it += nb) {
      const int mt = it / 14, nt = it % 14;
      gemm_tile(H, DM, WT_IN, DM, DM, mt * 256, nt * 256, lds,
        [&](f32x16& c0, f32x16& c1, f32x16& c2, f32x16& c3, int m, int nw, int hi) {
          if (nw >= LDP) return;
          bf16* dst = PJ + (size_t)m * LDP + nw + 4 * hi;
          if (nw < 1024) {
            const int pos = m & (SEQ - 1);
            const float* ct = cosT + pos * 32 + 4 * hi; const float* st = sinT + pos * 32 + 4 * hi;
#pragma unroll
            for (int g = 0; g < 4; ++g) {
              const f32x4 cs = *(const f32x4*)(ct + 8 * g), sn = *(const f32x4*)(st + 8 * g);
              *(u32x2*)(dst + 8 * g) = pk4(c0[4 * g] * cs[0] - c1[4 * g] * sn[0], c0[4 * g + 1] * cs[1] - c1[4 * g + 1] * sn[1],
                                           c0[4 * g + 2] * cs[2] - c1[4 * g + 2] * sn[2], c0[4 * g + 3] * cs[3] - c1[4 * g + 3] * sn[3]);
              *(u32x2*)(dst + 32 + 8 * g) = pk4(c0[4 * g] * sn[0] + c1[4 * g] * cs[0], c0[4 * g + 1] * sn[1] + c1[4 * g + 1] * cs[1],
                                                c0[4 * g + 2] * sn[2] + c1[4 * g + 2] * cs[2], c0[4 * g + 3] * sn[3] + c1[4 * g + 3] * cs[3]);
              *(u32x2*)(dst + 64 + 8 * g) = pk4(c2[4 * g] * cs[0] - c3[4 * g] * sn[0], c2[4 * g + 1] * cs[1] - c3[4 * g + 1] * sn[1],
                                                c2[4 * g + 2] * cs[2] - c3[4 * g + 2] * sn[2], c2[4 * g + 3] * cs[3] - c3[4 * g + 3] * sn[3]);
              *(u32x2*)(dst + 96 + 8 * g) = pk4(c2[4 * g] * sn[0] + c3[4 * g] * cs[0], c2[4 * g + 1] * sn[1] + c3[4 * g + 1] * cs[1],
                                                c2[4 * g + 2] * sn[2] + c3[4 * g + 2] * cs[2], c2[4 * g + 3] * sn[3] + c3[4 * g + 3] * cs[3]);
            }
          } else {
#pragma unroll
            for (int g = 0; g < 4; ++g) {
              *(u32x2*)(dst + 8 * g) = pk4(c0[4 * g], c0[4 * g + 1], c0[4 * g + 2], c0[4 * g + 3]);
              *(u32x2*)(dst + 32 + 8 * g) = pk4(c1[4 * g], c1[4 * g + 1], c1[4 * g + 2], c1[4 * g + 3]);
              *(u32x2*)(dst + 64 + 8 * g) = pk4(c2[4 * g], c2[4 * g + 1], c2[4 * g + 2], c2[4 * g + 3]);
              *(u32x2*)(dst + 96 + 8 * g) = pk4(c3[4 * g], c3[4 * g + 1], c3[4 * g + 2], c3[4 * g + 3]);
            }
          }
        });
    }
    GSYNC();
    phase_zl(p, l);
    {
      float s1 = 0, s2 = 0;
      for (int i = 0; i < 64; ++i) { s1 += p.lam_q1[l * 64 + i] * p.lam_k1[l * 64 + i]; s2 += p.lam_q2[l * 64 + i] * p.lam_k2[l * 64 + i]; }
      const float lam_init = 0.8f - 0.6f * expf(-0.3f * (float)l);
      const float lam = expf(s1) - expf(s2) + lam_init;
#ifndef SKIP_ATT
#ifdef REP_ATT
      for (int rep = 0; rep < 2; ++rep) {
      const bool dst_ = rep == 1;
#else
      { const bool dst_ = true;
#endif
      if (nb == 256) {
        const int xcd = bid & 7, jj = bid >> 3;
#pragma unroll 1
        for (int i4 = 0; i4 < 4; ++i4) {
          {
            const int bh = xcd + 8 * (i4 >> 1), qb = jj + 32 * (i4 & 1);
            attn_item(PJ, bh >> 2, bh & 3, qb, lam, 1.f - lam_init, p.subln_w + l * 128, lds, dst_);
          }
        }
      } else {
#pragma unroll 1
        for (int it = bid; it < 1024; it += nb) attn_item(PJ, it >> 8, (it >> 6) & 3, it & 63, lam, 1.f - lam_init, p.subln_w + l * 128, lds, dst_);
      }
      }
#endif
    }
    GSYNC();
    for (int it = bid; it < 5 * 256; it += nb) {
      const int g = it / 256, t = it % 256, mt = t >> 1, nt = t & 1, d = g & 1;
      const bf16* Ap; const bf16* Bp; int ldb, KK;
      if (g < 2) { Ap = ZL + d * 64; Bp = W2T + d * 512 * 64; ldb = 64; KK = 64; }
      else if (g < 4) { Ap = ZL + 128 + d * 64; Bp = A2T + d * 512 * 64; ldb = 64; KK = 64; }
      else { Ap = ZL + 256; Bp = G2T; ldb = 128; KK = 128; }
      const float* w0 = p.decay_w0 + (size_t)(l * 2 + d) * 512; const float* a0 = p.icl_a0 + (size_t)(l * 2 + d) * 512;
      gemm_tile(Ap, 384, Bp, ldb, KK, mt * 256, nt * 256, lds,
        [&](f32x16& c0, f32x16& c1, f32x16& c2, f32x16& c3, int m, int nw, int hi) {
          auto tile_ = [&](const f32x16& c, const int j) {
#pragma unroll
            for (int gq = 0; gq < 4; ++gq) {
              const int col = nw + 32 * j + 8 * gq + 4 * hi;
              float o[4];
              if (g < 2) {
                const f32x4 w0c = *(const f32x4*)&w0[col];
#pragma unroll
                for (int e = 0; e < 4; ++e) {
                  const float nx = -(c[4 * gq + e] + w0c[e]);
                  const float sp = fmaxf(nx, 0.f) + log1pf(expf(-fabsf(nx)));
                  const float ee = expf(-sp - 0.5f);
                  o[e] = -expm1f(-ee);
                }
                typedef _Float16 h4 __attribute__((ext_vector_type(4)));
                h4 hv = {(_Float16)o[0], (_Float16)o[1], (_Float16)o[2], (_Float16)o[3]};
                *(h4*)&OMW[((size_t)m * 2 + d) * 512 + col] = hv;
              } else if (g < 4) {
                const f32x4 a0c = *(const f32x4*)&a0[col];
#pragma unroll
                for (int e = 0; e < 4; ++e) o[e] = 1.f / (1.f + expf(-(c[4 * gq + e] + a0c[e])));
                *(u32x2*)&AA[((size_t)m * 2 + d) * 512 + col] = pk4(o[0], o[1], o[2], o[3]);
              } else {
                *(u32x2*)&GG[(size_t)m * 512 + col] = pk4(c[4 * gq], c[4 * gq + 1], c[4 * gq + 2], c[4 * gq + 3]);
              }
            }
                    };
          tile_(c0, 0); tile_(c1, 1); tile_(c2, 2); tile_(c3, 3);

        });
    }
    GSYNC();
#ifndef SKIP_SCAN
    phase_scan(p, l, lds);
#ifdef REP_SCAN
    phase_scan(p, l, lds);
#endif
#endif
    GSYNC();
#ifndef SKIP_POST
    phase_post(p, l);
#endif
    GSYNC();
    for (int it = bid; it < 128 * 4; it += nb) {
      const int mt = it >> 2, nt = it & 3;
      gemm_tile(PJ, LDP, WT_OUT, DM, DM, mt * 256, nt * 256, lds,
        [&](f32x16& c0, f32x16& c1, f32x16& c2, f32x16& c3, int m, int nw, int hi) {
          const int b = m >> 13; const float* gt = modl + b * 6144 + 2048 + nw + 4 * hi;
          const float* xi = xin + (size_t)m * DM + nw + 4 * hi; float* xo = p.out + (size_t)m * DM + nw + 4 * hi;
          auto tile_ = [&](const f32x16& c, const int j) {
#pragma unroll
            for (int g = 0; g < 4; ++g) {
              const f32x4 x4 = *(const f32x4*)(xi + 32 * j + 8 * g), g4 = *(const f32x4*)(gt + 32 * j + 8 * g);
              f32x4 o = {x4[0] + g4[0] * c[4 * g], x4[1] + g4[1] * c[4 * g + 1], x4[2] + g4[2] * c[4 * g + 2], x4[3] + g4[3] * c[4 * g + 3]};
              *(f32x4*)(xo + 32 * j + 8 * g) = o;
            }
                    };
          tile_(c0, 0); tile_(c1, 1); tile_(c2, 2); tile_(c3, 3);

        });
    }
    GSYNC();
    phase_norm(p.out, p.norm2 + l * DM, modl, 3072, 4096, H);
    GSYNC();
#ifdef REP_UP
    for (int rep = 0; rep < 2; ++rep)
#endif
    for (int it = bid; it < 128 * 16; it += nb) {
      const int mt = it >> 4, nt = it & 15;
      gemm_tile(H, DM, WT_UP, DM, DM, mt * 256, nt * 256, lds,
        [&](f32x16& c0, f32x16& c1, f32x16& c2, f32x16& c3, int m, int nw, int hi) {
          bf16* dst = U + (size_t)m * DFF + nw + 4 * hi;
          auto tile_ = [&](const f32x16& c, const int j) {
#pragma unroll
            for (int g = 0; g < 4; ++g) {
              const float u0 = fmaxf(c[4 * g], 0.f), u1 = fmaxf(c[4 * g + 1], 0.f), u2 = fmaxf(c[4 * g + 2], 0.f), u3 = fmaxf(c[4 * g + 3], 0.f);
              *(u32x2*)(dst + 32 * j + 8 * g) = pk4(u0 * u0, u1 * u1, u2 * u2, u3 * u3);
            }
                    };
          tile_(c0, 0); tile_(c1, 1); tile_(c2, 2); tile_(c3, 3);

        });
    }
    GSYNC();
    for (int it = bid; it < 128 * 4; it += nb) {
      const int mt = it >> 2, nt = it & 3;
      gemm_tile(U, DFF, WT_DOWN, DFF, DFF, mt * 256, nt * 256, lds,
        [&](f32x16& c0, f32x16& c1, f32x16& c2, f32x16& c3, int m, int nw, int hi) {
          const int b = m >> 13; const float* gt = modl + b * 6144 + 5120 + nw + 4 * hi;
          float* xo = p.out + (size_t)m * DM + nw + 4 * hi;
          auto tile_ = [&](const f32x16& c, const int j) {
#pragma unroll
            for (int g = 0; g < 4; ++g) {
              const f32x4 x4 = *(const f32x4*)(xo + 32 * j + 8 * g), g4 = *(const f32x4*)(gt + 32 * j + 8 * g);
              f32x4 o = {x4[0] + g4[0] * c[4 * g], x4[1] + g4[1] * c[4 * g + 1], x4[2] + g4[2] * c[4 * g + 2], x4[3] + g4[3] * c[4 * g + 3]};
              *(f32x4*)(xo + 32 * j + 8 * g) = o;
            }
                    };
          tile_(c0, 0); tile_(c1, 1); tile_(c2, 2); tile_(c3, 3);

        });
    }
    GSYNC();
  }
  phase_final_norm(p.out, p.norm_f);
}

extern "C" void kernel_launch(void* const* d_in, const int* in_sizes, int n_in, void* d_out, int out_size, void* d_ws, size_t ws_size,
                              hipStream_t stream) {
  static int grid_blocks = 0;
  if (n_in != 27 || ws_size < WS_NEED) { fprintf(stderr, "kernel_launch: bad n_in %d or ws_size %zu (< %zu)\n", n_in, ws_size, (size_t)WS_NEED); return; }
  if (!grid_blocks) {
    int dev = 0, cus = 0, per_cu = 0;
    hipGetDevice(&dev);
    hipDeviceGetAttribute(&cus, hipDeviceAttributeMultiprocessorCount, dev);
    hipFuncSetAttribute((const void*)fwd_megakernel, hipFuncAttributeMaxDynamicSharedMemorySize, LDS_BYTES);
    hipOccupancyMaxActiveBlocksPerMultiprocessor(&per_cu, fwd_megakernel, NTHR, LDS_BYTES);
    if (per_cu < 1) per_cu = 1;
    if (per_cu > 1) per_cu = 1;
    grid_blocks = cus * per_cu;
  }
  Params p{};
  const float** pp = (const float**)&p;
  for (int i = 0; i < 27; ++i) pp[i] = (const float*)d_in[i];
  p.out = (float*)d_out; p.ws = (char*)d_ws;
  for (int i = 0; i < 32; ++i) p.inv_freq[i] = 1.0f / powf(10000.0f, (float)(2 * i) / 64.0f);
  hipMemsetAsync((char*)d_ws + OFF_BAR, 0, 256, stream);
  void* args[] = {&p};
  hipError_t e = hipLaunchCooperativeKernel((void*)fwd_megakernel, dim3(grid_blocks), dim3(NTHR), args, LDS_BYTES, stream);
  if (e != hipSuccess) fprintf(stderr, "cooperative launch failed: %s (grid %d)\n", hipGetErrorString(e), grid_blocks);
}
```

```cpp
#include <hip/hip_runtime.h>
#include <hip/hip_bf16.h>
#include <hip/hip_cooperative_groups.h>
#include <cstdio>
#include <cmath>
namespace cg = cooperative_groups;

#define DEVI __device__ __forceinline__
using bf16 = __hip_bfloat16;
typedef short bf16x8 __attribute__((ext_vector_type(8)));
typedef short s16x4 __attribute__((ext_vector_type(4)));
typedef float f32x16 __attribute__((ext_vector_type(16)));
typedef float f32x4 __attribute__((ext_vector_type(4)));
typedef unsigned u32x4 __attribute__((ext_vector_type(4)));
typedef unsigned u32x2 __attribute__((ext_vector_type(2)));
typedef float f32x2 __attribute__((ext_vector_type(2)));

constexpr int NTOK = 32768, SEQ = 8192, DM = 1024, LDP = 3456, DFF = 4096;
constexpr int NTHR = 512;
constexpr size_t MiB = 1024 * 1024;
constexpr size_t OFF_WT_IN = 0;
constexpr size_t OFF_WT_OUT = OFF_WT_IN + (size_t)3456 * 1024 * 2;
constexpr size_t OFF_WT_UP = OFF_WT_OUT + (size_t)1024 * 1024 * 2;
constexpr size_t OFF_WT_DOWN = OFF_WT_UP + (size_t)4096 * 1024 * 2;
constexpr size_t OFF_W2T = OFF_WT_DOWN + (size_t)4096 * 1024 * 2;
constexpr size_t OFF_A2T = OFF_W2T + (size_t)2 * 512 * 64 * 2;
constexpr size_t OFF_G2T = OFF_A2T + (size_t)2 * 512 * 64 * 2;
constexpr size_t OFF_U = 26 * MiB;
constexpr size_t OFF_ZL = OFF_U + 216 * MiB;
constexpr size_t OFF_H = OFF_U + 256 * MiB;
constexpr size_t OFF_OMW = OFF_H + 64 * MiB;
constexpr size_t OFF_A = OFF_OMW + 64 * MiB;
constexpr size_t OFF_G = OFF_A + 64 * MiB;
constexpr size_t OFF_MOD = OFF_G + 32 * MiB;
constexpr size_t OFF_COS = OFF_MOD + 1 * MiB;
constexpr size_t OFF_SIN = OFF_COS + 1 * MiB;
constexpr size_t OFF_BAR = OFF_SIN + 1 * MiB;
constexpr size_t WS_NEED = OFF_BAR + 1 * MiB;
constexpr int LDS_BYTES = 131072;

struct Params {
  const float *x, *c, *w_ada, *b_ada, *norm1, *norm2, *w_in, *w_out, *lam_q1, *lam_k1, *lam_q2, *lam_k2, *subln_w, *tshift_mu,
      *decay_w0, *decay_w2, *icl_a0, *icl_a2, *gate_g2, *k_k, *k_a, *r_k, *lnx_w, *lnx_b, *w_up, *w_down, *norm_f;
  float* out;
  char* ws;
  float inv_freq[32];
};

DEVI void grid_barrier(unsigned* bar, unsigned& target) {
  asm volatile("s_waitcnt vmcnt(0) lgkmcnt(0)" ::: "memory");
  __syncthreads();
  target += gridDim.x;
  if (threadIdx.x == 0) {
    __builtin_amdgcn_fence(__ATOMIC_RELEASE, "agent");
    asm volatile("s_waitcnt vmcnt(0)" ::: "memory");
    __hip_atomic_fetch_add(bar, 1u, __ATOMIC_RELAXED, __HIP_MEMORY_SCOPE_AGENT);
    while (__hip_atomic_load(bar, __ATOMIC_RELAXED, __HIP_MEMORY_SCOPE_AGENT) < target) __builtin_amdgcn_s_sleep(2);
    __builtin_amdgcn_fence(__ATOMIC_ACQUIRE, "agent");
    asm volatile("s_waitcnt vmcnt(0)" ::: "memory");
  }
  __syncthreads();
}
#define GSYNC() grid_barrier(gbar, gtarget)
struct Params;
#define GAS __attribute__((address_space(1)))
template <class T> DEVI T* launder(T* q) { unsigned long long u = (unsigned long long)q; asm volatile("" : "+v"(u)); return (T*)(GAS T*)u; }
DEVI char* ws_launder(char* w) { return launder(w); }
#define WSV(p) ws_launder((p).ws)
DEVI int tid_opaque() { int t = threadIdx.x; asm volatile("" : "+v"(t)); return t; }
DEVI int crow(int r, int hi) { return (r & 3) + 8 * (r >> 2) + 4 * hi; }
DEVI unsigned cvtpk(float lo, float hi) {
  unsigned r; asm volatile("v_cvt_pk_bf16_f32 %0, %1, %2" : "=v"(r) : "v"(lo), "v"(hi)); return r;
}
DEVI unsigned short f2bf(float x) { return (unsigned short)(cvtpk(x, 0.f) & 0xffffu); }
DEVI float bf2f(unsigned short u) { return __uint_as_float(((unsigned)u) << 16); }
DEVI float bflo(unsigned u) { return __uint_as_float(u << 16); }
DEVI float bfhi(unsigned u) { return __uint_as_float(u & 0xffff0000u); }
template <int CTRL> DEVI float dppf(float x) {
  return __builtin_bit_cast(float, __builtin_amdgcn_mov_dpp(__builtin_bit_cast(int, x), CTRL, 0xf, 0xf, true));
}
DEVI float red8(float x) { x += dppf<0xB1>(x); x += dppf<0x4E>(x); x += dppf<0x141>(x); return x; }
DEVI float red16(float x) { x = red8(x); x += dppf<0x128>(x); return x; }
DEVI float red64(float x) { x = red16(x); x += __shfl_xor(x, 16); x += __shfl_xor(x, 32); return x; }
DEVI float sigmoidf_(float x) { return 1.f / (1.f + __expf(-x)); }
DEVI void unpack8(u32x4 v, float* f) {
  f[0] = bflo(v[0]); f[1] = bfhi(v[0]); f[2] = bflo(v[1]); f[3] = bfhi(v[1]);
  f[4] = bflo(v[2]); f[5] = bfhi(v[2]); f[6] = bflo(v[3]); f[7] = bfhi(v[3]);
}
DEVI u32x4 pack8(const float* f) {
  u32x4 w = {cvtpk(f[0], f[1]), cvtpk(f[2], f[3]), cvtpk(f[4], f[5]), cvtpk(f[6], f[7])}; return w;
}

DEVI void phase_mod(const Params& p, char* lds) {
  float* sc = (float*)lds;
  float* red = sc + 4096;
  const int tid = tid_opaque(), w = tid >> 6, lane = tid & 63;
  for (int i = tid; i < 4096; i += NTHR) { float v = p.c[i]; sc[i] = v / (1.f + expf(-v)); }
  __syncthreads();
  float* mod = (float*)(WSV(p) + OFF_MOD);
  for (int it = blockIdx.x; it < 192; it += gridDim.x) {
    const int l = it / 96, col = (it % 96) * 64 + lane;
    const float* W = p.w_ada + (size_t)l * 1024 * 6144 + col;
    float a0 = 0, a1 = 0, a2 = 0, a3 = 0;
    for (int k = w * 128; k < w * 128 + 128; ++k) {
      float wv = W[(size_t)k * 6144];
      a0 += sc[k] * wv; a1 += sc[1024 + k] * wv; a2 += sc[2048 + k] * wv; a3 += sc[3072 + k] * wv;
    }
    red[(w * 4 + 0) * 64 + lane] = a0; red[(w * 4 + 1) * 64 + lane] = a1;
    red[(w * 4 + 2) * 64 + lane] = a2; red[(w * 4 + 3) * 64 + lane] = a3;
    __syncthreads();
    if (tid < 256) {
      const int bb = tid >> 6; float s = 0;
      for (int ww = 0; ww < 8; ++ww) s += red[(ww * 4 + bb) * 64 + lane];
      mod[(l * 4 + bb) * 6144 + col] = s + p.b_ada[l * 6144 + col];
    }
    __syncthreads();
  }
}

DEVI void phase_rope(const Params& p) {
  float* cosT = (float*)(WSV(p) + OFF_COS); float* sinT = (float*)(WSV(p) + OFF_SIN);
  for (int idx = blockIdx.x * NTHR + tid_opaque(); idx < SEQ * 32; idx += gridDim.x * NTHR) {
    const int pos = idx >> 5, i = idx & 31;
    const float ang = (float)pos * p.inv_freq[i];
    double q = (double)ang * 0.15915494309189533577; q -= floor(q);
    const float f = (float)q;
    cosT[idx] = __builtin_amdgcn_cosf(f); sinT[idx] = __builtin_amdgcn_sinf(f);
  }
}

DEVI void conv_tile(const float* __restrict__ src, int ldsrc, bf16* __restrict__ dst, int lddst, int k0, int n0, float* tile) {
  const int tid = tid_opaque();
#pragma unroll
  for (int ps = 0; ps < 2; ++ps) {
    const int k = ps * 32 + (tid >> 4), n = (tid & 15) * 4;
    const f32x4 v = *(const f32x4*)&src[(size_t)(k0 + k) * ldsrc + n0 + n];
    tile[k * 65 + n + 0] = v[0]; tile[k * 65 + n + 1] = v[1]; tile[k * 65 + n + 2] = v[2]; tile[k * 65 + n + 3] = v[3];
  }
  __syncthreads();
  {
    const int n = tid >> 3, kc = (tid & 7) * 8; float f[8];
#pragma unroll
    for (int j = 0; j < 8; ++j) f[j] = tile[(kc + j) * 65 + n];
    *(u32x4*)&dst[(size_t)(n0 + n) * lddst + k0 + kc] = pack8(f);
  }
  __syncthreads();
}
DEVI void phase_conv(const Params& p, int l, char* lds) {
  float* tile = (float*)lds;
  for (int it = blockIdx.x; it < 3216; it += gridDim.x) {
    const float* src; bf16* dst; int K, N, t = it;
    char* wsb = launder(p.ws);
    if (t < 864) { src = p.w_in + (size_t)l * 1024 * 3456; dst = (bf16*)(wsb + OFF_WT_IN); K = 1024; N = 3456; }
    else if ((t -= 864) < 256) { src = p.w_out + (size_t)l * 1024 * 1024; dst = (bf16*)(wsb + OFF_WT_OUT); K = 1024; N = 1024; }
    else if ((t -= 256) < 1024) { src = p.w_up + (size_t)l * 1024 * 4096; dst = (bf16*)(wsb + OFF_WT_UP); K = 1024; N = 4096; }
    else if ((t -= 1024) < 1024) { src = p.w_down + (size_t)l * 4096 * 1024; dst = (bf16*)(wsb + OFF_WT_DOWN); K = 4096; N = 1024; }
    else if ((t -= 1024) < 16) { const int d = t >> 3; t &= 7; src = p.decay_w2 + (size_t)(l * 2 + d) * 64 * 512; dst = (bf16*)(wsb + OFF_W2T) + d * 512 * 64; K = 64; N = 512; }
    else if ((t -= 16) < 16) { const int d = t >> 3; t &= 7; src = p.icl_a2 + (size_t)(l * 2 + d) * 64 * 512; dst = (bf16*)(wsb + OFF_A2T) + d * 512 * 64; K = 64; N = 512; }
    else { t -= 16; src = p.gate_g2 + (size_t)l * 128 * 512; dst = (bf16*)(wsb + OFF_G2T); K = 128; N = 512; }
    const int nt = N / 64; const int kt = t / nt, ntile = t % nt;
    conv_tile(src, N, dst, K, kt * 64, ntile * 64, tile);
  }
}

DEVI void phase_norm(const float* __restrict__ xin, const float* __restrict__ g, const float* __restrict__ modl, int shoff, int scoff,
                     bf16* __restrict__ H) {
  const int tid = tid_opaque(), w = tid >> 6, lane = tid & 63;
  for (int row = blockIdx.x * 8 + w; row < NTOK; row += gridDim.x * 8) {
    const int b = row >> 13; f32x4 v[4]; float ss = 0;
#pragma unroll
    for (int j = 0; j < 4; ++j) { v[j] = *(const f32x4*)&xin[(size_t)row * DM + j * 256 + lane * 4]; ss += v[j][0] * v[j][0] + v[j][1] * v[j][1] + v[j][2] * v[j][2] + v[j][3] * v[j][3]; }
    ss = red64(ss);
    const float rstd = rsqrtf(ss * (1.f / 1024.f) + 1e-6f);
#pragma unroll
    for (int j = 0; j < 4; ++j) {
      const int col = j * 256 + lane * 4;
      const f32x4 g4 = *(const f32x4*)&g[col];
      const f32x4 sc4 = *(const f32x4*)&modl[b * 6144 + scoff + col];
      const f32x4 sh4 = *(const f32x4*)&modl[b * 6144 + shoff + col];
      float o[4];
#pragma unroll
      for (int e = 0; e < 4; ++e) o[e] = v[j][e] * rstd * g4[e] * (1.f + sc4[e]) + sh4[e];
      u32x2 pk = {cvtpk(o[0], o[1]), cvtpk(o[2], o[3])};
      *(u32x2*)&H[(size_t)row * DM + col] = pk;
    }
  }
}
DEVI void phase_final_norm(float* __restrict__ x, const float* __restrict__ g) {
  const int tid = tid_opaque(), w = tid >> 6, lane = tid & 63;
  for (int row = blockIdx.x * 8 + w; row < NTOK; row += gridDim.x * 8) {
    f32x4 v[4]; float ss = 0;
#pragma unroll
    for (int j = 0; j < 4; ++j) { v[j] = *(const f32x4*)&x[(size_t)row * DM + j * 256 + lane * 4]; ss += v[j][0] * v[j][0] + v[j][1] * v[j][1] + v[j][2] * v[j][2] + v[j][3] * v[j][3]; }
    ss = red64(ss);
    const float rstd = rsqrtf(ss * (1.f / 1024.f) + 1e-6f);
#pragma unroll
    for (int j = 0; j < 4; ++j) {
      const int col = j * 256 + lane * 4;
      const f32x4 g4 = *(const f32x4*)&g[col];
      f32x4 o = {v[j][0] * rstd * g4[0], v[j][1] * rstd * g4[1], v[j][2] * rstd * g4[2], v[j][3] * rstd * g4[3]};
#ifdef SANITIZE
      for (int e = 0; e < 4; ++e) if (!(fabsf(o[e]) < 1e30f)) o[e] = 0.f;
#endif
      *(f32x4*)&x[(size_t)row * DM + col] = o;
    }
  }
}

template <class Epi>
DEVI void gemm_tile(const bf16* __restrict__ A, int lda, const bf16* __restrict__ Bt, int ldb, int K, int m0, int n0, char* lds, Epi&& epi) {
  const int tid = tid_opaque(), wid = tid >> 6, lane = tid & 63, r32 = lane & 31, hi = lane >> 5;
  const int wm = wid >> 1, wn = wid & 1;
  char* As = lds; char* Bs = lds + 65536;
  f32x16 acc00 = {}, acc01 = {}, acc02 = {}, acc03 = {}, acc10 = {}, acc11 = {}, acc12 = {}, acc13 = {};
  const int lrow = tid >> 3, lch = tid & 7;
  const bf16* Ag = A + (size_t)(m0 + lrow) * lda + lch * 8;
  const bf16* Bg = Bt + (size_t)(n0 + lrow) * ldb + lch * 8;
  const int wsw = lrow * 128 + ((lch ^ ((lrow >> 1) & 7)) * 16);
  bf16x8 ra0, ra1, ra2, ra3, rb0, rb1, rb2, rb3;
#define GLOAD(k0) do { ra0 = *(const bf16x8*)(Ag + (k0)); ra1 = *(const bf16x8*)(Ag + (size_t)64 * lda + (k0)); \
    ra2 = *(const bf16x8*)(Ag + (size_t)128 * lda + (k0)); ra3 = *(const bf16x8*)(Ag + (size_t)192 * lda + (k0)); \
    rb0 = *(const bf16x8*)(Bg + (k0)); rb1 = *(const bf16x8*)(Bg + (size_t)64 * ldb + (k0)); \
    rb2 = *(const bf16x8*)(Bg + (size_t)128 * ldb + (k0)); rb3 = *(const bf16x8*)(Bg + (size_t)192 * ldb + (k0)); } while (0)
#define LWRITE(buf) do { char* a_ = As + (buf) * 32768 + wsw; char* b_ = Bs + (buf) * 32768 + wsw; \
    *(bf16x8*)(a_) = ra0; *(bf16x8*)(a_ + 64 * 128) = ra1; *(bf16x8*)(a_ + 128 * 128) = ra2; *(bf16x8*)(a_ + 192 * 128) = ra3; \
    *(bf16x8*)(b_) = rb0; *(bf16x8*)(b_ + 64 * 128) = rb1; *(bf16x8*)(b_ + 128 * 128) = rb2; *(bf16x8*)(b_ + 192 * 128) = rb3; } while (0)
  const int KT = K >> 6;
  const int arow0 = wm * 64 + r32, arow1 = arow0 + 32, brow0 = wn * 128 + r32;
  const int asw = (arow0 >> 1) & 7;
  const int bsw = (brow0 >> 1) & 7;
  GLOAD(0); LWRITE(0); __syncthreads();
#pragma unroll 2
  for (int kt = 0; kt < KT; ++kt) {
    if (kt + 1 < KT) GLOAD((kt + 1) * 64);
    const char* Ab = As + (kt & 1) * 32768; const char* Bb = Bs + (kt & 1) * 32768;
#pragma unroll
    for (int kk = 0; kk < 4; ++kk) {
      const int ch = kk * 2 + hi;
      const bf16x8 a0 = *(const bf16x8*)(Ab + arow0 * 128 + ((ch ^ asw) * 16));
      const bf16x8 a1 = *(const bf16x8*)(Ab + arow1 * 128 + ((ch ^ asw) * 16));
      const bf16x8 b0 = *(const bf16x8*)(Bb + brow0 * 128 + ((ch ^ bsw) * 16));
      const bf16x8 b1 = *(const bf16x8*)(Bb + (brow0 + 32) * 128 + ((ch ^ bsw) * 16));
      const bf16x8 b2 = *(const bf16x8*)(Bb + (brow0 + 64) * 128 + ((ch ^ bsw) * 16));
      const bf16x8 b3 = *(const bf16x8*)(Bb + (brow0 + 96) * 128 + ((ch ^ bsw) * 16));
      acc00 = __builtin_amdgcn_mfma_f32_32x32x16_bf16(b0, a0, acc00, 0, 0, 0);
      acc01 = __builtin_amdgcn_mfma_f32_32x32x16_bf16(b1, a0, acc01, 0, 0, 0);
      acc02 = __builtin_amdgcn_mfma_f32_32x32x16_bf16(b2, a0, acc02, 0, 0, 0);
      acc03 = __builtin_amdgcn_mfma_f32_32x32x16_bf16(b3, a0, acc03, 0, 0, 0);
      acc10 = __builtin_amdgcn_mfma_f32_32x32x16_bf16(b0, a1, acc10, 0, 0, 0);
      acc11 = __builtin_amdgcn_mfma_f32_32x32x16_bf16(b1, a1, acc11, 0, 0, 0);
      acc12 = __builtin_amdgcn_mfma_f32_32x32x16_bf16(b2, a1, acc12, 0, 0, 0);
      acc13 = __builtin_amdgcn_mfma_f32_32x32x16_bf16(b3, a1, acc13, 0, 0, 0);
    }
    if (kt + 1 < KT) LWRITE((kt + 1) & 1);
    __syncthreads();
  }
#undef GLOAD
#undef LWRITE
  const int mw = m0 + wm * 64 + r32, nw = n0 + wn * 128;
  epi(acc00, acc01, acc02, acc03, mw, nw, hi);
  epi(acc10, acc11, acc12, acc13, mw + 32, nw, hi);
}
DEVI u32x2 pk4(float a, float b, float c, float d) { u32x2 r = {cvtpk(a, b), cvtpk(c, d)}; return r; }

constexpr float ATT_SCALE = 0.125f;
constexpr float ATT_THR = 8.f;
constexpr int SHM_V = 64 * 128 * 2, SHM_K = 64 * 128 * 2;
#define KSWZ(row, colB) ((row) * 256 + ((colB) ^ (((row) & 7) << 4)))
#define SBAR() __builtin_amdgcn_sched_barrier(0)
DEVI void partialSM(f32x16& p0, f32x16& p1, float& m_reg, float& mn, float& alpha) {
  constexpr float C = ATT_SCALE * 1.4426950408889634f;
  float pmax = p0[0];
#pragma unroll
  for (int r = 1; r < 16; ++r) pmax = fmaxf(pmax, p0[r]);
#pragma unroll
  for (int r = 0; r < 16; ++r) pmax = fmaxf(pmax, p1[r]);
  { auto rr = __builtin_amdgcn_permlane32_swap(__float_as_uint(pmax), __float_as_uint(pmax), false, false);
    pmax = fmaxf(__uint_as_float(rr[0]), __uint_as_float(rr[1])); }
  if (__builtin_expect(__all(pmax - m_reg <= ATT_THR / ATT_SCALE), 1)) { mn = m_reg; alpha = 1.f; }
  else { mn = fmaxf(m_reg, pmax); alpha = __builtin_amdgcn_exp2f((m_reg - mn) * C); m_reg = mn; }
  const float mnC = -mn * C;
#pragma unroll
  for (int r = 0; r < 16; ++r) p0[r] = __builtin_amdgcn_exp2f(fmaf(p0[r], C, mnC));
#pragma unroll
  for (int r = 0; r < 16; ++r) p1[r] = __builtin_amdgcn_exp2f(fmaf(p1[r], C, mnC));
}
DEVI void finishSM(f32x16& p0, f32x16& p1, float alpha, float& l_reg, bf16x8& pa0, bf16x8& pa1, bf16x8& pa2, bf16x8& pa3) {
  float ps = 0;
#pragma unroll
  for (int r = 0; r < 16; ++r) ps += p0[r];
#pragma unroll
  for (int r = 0; r < 16; ++r) ps += p1[r];
  { auto rr = __builtin_amdgcn_permlane32_swap(__float_as_uint(ps), __float_as_uint(ps), false, false);
    ps = __uint_as_float(rr[0]) + __uint_as_float(rr[1]); }
  l_reg = l_reg * alpha + ps;
#define PK4(P, BASE, OUT) do { unsigned a0 = cvtpk(P[BASE + 0], P[BASE + 1]), a1 = cvtpk(P[BASE + 2], P[BASE + 3]);   \
    unsigned b0 = cvtpk(P[BASE + 4], P[BASE + 5]), b1 = cvtpk(P[BASE + 6], P[BASE + 7]);                              \
    auto r0 = __builtin_amdgcn_permlane32_swap(a0, b0, false, false); auto r1 = __builtin_amdgcn_permlane32_swap(a1, b1, false, false); \
    u32x4 w = {r0[0], r1[0], r0[1], r1[1]}; OUT = *reinterpret_cast<bf16x8*>(&w); } while (0)
  PK4(p0, 0, pa0); PK4(p0, 8, pa1); PK4(p1, 0, pa2); PK4(p1, 8, pa3);
#undef PK4
}
DEVI int v_st(int k, int c) { const int kk = (k & ~0xC) | ((k & 4) << 1) | ((k & 8) >> 1); return ((kk >> 3) * 4 + (c >> 5)) * 512 + ((kk & 7) * 32 + (c & 31)) * 2; }
DEVI int v_rd_base(int lane) { return ((lane & 3) << 3) | (((lane >> 2) & 3) << 6) | (((lane >> 4) & 1) << 5) | (((lane >> 5) & 1) << 8); }
constexpr int v_rd_off(int d0, int ks, int half) { return d0 * 512 + ks * 4096 + half * 2048; }
template <int OFF> DEVI s16x4 tr_read(int vb) {
  s16x4 r; asm volatile("ds_read_b64_tr_b16 %0, %1 offset:%2" : "=&v"(r) : "v"(vb), "i"(OFF) : "memory"); return r;
}
template <int D0> DEVI void pv_one(f32x16& od, int vb, bf16x8 pa0, bf16x8 pa1, bf16x8 pa2, bf16x8 pa3) {
  const s16x4 l0 = tr_read<v_rd_off(D0, 0, 0)>(vb), h0 = tr_read<v_rd_off(D0, 0, 1)>(vb), l1 = tr_read<v_rd_off(D0, 1, 0)>(vb), h1 = tr_read<v_rd_off(D0, 1, 1)>(vb);
  const s16x4 l2 = tr_read<v_rd_off(D0, 2, 0)>(vb), h2 = tr_read<v_rd_off(D0, 2, 1)>(vb), l3 = tr_read<v_rd_off(D0, 3, 0)>(vb), h3 = tr_read<v_rd_off(D0, 3, 1)>(vb);
  asm volatile("s_waitcnt lgkmcnt(0)" ::: "memory"); SBAR();
#define PK(L, H) (bf16x8){L[0], L[1], L[2], L[3], H[0], H[1], H[2], H[3]}
  od = __builtin_amdgcn_mfma_f32_32x32x16_bf16(pa0, PK(l0, h0), od, 0, 0, 0);
  od = __builtin_amdgcn_mfma_f32_32x32x16_bf16(pa1, PK(l1, h1), od, 0, 0, 0);
  od = __builtin_amdgcn_mfma_f32_32x32x16_bf16(pa2, PK(l2, h2), od, 0, 0, 0);
  od = __builtin_amdgcn_mfma_f32_32x32x16_bf16(pa3, PK(l3, h3), od, 0, 0, 0);
#undef PK
}
DEVI void pv_d0(f32x16* o, int vb, bf16x8 pa0, bf16x8 pa1, bf16x8 pa2, bf16x8 pa3) {
  pv_one<0>(o[0], vb, pa0, pa1, pa2, pa3); pv_one<1>(o[1], vb, pa0, pa1, pa2, pa3); pv_one<2>(o[2], vb, pa0, pa1, pa2, pa3); pv_one<3>(o[3], vb, pa0, pa1, pa2, pa3);
}

DEVI void attn_item(bf16* __restrict__ PJ, int b, int h, int qb, float lam, float one_m_li, const float* __restrict__ subw, char* lds, bool do_store = true) {
  const int tid = tid_opaque(), wid = tid >> 6, lane = tid & 63, r32 = lane & 31, hi = lane >> 5;
  const int cmp = wid & 1, wq = wid >> 1;
  char* V_lds = lds; char* K_lds = lds + 2 * SHM_V;
  float* wsl = (float*)(lds + 2 * SHM_V + 2 * SHM_K) + wid * 64; float* li_l = wsl; float* al_l = wsl + 32;
  const size_t rowQ = (size_t)b * SEQ + (size_t)qb * 128 + wq * 32;
  const bf16* Kh = PJ + (size_t)b * SEQ * LDP + 512 + h * 128;
  float m1 = -1e30f, l1 = 0; f32x16 o1[4] = {}; bf16x8 qr[4];
  { const bf16* Qw = PJ + (rowQ + r32) * LDP + h * 128 + cmp * 64 + hi * 8;
#pragma unroll
    for (int d0 = 0; d0 < 4; ++d0) qr[d0] = *(const bf16x8*)(Qw + d0 * 16); }
  const int sr = tid >> 4, sc = (tid & 15) * 8, vst0 = v_st(sr, sc), vst1 = v_st(32 + sr, sc);
  const int vb0 = (int)(uintptr_t)V_lds + v_rd_base(lane);
  int kof0[4], kof1[4];
#pragma unroll
  for (int d0 = 0; d0 < 4; ++d0) { const int cb = ((cmp * 4 + d0) * 16 + hi * 8) * 2; kof0[d0] = KSWZ(r32, cb); kof1[d0] = KSWZ(32 + r32, cb); }
  bf16x8 vs0, vs1, ks0, ks1;
  const bf16* kpA = Kh + (size_t)sr * LDP + sc; const bf16* kpB = kpA + (size_t)32 * LDP;
  kpA = launder(kpA); kpB = launder(kpB);
#define SLOAD() do { vs0 = *(const bf16x8*)(kpA + 512); vs1 = *(const bf16x8*)(kpB + 512); ks0 = *(const bf16x8*)(kpA); ks1 = *(const bf16x8*)(kpB); \
    kpA += (size_t)64 * LDP; kpB += (size_t)64 * LDP; } while (0)
#define SWRITE(bb) do { *(bf16x8*)(V_lds + (bb) * SHM_V + vst0) = vs0; *(bf16x8*)(V_lds + (bb) * SHM_V + vst1) = vs1; const int kc = sc * 2; \
    *(bf16x8*)(K_lds + (bb) * SHM_K + KSWZ(sr, kc)) = ks0; *(bf16x8*)(K_lds + (bb) * SHM_K + KSWZ(32 + sr, kc)) = ks1; } while (0)
#define RESC(a, o) do { if (__any((a) < 1.f)) { if (hi == 0) al_l[r32] = (a); asm volatile("s_waitcnt lgkmcnt(0)" ::: "memory"); \
    _Pragma("unroll") for (int d = 0; d < 4; ++d) _Pragma("unroll") for (int r = 0; r < 16; ++r) o[d][r] *= al_l[crow(r, hi)]; } } while (0)
  constexpr int NT = SEQ / 64;
  SLOAD(); SWRITE(0); __syncthreads();
  for (int j = 0; j < NT; ++j) {
    if (j + 1 < NT) SLOAD();
    const char* Kb = K_lds + (j & 1) * SHM_K; const int vb = vb0 + (j & 1) * SHM_V;
    f32x16 p0 = {}, p1 = {}; float mn, al; bf16x8 pa0, pa1, pa2, pa3;
#pragma unroll
    for (int d0 = 0; d0 < 4; ++d0) {
      const bf16x8 b0 = *reinterpret_cast<const bf16x8*>(Kb + kof0[d0]);
      const bf16x8 b1 = *reinterpret_cast<const bf16x8*>(Kb + kof1[d0]);
      p0 = __builtin_amdgcn_mfma_f32_32x32x16_bf16(b0, qr[d0], p0, 0, 0, 0);
      p1 = __builtin_amdgcn_mfma_f32_32x32x16_bf16(b1, qr[d0], p1, 0, 0, 0);
    }
    partialSM(p0, p1, m1, mn, al);
    RESC(al, o1);
    finishSM(p0, p1, al, l1, pa0, pa1, pa2, pa3); SBAR();
    pv_d0(o1, vb, pa0, pa1, pa2, pa3);
    if (j + 1 < NT) SWRITE((j + 1) & 1);
    __syncthreads();
  }
#undef SLOAD
#undef SWRITE
#undef RESC
  if (hi == 0) li_l[r32] = (cmp ? lam : 1.f) / l1;
  asm volatile("s_waitcnt lgkmcnt(0)" ::: "memory");
#pragma unroll
  for (int r = 0; r < 16; ++r) { const float c1 = li_l[crow(r, hi)];
#pragma unroll
    for (int d = 0; d < 4; ++d) o1[d][r] *= c1; }
  float* X = (float*)lds + wq * 4096 + lane;
  if (cmp == 1) {
#pragma unroll
    for (int d = 0; d < 4; ++d)
#pragma unroll
      for (int r = 0; r < 16; ++r) X[(d * 16 + r) * 64] = o1[d][r];
  }
  __syncthreads();
  if (cmp == 0 && do_store) {
    float sw[4];
#pragma unroll
    for (int d = 0; d < 4; ++d) sw[d] = subw[d * 32 + r32] * one_m_li;
    bf16* Ow = PJ + (rowQ + 4 * hi) * LDP + h * 128 + r32;
#pragma unroll
    for (int r = 0; r < 16; ++r) {
      float s = 0;
#pragma unroll
      for (int d = 0; d < 4; ++d) { const float v = o1[d][r] - X[(d * 16 + r) * 64]; o1[d][r] = v; s += v * v; }
      s = red16(s); s += __shfl_xor(s, 16);
      const float rs = rsqrtf(s * (1.f / 128.f) + 1e-5f);
      bf16* orp = launder(Ow + (size_t)((r & 3) + 8 * (r >> 2)) * LDP);
#pragma unroll
      for (int d = 0; d < 4; ++d) *(unsigned short*)&orp[d * 32] = f2bf(o1[d][r] * rs * sw[d]);
    }
  }
  __syncthreads();
}

DEVI void shiftmix8(const bf16* __restrict__ PJ, size_t R, int pos, int col, const float* __restrict__ mu, float* z) {
  float zc[8], zp[8], zn[8];
  unpack8(*(const u32x4*)&PJ[R * LDP + col], zc);
  if (pos > 0) unpack8(*(const u32x4*)&PJ[(R - 1) * LDP + col], zp); else { for (int j = 0; j < 8; ++j) zp[j] = 0.f; }
  if (pos < SEQ - 1) unpack8(*(const u32x4*)&PJ[(R + 1) * LDP + col], zn); else { for (int j = 0; j < 8; ++j) zn[j] = 0.f; }
#pragma unroll
  for (int j = 0; j < 8; ++j) z[j] = zc[j] + mu[j] * (0.5f * (zp[j] + zn[j]) - zc[j]);
}
DEVI void phase_zl(const Params& p, int l) {
  const bf16* PJ = (const bf16*)(WSV(p) + OFF_U); bf16* ZL = (bf16*)(WSV(p) + OFF_ZL);
  const float* mu = p.tshift_mu + (size_t)l * 1920 + 1536;
  for (int idx = blockIdx.x * NTHR + tid_opaque(); idx < NTOK * 48; idx += gridDim.x * NTHR) {
    const int R = idx / 48, ch = idx % 48, j0 = ch * 8, pos = R & (SEQ - 1);
    float m8[8], z[8];
#pragma unroll
    for (int j = 0; j < 8; ++j) m8[j] = mu[j0 + j];
    shiftmix8(PJ, R, pos, 3072 + j0, m8, z);
    if (j0 < 128) { for (int j = 0; j < 8; ++j) z[j] = tanhf(z[j]); }
    else if (j0 >= 256) { for (int j = 0; j < 8; ++j) z[j] = sigmoidf_(z[j]); }
    *(u32x4*)&ZL[(size_t)R * 384 + j0] = pack8(z);
  }
}

DEVI void phase_mix(const Params& p, int l) {
  bf16* PJm = (bf16*)(WSV(p) + OFF_U); bf16* VV = (bf16*)(WSV(p) + OFF_ZL);
  const float* mu = p.tshift_mu + (size_t)l * 1920;
  for (int idx = blockIdx.x * NTHR + tid_opaque(); idx < NTOK * 192; idx += gridDim.x * NTHR) {
    const int R = idx / 192, col = (idx % 192) * 8, pos = R & (SEQ - 1);
    float m8[8], z[8];
#pragma unroll
    for (int j = 0; j < 8; ++j) m8[j] = mu[col + j];
    shiftmix8(PJm, R, pos, 1536 + col, m8, z);
    if (col < 1024) *(u32x4*)&PJm[(size_t)R * LDP + 512 + col] = pack8(z);
    else *(u32x4*)&VV[(size_t)R * 512 + (col - 1024)] = pack8(z);
  }
}

constexpr int SC_T = 16;
constexpr int SC_DIR = 5 * SC_T * 64 + SC_T * 8;
constexpr int SC_BUF = 2 * SC_DIR;
constexpr int SC_SY = 2 * SC_BUF;
struct ScRaw { u32x2 c0, c1, c2, au, om; };
#define SC_BAR() asm volatile("s_waitcnt lgkmcnt(0)\n\ts_barrier" ::: "memory")
template <int MODE>
DEVI void phase_scan(const Params& p, int l, char* lds) {
  const bf16* PJ = (const bf16*)(WSV(p) + OFF_U);
  const bf16* Aa = (const bf16*)(WSV(p) + OFF_A);
  const _Float16* OM = (const _Float16*)(WSV(p) + OFF_OMW);
  _Float16* YH = (_Float16*)(WSV(p) + OFF_H);
  const bf16* VV = (const bf16*)(WSV(p) + OFF_ZL);
  float* L = (float*)lds;
  const int tid = tid_opaque(), wid = tid >> 6, lane = tid & 63, l16 = lane & 15;
  const bool producer = wid >= 4;
  const int stid = tid & 255;
  const int wdir = (wid >> 1) & 1, rowl = (wid & 1) * 4 + (lane >> 4);
  const int si = stid >> 4, sn = (stid & 15) * 4;
  constexpr int NCH = SEQ / SC_T;
  for (int it = blockIdx.x; it < 256; it += gridDim.x) {
    const int q8 = it & 7, h = (it >> 3) & 7, b = it >> 6;
    const int cbase = h * 64 + sn;
    float kk4[4], ka4[4];
#pragma unroll
    for (int j = 0; j < 4; ++j) { kk4[j] = p.k_k[l * 512 + cbase + j]; ka4[j] = p.k_a[l * 512 + cbase + j]; }
    f32x2 Sa = {0.f, 0.f}, Sb = {0.f, 0.f};
    ScRaw xa0, xb0, xa1, xb1;
#define SC_LOAD(chk_, d_, RW) do { const int s = (chk_) * SC_T + si; const int pos = (d_) ? (SEQ - 1 - s) : s; const size_t R = (size_t)b * SEQ + pos; \
      const bf16* base = PJ + R * LDP + 512 + cbase; \
      RW.c0 = *(const u32x2*)(base); RW.c1 = *(const u32x2*)(base + 512); RW.c2 = *(const u32x2*)(VV + R * 512 + cbase); \
      RW.au = *(const u32x2*)&Aa[(R * 2 + (d_)) * 512 + cbase]; RW.om = *(const u32x2*)&OM[(R * 2 + (d_)) * 512 + cbase]; } while (0)
#define SC_PROC(buf_, d_, RW) do { float* sd = L + (buf_) * SC_BUF + (d_) * SC_DIR; \
      const float rc[4] = {bflo(RW.c0[0]), bfhi(RW.c0[0]), bflo(RW.c0[1]), bfhi(RW.c0[1])}; \
      const float kc[4] = {bflo(RW.c1[0]), bfhi(RW.c1[0]), bflo(RW.c1[1]), bfhi(RW.c1[1])}; \
      const float a4[4] = {bflo(RW.au[0]), bfhi(RW.au[0]), bflo(RW.au[1]), bfhi(RW.au[1])}; \
      typedef _Float16 h4 __attribute__((ext_vector_type(4))); const h4 om = __builtin_bit_cast(h4, RW.om); \
      float kq[4], ssq = 0.f; \
      _Pragma("unroll") for (int j = 0; j < 4; ++j) { kq[j] = kc[j] * kk4[j]; ssq += kq[j] * kq[j]; } \
      ssq = red16(ssq); \
      const float inv = rsqrtf(fmaxf(ssq, 1e-24f)); \
      f32x4 w4, k4, b4, kd4, r4; \
      _Pragma("unroll") for (int j = 0; j < 4; ++j) { const float kap = kq[j] * inv; \
        w4[j] = 1.f - (float)om[j]; k4[j] = kap; b4[j] = kap * a4[j]; kd4[j] = kc[j] * (1.f + (a4[j] - 1.f) * ka4[j]); r4[j] = rc[j]; } \
      const int o = si * 64 + sn; \
      *(f32x4*)&sd[o] = w4; *(f32x4*)&sd[SC_T * 64 + o] = k4; *(f32x4*)&sd[2 * SC_T * 64 + o] = b4; \
      *(f32x4*)&sd[3 * SC_T * 64 + o] = kd4; *(f32x4*)&sd[4 * SC_T * 64 + o] = r4; \
      if ((sn >> 3) == q8) { f32x4 v4 = {bflo(RW.c2[0]), bfhi(RW.c2[0]), bflo(RW.c2[1]), bfhi(RW.c2[1])}; *(f32x4*)&sd[5 * SC_T * 64 + si * 8 + (sn & 7)] = v4; } } while (0)
#define SC_WRITEOUT2(chk_, sb_) do { const int e = stid >> 7, u = stid & 127, i = u >> 3, rl = u & 7; \
      const float* sy = L + SC_SY + (sb_) * (2 * SC_T * 128) + e * (SC_T * 128) + (i * 8 + rl) * 16; \
      const f32x4 q0 = *(const f32x4*)&sy[0], q1 = *(const f32x4*)&sy[4], q2 = *(const f32x4*)&sy[8], q3 = *(const f32x4*)&sy[12]; \
      const float tot = ((q0[0] + q0[1]) + (q0[2] + q0[3])) + ((q1[0] + q1[1]) + (q1[2] + q1[3])) + ((q2[0] + q2[1]) + (q2[2] + q2[3])) + ((q3[0] + q3[1]) + (q3[2] + q3[3])); \
      const int s = (chk_) * SC_T + i; const int pos = e ? (SEQ - 1 - s) : s; \
      YH[((size_t)e * NTOK + (size_t)b * SEQ + pos) * 512 + h * 64 + q8 * 8 + rl] = (_Float16)(tot * 0.0625f); } while (0)
#define SC_WRITEOUT(chk_) SC_WRITEOUT2(chk_, (chk_) & 1)
    if (producer) {
      SC_LOAD(0, 0, xa0); SC_LOAD(0, 1, xb0); SC_PROC(0, 0, xa0); SC_PROC(0, 1, xb0);
      SC_LOAD(1, 0, xa0); SC_LOAD(1, 1, xb0); SC_LOAD(2, 0, xa1); SC_LOAD(2, 1, xb1);
      SC_BAR();
#pragma unroll 1
      for (int chk = 0; chk < NCH; chk += 2) {
        if (MODE != 2) {
        SC_PROC(1, 0, xa0); SC_PROC(1, 1, xb0);
        { const int cw_ = chk > 0 ? chk - 1 : 0; SC_WRITEOUT2(cw_, (chk + 1) & 1); }
        { const int cl_ = chk + 3 < NCH ? chk + 3 : NCH - 1; SC_LOAD(cl_, 0, xa0); SC_LOAD(cl_, 1, xb0); }
        }
        SC_BAR();
        if (MODE != 2) {
        SC_PROC(0, 0, xa1); SC_PROC(0, 1, xb1);
        SC_WRITEOUT2(chk, 0);
        { const int cl_ = chk + 4 < NCH ? chk + 4 : NCH - 1; SC_LOAD(cl_, 0, xa1); SC_LOAD(cl_, 1, xb1); }
        }
        SC_BAR();
      }
      SC_WRITEOUT(NCH - 1);
    } else {
      SC_BAR();
      __builtin_amdgcn_s_setprio(3);
#pragma unroll 1
      for (int chk = 0; chk < NCH; ++chk) {
        const float* cw = L + (chk & 1) * SC_BUF + wdir * SC_DIR;
        float* sy = L + SC_SY + (chk & 1) * (2 * SC_T * 128) + wdir * (SC_T * 128) + rowl * 16 + l16;
        const float* cl = cw + l16 * 4; const float* cv = cw + 5 * SC_T * 64 + rowl;
        f32x4 w4 = *(const f32x4*)&cl[0], k4 = *(const f32x4*)&cl[SC_T * 64], b4 = *(const f32x4*)&cl[2 * SC_T * 64],
              kd4 = *(const f32x4*)&cl[3 * SC_T * 64], r4 = *(const f32x4*)&cl[4 * SC_T * 64];
        float vv = cv[0], ylast = 0.f;
#pragma unroll 4
        for (int i = 0; i < (MODE == 1 ? 0 : SC_T); ++i) {
          if (i > 0) sy[(i - 1) * 128] = ylast;
          f32x4 w4n = w4, k4n = k4, b4n = b4, kd4n = kd4, r4n = r4; float vvn = vv;
          if (i + 1 < SC_T) {
            const int o = (i + 1) * 64;
            w4n = *(const f32x4*)&cl[o]; k4n = *(const f32x4*)&cl[SC_T * 64 + o]; b4n = *(const f32x4*)&cl[2 * SC_T * 64 + o];
            kd4n = *(const f32x4*)&cl[3 * SC_T * 64 + o]; r4n = *(const f32x4*)&cl[4 * SC_T * 64 + o]; vvn = cv[(i + 1) * 8];
          }
          __builtin_amdgcn_sched_barrier(0);
          const f32x2 ka = {k4[0], k4[1]}, kb = {k4[2], k4[3]}, wa = {w4[0], w4[1]}, wb = {w4[2], w4[3]}, ba = {b4[0], b4[1]}, bb = {b4[2], b4[3]};
          const f32x2 kda = {kd4[0], kd4[1]}, kdb = {kd4[2], kd4[3]}, ra = {r4[0], r4[1]}, rb = {r4[2], r4[3]};
          f32x2 t = Sa * ka; t = Sb * kb + t;
          const float sa = red16(t[0] + t[1]);
          const f32x2 ua = kda * vv - ba * sa, ub = kdb * vv - bb * sa;
          Sa = Sa * wa + ua; Sb = Sb * wb + ub;
          f32x2 yy = Sa * ra; yy = Sb * rb + yy;
          ylast = yy[0] + yy[1];
          w4 = w4n; k4 = k4n; b4 = b4n; kd4 = kd4n; r4 = r4n; vv = vvn;
          __builtin_amdgcn_sched_barrier(0);
        }
        sy[(SC_T - 1) * 128] = ylast;
        SC_BAR();
      }
      __builtin_amdgcn_s_setprio(0);
    }
    __syncthreads();
#undef SC_LOAD
#undef SC_PROC
#undef SC_WRITEOUT
#undef SC_WRITEOUT2
  }
}

DEVI void phase_post(const Params& p, int l) {
  bf16* PJ = (bf16*)(WSV(p) + OFF_U);
  const bf16* Aa = (const bf16*)(WSV(p) + OFF_A);
  const bf16* G = (const bf16*)(WSV(p) + OFF_G);
  const _Float16* YH = (const _Float16*)(WSV(p) + OFF_H);
  const int tid = tid_opaque(), wid = tid >> 6, lane = tid & 63, c0 = lane * 8;
  const bf16* VV = (const bf16*)(WSV(p) + OFF_ZL);
  float ka[8], rk[8], lw[8], lb[8];
#pragma unroll
  for (int j = 0; j < 8; ++j) {
    ka[j] = p.k_a[l * 512 + c0 + j]; rk[j] = p.r_k[l * 512 + c0 + j]; lw[j] = p.lnx_w[l * 512 + c0 + j]; lb[j] = p.lnx_b[l * 512 + c0 + j];
  }
  for (int R = blockIdx.x * 8 + wid; R < NTOK; R += gridDim.x * 8) {
    const int pos = R & (SEQ - 1);
    float y[8];
    { typedef _Float16 h8 __attribute__((ext_vector_type(8)));
      const h8 yf = *(const h8*)&YH[(size_t)R * 512 + c0], yb = *(const h8*)&YH[((size_t)NTOK + R) * 512 + c0];
#pragma unroll
      for (int j = 0; j < 8; ++j) y[j] = ((float)yf[j] + (float)yb[j]) * 16.f; }
    float s1 = 0;
#pragma unroll
    for (int j = 0; j < 8; ++j) s1 += y[j];
    const float mean = red8(s1) * (1.f / 64.f);
    float s2 = 0;
#pragma unroll
    for (int j = 0; j < 8; ++j) { y[j] -= mean; s2 += y[j] * y[j]; }
    const float rstd = rsqrtf(red8(s2) * (1.f / 64.f) + 64e-5f);
    float rr[8], kk[8], vv[8], a0[8], a1[8], g8[8];
    unpack8(*(const u32x4*)&PJ[(size_t)R * LDP + 512 + c0], rr);
    unpack8(*(const u32x4*)&PJ[(size_t)R * LDP + 1024 + c0], kk);
    unpack8(*(const u32x4*)&VV[(size_t)R * 512 + c0], vv);
    unpack8(*(const u32x4*)&Aa[((size_t)R * 2 + 0) * 512 + c0], a0);
    unpack8(*(const u32x4*)&Aa[((size_t)R * 2 + 1) * 512 + c0], a1);
    unpack8(*(const u32x4*)&G[(size_t)R * 512 + c0], g8);
#ifdef NAIVE_G
    { const bf16* ZLp = (const bf16*)(WSV(p) + OFF_ZL) + (size_t)R * 384 + 256; const float* g2 = p.gate_g2 + (size_t)l * 128 * 512 + c0;
      for (int j = 0; j < 8; ++j) g8[j] = 0.f;
      for (int k = 0; k < 128; ++k) { const float sv = bf2f(*(const unsigned short*)&ZLp[k]);
        for (int j = 0; j < 8; ++j) g8[j] += sv * g2[(size_t)k * 512 + j]; } }
#endif
#ifdef NAIVE_G2T
    { const bf16* ZLp = (const bf16*)(WSV(p) + OFF_ZL) + (size_t)R * 384 + 256; const bf16* g2t = (const bf16*)(WSV(p) + OFF_G2T) + (size_t)c0 * 128;
      for (int j = 0; j < 8; ++j) g8[j] = 0.f;
      for (int k = 0; k < 128; ++k) { const float sv = bf2f(*(const unsigned short*)&ZLp[k]);
        for (int j = 0; j < 8; ++j) g8[j] += sv * bf2f(*(const unsigned short*)&g2t[(size_t)j * 128 + k]); } }
#endif
#define FIN(x) (fabsf(x) < 1e30f)
#ifdef IGN_Y
    for (int j = 0; j < 8; ++j) y[j] = 0.01f * j;
#endif
#ifdef IGN_A
    for (int j = 0; j < 8; ++j) { a0[j] = 0.5f; a1[j] = 0.5f; }
#endif
#ifdef IGN_G
    for (int j = 0; j < 8; ++j) { g8[j] = 1.f; }
#endif
#ifdef IGN_RKV
    for (int j = 0; j < 8; ++j) { rr[j] = 0.1f; kk[j] = 0.1f; vv[j] = 0.1f; }
#endif
#ifdef SAN_Y
    for (int j = 0; j < 8; ++j) if (!FIN(y[j])) y[j] = 0.f;
#endif
#ifdef SAN_A
    for (int j = 0; j < 8; ++j) { if (!FIN(a0[j])) a0[j] = 0.f; if (!FIN(a1[j])) a1[j] = 0.f; }
#endif
#ifdef SAN_G
    for (int j = 0; j < 8; ++j) if (!FIN(g8[j])) g8[j] = 0.f;
#endif
#ifdef SAN_RKV
    for (int j = 0; j < 8; ++j) { if (!FIN(rr[j])) rr[j] = 0.f; if (!FIN(kk[j])) kk[j] = 0.f; if (!FIN(vv[j])) vv[j] = 0.f; }
#endif
    float bs = 0;
#pragma unroll
    for (int j = 0; j < 8; ++j) {
      const float kds = kk[j] * ((1.f + (a0[j] - 1.f) * ka[j]) + (1.f + (a1[j] - 1.f) * ka[j]));
      bs += rr[j] * kds * rk[j];
    }
    bs = red8(bs);
    float o[8];
#pragma unroll
    for (int j = 0; j < 8; ++j) o[j] = (y[j] * rstd * lw[j] + lb[j] + bs * vv[j]) * g8[j];
    *(u32x4*)&PJ[(size_t)R * LDP + 512 + c0] = pack8(o);
  }
}

#define WT_IN ((bf16*)(WSV(p) + OFF_WT_IN))
#define WT_OUT ((bf16*)(WSV(p) + OFF_WT_OUT))
#define WT_UP ((bf16*)(WSV(p) + OFF_WT_UP))
#define WT_DOWN ((bf16*)(WSV(p) + OFF_WT_DOWN))
#define W2T ((bf16*)(WSV(p) + OFF_W2T))
#define A2T ((bf16*)(WSV(p) + OFF_A2T))
#define G2T ((bf16*)(WSV(p) + OFF_G2T))
#define PJ ((bf16*)(WSV(p) + OFF_U))
#define U PJ
#define ZL ((bf16*)(WSV(p) + OFF_ZL))
#define H ((bf16*)(WSV(p) + OFF_H))
#define OMW ((_Float16*)(WSV(p) + OFF_OMW))
#define AA ((bf16*)(WSV(p) + OFF_A))
#define GG ((bf16*)(WSV(p) + OFF_G))
#define MODP ((const float*)(WSV(p) + OFF_MOD))
#define cosT ((const float*)(WSV(p) + OFF_COS))
#define sinT ((const float*)(WSV(p) + OFF_SIN))
__global__ void __launch_bounds__(NTHR) fwd_megakernel(Params p) {
  extern __shared__ __attribute__((aligned(16))) char lds[];
  cg::grid_group grid = cg::this_grid();
  const int nb = gridDim.x, bid = blockIdx.x;
  unsigned* gbar = (unsigned*)(p.ws + OFF_BAR); unsigned gtarget = 0;
  grid.sync();
  phase_mod(p, lds);
  phase_rope(p);
  phase_conv(p, 0, lds);
  GSYNC();

  for (int l = 0; l < 2; ++l) {
    const float* xin = (l == 0) ? p.x : p.out;
    const float* modl = launder(MODP + (size_t)l * 4 * 6144);
    if (l > 0) phase_conv(p, l, lds);
    phase_norm(xin, p.norm1 + l * DM, modl, 0, 1024, H);
    GSYNC();
#ifdef REP_G1
    for (int rep = 0; rep < 2; ++rep)
#endif
    for (int it = bid; it < 128 * 14; it += nb) {
      const int mt = it / 14, nt = it % 14;
      gemm_tile(H, DM, WT_IN, DM, DM, mt * 256, nt * 256, lds,
        [&](f32x16& c0, f32x16& c1, f32x16& c2, f32x16& c3, int m, int nw, int hi) {
          if (nw >= LDP) return;
          bf16* dst = PJ + (size_t)m * LDP + nw + 4 * hi;
          if (nw < 1024) {
            const int pos = m & (SEQ - 1);
            const float* ct = cosT + pos * 32 + 4 * hi; const float* st = sinT + pos * 32 + 4 * hi;
#pragma unroll
            for (int g = 0; g < 4; ++g) {
              const f32x4 cs = *(const f32x4*)(ct + 8 * g), sn = *(const f32x4*)(st + 8 * g);
              *(u32x2*)(dst + 8 * g) = pk4(c0[4 * g] * cs[0] - c1[4 * g] * sn[0], c0[4 * g + 1] * cs[1] - c1[4 * g + 1] * sn[1],
                                           c0[4 * g + 2] * cs[2] - c1[4 * g + 2] * sn[2], c0[4 * g + 3] * cs[3] - c1[4 * g + 3] * sn[3]);
              *(u32x2*)(dst + 32 + 8 * g) = pk4(c0[4 * g] * sn[0] + c1[4 * g] * cs[0], c0[4 * g + 1] * sn[1] + c1[4 * g + 1] * cs[1],
                                                c0[4 * g + 2] * sn[2] + c1[4 * g + 2] * cs[2], c0[4 * g + 3] * sn[3] + c1[4 * g + 3] * cs[3]);
              *(u32x2*)(dst + 64 + 8 * g) = pk4(c2[4 * g] * cs[0] - c3[4 * g] * sn[0], c2[4 * g + 1] * cs[1] - c3[4 * g + 1] * sn[1],
                                                c2[4 * g + 2] * cs[2] - c3[4 * g + 2] * sn[2], c2[4 * g + 3] * cs[3] - c3[4 * g + 3] * sn[3]);
              *(u32x2*)(dst + 96 + 8 * g) = pk4(c2[4 * g] * sn[0] + c3[4 * g] * cs[0], c2[4 * g + 1] * sn[1] + c3[4 * g + 1] * cs[1],
                                                c2[4 * g + 2] * sn[2] + c3[4 * g + 2] * cs[2], c2[4 * g + 3] * sn[3] + c3[4 * g + 3] * cs[3]);
            }
          } else {
#pragma unroll
            for (int g = 0; g < 4; ++g) {
              *(u32x2*)(dst + 8 * g) = pk4(c0[4 * g], c0[4 * g + 1], c0[4 * g + 2], c0[4 * g + 3]);
              *(u32x2*)(dst + 32 + 8 * g) = pk4(c1[4 * g], c1[4 * g + 1], c1[4 * g + 2], c1[4 * g + 3]);
              *(u32x2*)(dst + 64 + 8 * g) = pk4(c2[4 * g], c2[4 * g + 1], c2[4 * g + 2], c2[4 * g + 3]);
              *(u32x2*)(dst + 96 + 8 * g) = pk4(c3[4 * g], c3[4 * g + 1], c3[4 * g + 2], c3[4 * g + 3]);
            }
          }
        });
    }
    GSYNC();
    phase_zl(p, l);
    {
      float s1 = 0, s2 = 0;
      for (int i = 0; i < 64; ++i) { s1 += p.lam_q1[l * 64 + i] * p.lam_k1[l * 64 + i]; s2 += p.lam_q2[l * 64 + i] * p.lam_k2[l * 64 + i]; }
      const float lam_init = 0.8f - 0.6f * expf(-0.3f * (float)l);
      const float lam = expf(s1) - expf(s2) + lam_init;
#ifndef SKIP_ATT
#ifdef REP_ATT
      for (int rep = 0; rep < 2; ++rep) {
      const bool dst_ = rep == 1;
#else
      { const bool dst_ = true;
#endif
      if (nb == 256) {
        const int xcd = bid & 7, jj = bid >> 3;
#pragma unroll 1
        for (int i4 = 0; i4 < 4; ++i4) {
          {
            const int bh = xcd + 8 * (i4 >> 1), qb = jj + 32 * (i4 & 1);
            attn_item(PJ, bh >> 2, bh & 3, qb, lam, 1.f - lam_init, p.subln_w + l * 128, lds, dst_);
          }
        }
      } else {
#pragma unroll 1
        for (int it = bid; it < 1024; it += nb) attn_item(PJ, it >> 8, (it >> 6) & 3, it & 63, lam, 1.f - lam_init, p.subln_w + l * 128, lds, dst_);
      }
      }
#endif
    }
    GSYNC();
    for (int it = bid; it < 5 * 256; it += nb) {
      const int g = it / 256, t = it % 256, mt = t >> 1, nt = t & 1, d = g & 1;
      const bf16* Ap; const bf16* Bp; int ldb, KK;
      if (g < 2) { Ap = ZL + d * 64; Bp = W2T + d * 512 * 64; ldb = 64; KK = 64; }
      else if (g < 4) { Ap = ZL + 128 + d * 64; Bp = A2T + d * 512 * 64; ldb = 64; KK = 64; }
      else { Ap = ZL + 256; Bp = G2T; ldb = 128; KK = 128; }
      const float* w0 = p.decay_w0 + (size_t)(l * 2 + d) * 512; const float* a0 = p.icl_a0 + (size_t)(l * 2 + d) * 512;
      gemm_tile(Ap, 384, Bp, ldb, KK, mt * 256, nt * 256, lds,
        [&](f32x16& c0, f32x16& c1, f32x16& c2, f32x16& c3, int m, int nw, int hi) {
          auto tile_ = [&](const f32x16& c, const int j) {
#pragma unroll
            for (int gq = 0; gq < 4; ++gq) {
              const int col = nw + 32 * j + 8 * gq + 4 * hi;
              float o[4];
              if (g < 2) {
                const f32x4 w0c = *(const f32x4*)&w0[col];
#pragma unroll
                for (int e = 0; e < 4; ++e) {
                  const float nx = -(c[4 * gq + e] + w0c[e]);
                  const float sp = fmaxf(nx, 0.f) + __logf(1.f + __expf(-fabsf(nx)));
                  const float ee = __expf(-sp - 0.5f);
                  o[e] = ee < 0.03125f ? ee * (1.f - ee * (0.5f - ee * (1.f / 6.f - ee * (1.f / 24.f)))) : 1.f - __expf(-ee);
                }
                typedef _Float16 h4 __attribute__((ext_vector_type(4)));
                h4 hv = {(_Float16)o[0], (_Float16)o[1], (_Float16)o[2], (_Float16)o[3]};
                *(h4*)&OMW[((size_t)m * 2 + d) * 512 + col] = hv;
              } else if (g < 4) {
                const f32x4 a0c = *(const f32x4*)&a0[col];
#pragma unroll
                for (int e = 0; e < 4; ++e) o[e] = 1.f / (1.f + __expf(-(c[4 * gq + e] + a0c[e])));
                *(u32x2*)&AA[((size_t)m * 2 + d) * 512 + col] = pk4(o[0], o[1], o[2], o[3]);
              } else {
                *(u32x2*)&GG[(size_t)m * 512 + col] = pk4(c[4 * gq], c[4 * gq + 1], c[4 * gq + 2], c[4 * gq + 3]);
              }
            }
                    };
          tile_(c0, 0); tile_(c1, 1); tile_(c2, 2); tile_(c3, 3);

        });
    }
    GSYNC();
    phase_mix(p, l);
    GSYNC();
#ifndef SKIP_SCAN
#ifdef REP_SCAN
    phase_scan<REP_SCAN>(p, l, lds);
#endif
    phase_scan<0>(p, l, lds);
#endif
    GSYNC();
#ifndef SKIP_POST
    phase_post(p, l);
#endif
    GSYNC();
    for (int it = bid; it < 128 * 4; it += nb) {
      const int mt = it >> 2, nt = it & 3;
      gemm_tile(PJ, LDP, WT_OUT, DM, DM, mt * 256, nt * 256, lds,
        [&](f32x16& c0, f32x16& c1, f32x16& c2, f32x16& c3, int m, int nw, int hi) {
          const int b = m >> 13; const float* gt = modl + b * 6144 + 2048 + nw + 4 * hi;
          const float* xi = xin + (size_t)m * DM + nw + 4 * hi; float* xo = p.out + (size_t)m * DM + nw + 4 * hi;
          auto tile_ = [&](const f32x16& c, const int j) {
#pragma unroll
            for (int g = 0; g < 4; ++g) {
              const f32x4 x4 = *(const f32x4*)(xi + 32 * j + 8 * g), g4 = *(const f32x4*)(gt + 32 * j + 8 * g);
              f32x4 o = {x4[0] + g4[0] * c[4 * g], x4[1] + g4[1] * c[4 * g + 1], x4[2] + g4[2] * c[4 * g + 2], x4[3] + g4[3] * c[4 * g + 3]};
              *(f32x4*)(xo + 32 * j + 8 * g) = o;
            }
                    };
          tile_(c0, 0); tile_(c1, 1); tile_(c2, 2); tile_(c3, 3);

        });
    }
    GSYNC();
    phase_norm(p.out, p.norm2 + l * DM, modl, 3072, 4096, H);
    GSYNC();
#ifdef REP_UP
    for (int rep = 0; rep < 2; ++rep)
#endif
    for (int it = bid; it < 128 * 16; it += nb) {
      const int mt = it >> 4, nt = it & 15;
      gemm_tile(H, DM, WT_UP, DM, DM, mt * 256, nt * 256, lds,
        [&](f32x16& c0, f32x16& c1, f32x16& c2, f32x16& c3, int m, int nw, int hi) {
          bf16* dst = U + (size_t)m * DFF + nw + 4 * hi;
          auto tile_ = [&](const f32x16& c, const int j) {
#pragma unroll
            for (int g = 0; g < 4; ++g) {
              const float u0 = fmaxf(c[4 * g], 0.f), u1 = fmaxf(c[4 * g + 1], 0.f), u2 = fmaxf(c[4 * g + 2], 0.f), u3 = fmaxf(c[4 * g + 3], 0.f);
              *(u32x2*)(dst + 32 * j + 8 * g) = pk4(u0 * u0, u1 * u1, u2 * u2, u3 * u3);
            }
                    };
          tile_(c0, 0); tile_(c1, 1); tile_(c2, 2); tile_(c3, 3);

        });
    }
    GSYNC();
    for (int it = bid; it < 128 * 4; it += nb) {
      const int mt = it >> 2, nt = it & 3;
      gemm_tile(U, DFF, WT_DOWN, DFF, DFF, mt * 256, nt * 256, lds,
        [&](f32x16& c0, f32x16& c1, f32x16& c2, f32x16& c3, int m, int nw, int hi) {
          const int b = m >> 13; const float* gt = modl + b * 6144 + 5120 + nw + 4 * hi;
          float* xo = p.out + (size_t)m * DM + nw + 4 * hi;
          auto tile_ = [&](const f32x16& c, const int j) {
#pragma unroll
            for (int g = 0; g < 4; ++g) {
              const f32x4 x4 = *(const f32x4*)(xo + 32 * j + 8 * g), g4 = *(const f32x4*)(gt + 32 * j + 8 * g);
              f32x4 o = {x4[0] + g4[0] * c[4 * g], x4[1] + g4[1] * c[4 * g + 1], x4[2] + g4[2] * c[4 * g + 2], x4[3] + g4[3] * c[4 * g + 3]};
              *(f32x4*)(xo + 32 * j + 8 * g) = o;
            }
                    };
          tile_(c0, 0); tile_(c1, 1); tile_(c2, 2); tile_(c3, 3);

        });
    }
    GSYNC();
  }
  phase_final_norm(p.out, p.norm_f);
}

extern "C" void kernel_launch(void* const* d_in, const int* in_sizes, int n_in, void* d_out, int out_size, void* d_ws, size_t ws_size,
                              hipStream_t stream) {
  static int grid_blocks = 0;
  if (n_in != 27 || ws_size < WS_NEED) { fprintf(stderr, "kernel_launch: bad n_in %d or ws_size %zu (< %zu)\n", n_in, ws_size, (size_t)WS_NEED); return; }
  if (!grid_blocks) {
    int dev = 0, cus = 0, per_cu = 0;
    hipGetDevice(&dev);
    hipDeviceGetAttribute(&cus, hipDeviceAttributeMultiprocessorCount, dev);
    hipFuncSetAttribute((const void*)fwd_megakernel, hipFuncAttributeMaxDynamicSharedMemorySize, LDS_BYTES);
    hipOccupancyMaxActiveBlocksPerMultiprocessor(&per_cu, fwd_megakernel, NTHR, LDS_BYTES);
    if (per_cu < 1) per_cu = 1;
    if (per_cu > 1) per_cu = 1;
    grid_blocks = cus * per_cu;
  }
  Params p{};
  const float** pp = (const float**)&p;
  for (int i = 0; i < 27; ++i) pp[i] = (const float*)d_in[i];
  p.out = (float*)d_out; p.ws = (char*)d_ws;
  for (int i = 0; i < 32; ++i) p.inv_freq[i] = 1.0f / powf(10000.0f, (float)(2 * i) / 64.0f);
  hipMemsetAsync((char*)d_ws + OFF_BAR, 0, 256, stream);
  void* args[] = {&p};
  hipError_t e = hipLaunchCooperativeKernel((void*)fwd_megakernel, dim3(grid_blocks), dim3(NTHR), args, LDS_BYTES, stream);
  if (e != hipSuccess) fprintf(stderr, "cooperative launch failed: %s (grid %d)\n", hipGetErrorString(e), grid_blocks);
}
```

```cpp
#include <hip/hip_runtime.h>
#include <hip/hip_bf16.h>
#include <hip/hip_cooperative_groups.h>
#include <cstdio>
#include <cmath>
namespace cg = cooperative_groups;

#define DEVI __device__ __forceinline__
using bf16 = __hip_bfloat16;
typedef short bf16x8 __attribute__((ext_vector_type(8)));
typedef short s16x4 __attribute__((ext_vector_type(4)));
typedef float f32x16 __attribute__((ext_vector_type(16)));
typedef float f32x4 __attribute__((ext_vector_type(4)));
typedef unsigned u32x4 __attribute__((ext_vector_type(4)));
typedef unsigned u32x2 __attribute__((ext_vector_type(2)));
typedef float f32x2 __attribute__((ext_vector_type(2)));

constexpr int NTOK = 32768, SEQ = 8192, DM = 1024, LDP = 3456, DFF = 4096;
constexpr int NTHR = 512;
constexpr size_t MiB = 1024 * 1024;
constexpr size_t OFF_WT_IN = 0;
constexpr size_t OFF_WT_OUT = OFF_WT_IN + (size_t)3456 * 1024 * 2;
constexpr size_t OFF_WT_UP = OFF_WT_OUT + (size_t)1024 * 1024 * 2;
constexpr size_t OFF_WT_DOWN = OFF_WT_UP + (size_t)4096 * 1024 * 2;
constexpr size_t OFF_W2T = OFF_WT_DOWN + (size_t)4096 * 1024 * 2;
constexpr size_t OFF_A2T = OFF_W2T + (size_t)2 * 512 * 64 * 2;
constexpr size_t OFF_G2T = OFF_A2T + (size_t)2 * 512 * 64 * 2;
constexpr size_t OFF_U = 26 * MiB;
constexpr size_t OFF_ZL = OFF_U + 216 * MiB;
constexpr size_t OFF_H = OFF_U + 256 * MiB;
constexpr size_t OFF_OMW = OFF_H + 64 * MiB;
constexpr size_t OFF_A = OFF_OMW + 64 * MiB;
constexpr size_t OFF_G = OFF_A + 64 * MiB;
constexpr size_t OFF_MOD = OFF_G + 32 * MiB;
constexpr size_t OFF_COS = OFF_MOD + 1 * MiB;
constexpr size_t OFF_SIN = OFF_COS + 1 * MiB;
constexpr size_t OFF_BAR = OFF_SIN + 1 * MiB;
constexpr size_t WS_NEED = OFF_BAR + 1 * MiB;
constexpr int LDS_BYTES = 131072;

struct Params {
  const float *x, *c, *w_ada, *b_ada, *norm1, *norm2, *w_in, *w_out, *lam_q1, *lam_k1, *lam_q2, *lam_k2, *subln_w, *tshift_mu,
      *decay_w0, *decay_w2, *icl_a0, *icl_a2, *gate_g2, *k_k, *k_a, *r_k, *lnx_w, *lnx_b, *w_up, *w_down, *norm_f;
  float* out;
  char* ws;
  float inv_freq[32];
};

DEVI void grid_barrier(unsigned* bar, unsigned& target) {
  asm volatile("s_waitcnt vmcnt(0) lgkmcnt(0)" ::: "memory");
  __syncthreads();
  target += gridDim.x;
  if (threadIdx.x == 0) {
    __builtin_amdgcn_fence(__ATOMIC_RELEASE, "agent");
    asm volatile("s_waitcnt vmcnt(0)" ::: "memory");
    __hip_atomic_fetch_add(bar, 1u, __ATOMIC_RELAXED, __HIP_MEMORY_SCOPE_AGENT);
    while (__hip_atomic_load(bar, __ATOMIC_RELAXED, __HIP_MEMORY_SCOPE_AGENT) < target) __builtin_amdgcn_s_sleep(2);
    __builtin_amdgcn_fence(__ATOMIC_ACQUIRE, "agent");
    asm volatile("s_waitcnt vmcnt(0)" ::: "memory");
  }
  __syncthreads();
}
#define GSYNC() grid_barrier(gbar, gtarget)
struct Params;
#define SBAR() __builtin_amdgcn_sched_barrier(0)
#define GAS __attribute__((address_space(1)))
#define LAS __attribute__((address_space(3)))
template <class T> DEVI T* launder(T* q) { unsigned long long u = (unsigned long long)q; asm volatile("" : "+v"(u)); return (T*)(GAS T*)u; }
DEVI char* ws_launder(char* w) { return launder(w); }
#define WSV(p) ws_launder((p).ws)
DEVI int tid_opaque() { int t = threadIdx.x; asm volatile("" : "+v"(t)); return t; }
DEVI int crow(int r, int hi) { return (r & 3) + 8 * (r >> 2) + 4 * hi; }
DEVI unsigned cvtpk(float lo, float hi) {
  unsigned r; asm volatile("v_cvt_pk_bf16_f32 %0, %1, %2" : "=v"(r) : "v"(lo), "v"(hi)); return r;
}
DEVI unsigned short f2bf(float x) { return (unsigned short)(cvtpk(x, 0.f) & 0xffffu); }
DEVI float bf2f(unsigned short u) { return __uint_as_float(((unsigned)u) << 16); }
DEVI float bflo(unsigned u) { return __uint_as_float(u << 16); }
DEVI float bfhi(unsigned u) { return __uint_as_float(u & 0xffff0000u); }
template <int CTRL> DEVI float dppf(float x) {
  return __builtin_bit_cast(float, __builtin_amdgcn_mov_dpp(__builtin_bit_cast(int, x), CTRL, 0xf, 0xf, true));
}
DEVI float red8(float x) { x += dppf<0xB1>(x); x += dppf<0x4E>(x); x += dppf<0x141>(x); return x; }
DEVI float red16(float x) { x = red8(x); x += dppf<0x128>(x); return x; }
DEVI float red64(float x) { x = red16(x); x += __shfl_xor(x, 16); x += __shfl_xor(x, 32); return x; }
DEVI float sigmoidf_(float x) { return 1.f / (1.f + __expf(-x)); }
DEVI void unpack8(u32x4 v, float* f) {
  f[0] = bflo(v[0]); f[1] = bfhi(v[0]); f[2] = bflo(v[1]); f[3] = bfhi(v[1]);
  f[4] = bflo(v[2]); f[5] = bfhi(v[2]); f[6] = bflo(v[3]); f[7] = bfhi(v[3]);
}
DEVI u32x4 pack8(const float* f) {
  u32x4 w = {cvtpk(f[0], f[1]), cvtpk(f[2], f[3]), cvtpk(f[4], f[5]), cvtpk(f[6], f[7])}; return w;
}

DEVI void phase_mod(const Params& p, char* lds) {
  float* sc = (float*)lds;
  float* red = sc + 4096;
  const int tid = tid_opaque(), w = tid >> 6, lane = tid & 63;
  for (int i = tid; i < 4096; i += NTHR) { float v = p.c[i]; sc[i] = v / (1.f + expf(-v)); }
  __syncthreads();
  float* mod = (float*)(WSV(p) + OFF_MOD);
  for (int it = blockIdx.x; it < 192; it += gridDim.x) {
    const int l = it / 96, col = (it % 96) * 64 + lane;
    const float* W = p.w_ada + (size_t)l * 1024 * 6144 + col;
    float a0 = 0, a1 = 0, a2 = 0, a3 = 0;
    for (int k = w * 128; k < w * 128 + 128; ++k) {
      float wv = W[(size_t)k * 6144];
      a0 += sc[k] * wv; a1 += sc[1024 + k] * wv; a2 += sc[2048 + k] * wv; a3 += sc[3072 + k] * wv;
    }
    red[(w * 4 + 0) * 64 + lane] = a0; red[(w * 4 + 1) * 64 + lane] = a1;
    red[(w * 4 + 2) * 64 + lane] = a2; red[(w * 4 + 3) * 64 + lane] = a3;
    __syncthreads();
    if (tid < 256) {
      const int bb = tid >> 6; float s = 0;
      for (int ww = 0; ww < 8; ++ww) s += red[(ww * 4 + bb) * 64 + lane];
      mod[(l * 4 + bb) * 6144 + col] = s + p.b_ada[l * 6144 + col];
    }
    __syncthreads();
  }
}

DEVI void phase_rope(const Params& p) {
  float* cosT = (float*)(WSV(p) + OFF_COS); float* sinT = (float*)(WSV(p) + OFF_SIN);
  for (int idx = blockIdx.x * NTHR + tid_opaque(); idx < SEQ * 32; idx += gridDim.x * NTHR) {
    const int pos = idx >> 5, i = idx & 31;
    const float ang = (float)pos * p.inv_freq[i];
    double q = (double)ang * 0.15915494309189533577; q -= floor(q);
    const float f = (float)q;
    cosT[idx] = __builtin_amdgcn_cosf(f); sinT[idx] = __builtin_amdgcn_sinf(f);
  }
}

DEVI void conv_tile(const float* __restrict__ src, int ldsrc, bf16* __restrict__ dst, int lddst, int k0, int n0, float* tile) {
  const int tid = tid_opaque();
#pragma unroll
  for (int ps = 0; ps < 2; ++ps) {
    const int k = ps * 32 + (tid >> 4), n = (tid & 15) * 4;
    const f32x4 v = *(const f32x4*)&src[(size_t)(k0 + k) * ldsrc + n0 + n];
    tile[k * 65 + n + 0] = v[0]; tile[k * 65 + n + 1] = v[1]; tile[k * 65 + n + 2] = v[2]; tile[k * 65 + n + 3] = v[3];
  }
  __syncthreads();
  {
    const int n = tid >> 3, kc = (tid & 7) * 8; float f[8];
#pragma unroll
    for (int j = 0; j < 8; ++j) f[j] = tile[(kc + j) * 65 + n];
    *(u32x4*)&dst[(size_t)(n0 + n) * lddst + k0 + kc] = pack8(f);
  }
  __syncthreads();
}
DEVI void phase_conv(const Params& p, int l, char* lds) {
  float* tile = (float*)lds;
  for (int it = blockIdx.x; it < 3216; it += gridDim.x) {
    const float* src; bf16* dst; int K, N, t = it;
    char* wsb = launder(p.ws);
    if (t < 864) { src = p.w_in + (size_t)l * 1024 * 3456; dst = (bf16*)(wsb + OFF_WT_IN); K = 1024; N = 3456; }
    else if ((t -= 864) < 256) { src = p.w_out + (size_t)l * 1024 * 1024; dst = (bf16*)(wsb + OFF_WT_OUT); K = 1024; N = 1024; }
    else if ((t -= 256) < 1024) { src = p.w_up + (size_t)l * 1024 * 4096; dst = (bf16*)(wsb + OFF_WT_UP); K = 1024; N = 4096; }
    else if ((t -= 1024) < 1024) { src = p.w_down + (size_t)l * 4096 * 1024; dst = (bf16*)(wsb + OFF_WT_DOWN); K = 4096; N = 1024; }
    else if ((t -= 1024) < 16) { const int d = t >> 3; t &= 7; src = p.decay_w2 + (size_t)(l * 2 + d) * 64 * 512; dst = (bf16*)(wsb + OFF_W2T) + d * 512 * 64; K = 64; N = 512; }
    else if ((t -= 16) < 16) { const int d = t >> 3; t &= 7; src = p.icl_a2 + (size_t)(l * 2 + d) * 64 * 512; dst = (bf16*)(wsb + OFF_A2T) + d * 512 * 64; K = 64; N = 512; }
    else { t -= 16; src = p.gate_g2 + (size_t)l * 128 * 512; dst = (bf16*)(wsb + OFF_G2T); K = 128; N = 512; }
    const int nt = N / 64; const int kt = t / nt, ntile = t % nt;
    conv_tile(src, N, dst, K, kt * 64, ntile * 64, tile);
  }
}

DEVI void phase_norm(const float* __restrict__ xin, const float* __restrict__ g, const float* __restrict__ modl, int shoff, int scoff,
                     bf16* __restrict__ H) {
  const int tid = tid_opaque(), w = tid >> 6, lane = tid & 63;
  for (int row = blockIdx.x * 8 + w; row < NTOK; row += gridDim.x * 8) {
    const int b = row >> 13; f32x4 v[4]; float ss = 0;
#pragma unroll
    for (int j = 0; j < 4; ++j) { v[j] = *(const f32x4*)&xin[(size_t)row * DM + j * 256 + lane * 4]; ss += v[j][0] * v[j][0] + v[j][1] * v[j][1] + v[j][2] * v[j][2] + v[j][3] * v[j][3]; }
    ss = red64(ss);
    const float rstd = rsqrtf(ss * (1.f / 1024.f) + 1e-6f);
#pragma unroll
    for (int j = 0; j < 4; ++j) {
      const int col = j * 256 + lane * 4;
      const f32x4 g4 = *(const f32x4*)&g[col];
      const f32x4 sc4 = *(const f32x4*)&modl[b * 6144 + scoff + col];
      const f32x4 sh4 = *(const f32x4*)&modl[b * 6144 + shoff + col];
      float o[4];
#pragma unroll
      for (int e = 0; e < 4; ++e) o[e] = v[j][e] * rstd * g4[e] * (1.f + sc4[e]) + sh4[e];
      u32x2 pk = {cvtpk(o[0], o[1]), cvtpk(o[2], o[3])};
      *(u32x2*)&H[(size_t)row * DM + col] = pk;
    }
  }
}
DEVI void phase_final_norm(float* __restrict__ x, const float* __restrict__ g) {
  const int tid = tid_opaque(), w = tid >> 6, lane = tid & 63;
  for (int row = blockIdx.x * 8 + w; row < NTOK; row += gridDim.x * 8) {
    f32x4 v[4]; float ss = 0;
#pragma unroll
    for (int j = 0; j < 4; ++j) { v[j] = *(const f32x4*)&x[(size_t)row * DM + j * 256 + lane * 4]; ss += v[j][0] * v[j][0] + v[j][1] * v[j][1] + v[j][2] * v[j][2] + v[j][3] * v[j][3]; }
    ss = red64(ss);
    const float rstd = rsqrtf(ss * (1.f / 1024.f) + 1e-6f);
#pragma unroll
    for (int j = 0; j < 4; ++j) {
      const int col = j * 256 + lane * 4;
      const f32x4 g4 = *(const f32x4*)&g[col];
      f32x4 o = {v[j][0] * rstd * g4[0], v[j][1] * rstd * g4[1], v[j][2] * rstd * g4[2], v[j][3] * rstd * g4[3]};
#ifdef SANITIZE
      for (int e = 0; e < 4; ++e) if (!(fabsf(o[e]) < 1e30f)) o[e] = 0.f;
#endif
      *(f32x4*)&x[(size_t)row * DM + col] = o;
    }
  }
}

template <class Epi>
DEVI void gemm_tile(const bf16* __restrict__ A, int lda, const bf16* __restrict__ Bt, int ldb, int K, int m0, int n0, char* lds, Epi&& epi) {
  const int tid = tid_opaque(), wid = tid >> 6, lane = tid & 63, r32 = lane & 31, hi = lane >> 5;
  const int wm = wid >> 1, wn = wid & 1;
  char* As = lds; char* Bs = lds + 65536;
  f32x16 acc00 = {}, acc01 = {}, acc02 = {}, acc03 = {}, acc10 = {}, acc11 = {}, acc12 = {}, acc13 = {};
  const int lrow = tid >> 3, lch = tid & 7, gch = lch ^ ((lrow >> 1) & 7);
  const bf16* Ag = A + (size_t)(m0 + lrow) * lda + gch * 8;
  const bf16* Bg = Bt + (size_t)(n0 + lrow) * ldb + gch * 8;
#define GLDS(buf, k0) do { char* a_ = As + (buf) * 32768 + wid * 1024; char* b_ = Bs + (buf) * 32768 + wid * 1024; \
    _Pragma("unroll") for (int i_ = 0; i_ < 4; ++i_) { \
      __builtin_amdgcn_global_load_lds((const GAS unsigned*)(Ag + (size_t)(64 * i_) * lda + (k0)), (LAS unsigned*)(a_ + i_ * 8192), 16, 0, 0); \
      __builtin_amdgcn_global_load_lds((const GAS unsigned*)(Bg + (size_t)(64 * i_) * ldb + (k0)), (LAS unsigned*)(b_ + i_ * 8192), 16, 0, 0); } } while (0)
  const int KT = K >> 6;
  const int arow0 = wm * 64 + r32, arow1 = arow0 + 32, brow0 = wn * 128 + r32;
  const int asw = (arow0 >> 1) & 7;
  const int bsw = (brow0 >> 1) & 7;
  GLDS(0, 0); asm volatile("s_waitcnt vmcnt(0)" ::: "memory"); __syncthreads();
#pragma unroll 2
  for (int kt = 0; kt < KT; ++kt) {
    if (kt + 1 < KT) GLDS((kt + 1) & 1, (kt + 1) * 64);
    const char* Ab = As + (kt & 1) * 32768; const char* Bb = Bs + (kt & 1) * 32768;
#define FRAGS(KK, A0, A1, B0, B1, B2, B3) do { const int ch_ = (KK) * 2 + hi; \
      A0 = *(const bf16x8*)(Ab + arow0 * 128 + ((ch_ ^ asw) * 16)); A1 = *(const bf16x8*)(Ab + arow1 * 128 + ((ch_ ^ asw) * 16)); \
      B0 = *(const bf16x8*)(Bb + brow0 * 128 + ((ch_ ^ bsw) * 16)); B1 = *(const bf16x8*)(Bb + (brow0 + 32) * 128 + ((ch_ ^ bsw) * 16)); \
      B2 = *(const bf16x8*)(Bb + (brow0 + 64) * 128 + ((ch_ ^ bsw) * 16)); B3 = *(const bf16x8*)(Bb + (brow0 + 96) * 128 + ((ch_ ^ bsw) * 16)); } while (0)
#define MMAS(A0, A1, B0, B1, B2, B3) do { \
      acc00 = __builtin_amdgcn_mfma_f32_32x32x16_bf16(B0, A0, acc00, 0, 0, 0); acc01 = __builtin_amdgcn_mfma_f32_32x32x16_bf16(B1, A0, acc01, 0, 0, 0); \
      acc02 = __builtin_amdgcn_mfma_f32_32x32x16_bf16(B2, A0, acc02, 0, 0, 0); acc03 = __builtin_amdgcn_mfma_f32_32x32x16_bf16(B3, A0, acc03, 0, 0, 0); \
      acc10 = __builtin_amdgcn_mfma_f32_32x32x16_bf16(B0, A1, acc10, 0, 0, 0); acc11 = __builtin_amdgcn_mfma_f32_32x32x16_bf16(B1, A1, acc11, 0, 0, 0); \
      acc12 = __builtin_amdgcn_mfma_f32_32x32x16_bf16(B2, A1, acc12, 0, 0, 0); acc13 = __builtin_amdgcn_mfma_f32_32x32x16_bf16(B3, A1, acc13, 0, 0, 0); } while (0)
    {
      bf16x8 xa0, xa1, xb0, xb1, xb2, xb3, ya0, ya1, yb0, yb1, yb2, yb3;
      FRAGS(0, xa0, xa1, xb0, xb1, xb2, xb3);
      FRAGS(1, ya0, ya1, yb0, yb1, yb2, yb3); SBAR();
      MMAS(xa0, xa1, xb0, xb1, xb2, xb3); SBAR();
      FRAGS(2, xa0, xa1, xb0, xb1, xb2, xb3); SBAR();
      MMAS(ya0, ya1, yb0, yb1, yb2, yb3); SBAR();
      FRAGS(3, ya0, ya1, yb0, yb1, yb2, yb3); SBAR();
      MMAS(xa0, xa1, xb0, xb1, xb2, xb3); SBAR();
      MMAS(ya0, ya1, yb0, yb1, yb2, yb3);
    }
#undef FRAGS
#undef MMAS
    asm volatile("s_waitcnt vmcnt(0)" ::: "memory");
    __syncthreads();
  }
#undef GLDS
  const int mw = m0 + wm * 64 + r32, nw = n0 + wn * 128;
  epi(acc00, acc01, acc02, acc03, mw, nw, hi);
  epi(acc10, acc11, acc12, acc13, mw + 32, nw, hi);
}
DEVI u32x2 pk4(float a, float b, float c, float d) { u32x2 r = {cvtpk(a, b), cvtpk(c, d)}; return r; }

constexpr float ATT_SCALE = 0.125f;
constexpr float ATT_THR = 8.f;
constexpr int SHM_V = 64 * 128 * 2, SHM_K = 64 * 128 * 2;
#define KSWZ(row, colB) ((row) * 256 + ((colB) ^ (((row) & 7) << 4)))
DEVI void partialSM(f32x16& p0, f32x16& p1, float& m_reg, float& mn, float& alpha) {
  constexpr float C = ATT_SCALE * 1.4426950408889634f;
  float pmax = p0[0];
#pragma unroll
  for (int r = 1; r < 16; ++r) pmax = fmaxf(pmax, p0[r]);
#pragma unroll
  for (int r = 0; r < 16; ++r) pmax = fmaxf(pmax, p1[r]);
  { auto rr = __builtin_amdgcn_permlane32_swap(__float_as_uint(pmax), __float_as_uint(pmax), false, false);
    pmax = fmaxf(__uint_as_float(rr[0]), __uint_as_float(rr[1])); }
  if (__builtin_expect(__all(pmax - m_reg <= ATT_THR / ATT_SCALE), 1)) { mn = m_reg; alpha = 1.f; }
  else { mn = fmaxf(m_reg, pmax); alpha = __builtin_amdgcn_exp2f((m_reg - mn) * C); m_reg = mn; }
  const float mnC = -mn * C;
#pragma unroll
  for (int r = 0; r < 16; ++r) p0[r] = __builtin_amdgcn_exp2f(fmaf(p0[r], C, mnC));
#pragma unroll
  for (int r = 0; r < 16; ++r) p1[r] = __builtin_amdgcn_exp2f(fmaf(p1[r], C, mnC));
}
DEVI void finishSM(f32x16& p0, f32x16& p1, float alpha, float& l_reg, bf16x8& pa0, bf16x8& pa1, bf16x8& pa2, bf16x8& pa3) {
  float ps = 0;
#pragma unroll
  for (int r = 0; r < 16; ++r) ps += p0[r];
#pragma unroll
  for (int r = 0; r < 16; ++r) ps += p1[r];
  { auto rr = __builtin_amdgcn_permlane32_swap(__float_as_uint(ps), __float_as_uint(ps), false, false);
    ps = __uint_as_float(rr[0]) + __uint_as_float(rr[1]); }
  l_reg = l_reg * alpha + ps;
#define PK4(P, BASE, OUT) do { unsigned a0 = cvtpk(P[BASE + 0], P[BASE + 1]), a1 = cvtpk(P[BASE + 2], P[BASE + 3]);   \
    unsigned b0 = cvtpk(P[BASE + 4], P[BASE + 5]), b1 = cvtpk(P[BASE + 6], P[BASE + 7]);                              \
    auto r0 = __builtin_amdgcn_permlane32_swap(a0, b0, false, false); auto r1 = __builtin_amdgcn_permlane32_swap(a1, b1, false, false); \
    u32x4 w = {r0[0], r1[0], r0[1], r1[1]}; OUT = *reinterpret_cast<bf16x8*>(&w); } while (0)
  PK4(p0, 0, pa0); PK4(p0, 8, pa1); PK4(p1, 0, pa2); PK4(p1, 8, pa3);
#undef PK4
}
DEVI int v_st(int k, int c) { const int kk = (k & ~0xC) | ((k & 4) << 1) | ((k & 8) >> 1); return ((kk >> 3) * 4 + (c >> 5)) * 512 + ((kk & 7) * 32 + (c & 31)) * 2; }
DEVI int v_rd_base(int lane) { return ((lane & 3) << 3) | (((lane >> 2) & 3) << 6) | (((lane >> 4) & 1) << 5) | (((lane >> 5) & 1) << 8); }
constexpr int v_rd_off(int d0, int ks, int half) { return d0 * 512 + ks * 4096 + half * 2048; }
template <int OFF> DEVI s16x4 tr_read(int vb) {
  s16x4 r; asm volatile("ds_read_b64_tr_b16 %0, %1 offset:%2" : "=&v"(r) : "v"(vb), "i"(OFF) : "memory"); return r;
}
template <int D0> DEVI void pv_one(f32x16& od, int vb, bf16x8 pa0, bf16x8 pa1, bf16x8 pa2, bf16x8 pa3) {
  const s16x4 l0 = tr_read<v_rd_off(D0, 0, 0)>(vb), h0 = tr_read<v_rd_off(D0, 0, 1)>(vb), l1 = tr_read<v_rd_off(D0, 1, 0)>(vb), h1 = tr_read<v_rd_off(D0, 1, 1)>(vb);
  const s16x4 l2 = tr_read<v_rd_off(D0, 2, 0)>(vb), h2 = tr_read<v_rd_off(D0, 2, 1)>(vb), l3 = tr_read<v_rd_off(D0, 3, 0)>(vb), h3 = tr_read<v_rd_off(D0, 3, 1)>(vb);
  asm volatile("s_waitcnt lgkmcnt(0)" ::: "memory"); SBAR();
#define PK(L, H) (bf16x8){L[0], L[1], L[2], L[3], H[0], H[1], H[2], H[3]}
  od = __builtin_amdgcn_mfma_f32_32x32x16_bf16(pa0, PK(l0, h0), od, 0, 0, 0);
  od = __builtin_amdgcn_mfma_f32_32x32x16_bf16(pa1, PK(l1, h1), od, 0, 0, 0);
  od = __builtin_amdgcn_mfma_f32_32x32x16_bf16(pa2, PK(l2, h2), od, 0, 0, 0);
  od = __builtin_amdgcn_mfma_f32_32x32x16_bf16(pa3, PK(l3, h3), od, 0, 0, 0);
#undef PK
}
DEVI void pv_d0(f32x16* o, int vb, bf16x8 pa0, bf16x8 pa1, bf16x8 pa2, bf16x8 pa3) {
  pv_one<0>(o[0], vb, pa0, pa1, pa2, pa3); pv_one<1>(o[1], vb, pa0, pa1, pa2, pa3); pv_one<2>(o[2], vb, pa0, pa1, pa2, pa3); pv_one<3>(o[3], vb, pa0, pa1, pa2, pa3);
}

DEVI void attn_item(bf16* __restrict__ PJ, int b, int h, int qb, float lam, float one_m_li, const float* __restrict__ subw, char* lds, bool do_store = true) {
  const int tid = tid_opaque(), wid = tid >> 6, lane = tid & 63, r32 = lane & 31, hi = lane >> 5;
  const int cmp = wid & 1, wq = wid >> 1;
  char* V_lds = lds; char* K_lds = lds + 2 * SHM_V;
  float* wsl = (float*)(lds + 2 * SHM_V + 2 * SHM_K) + wid * 64; float* li_l = wsl; float* al_l = wsl + 32;
  const size_t rowQ = (size_t)b * SEQ + (size_t)qb * 128 + wq * 32;
  const bf16* Kh = PJ + (size_t)b * SEQ * LDP + 512 + h * 128;
  float m1 = -1e30f, l1 = 0; f32x16 o1[4] = {}; bf16x8 qr[4];
  { const bf16* Qw = PJ + (rowQ + r32) * LDP + h * 128 + cmp * 64 + hi * 8;
#pragma unroll
    for (int d0 = 0; d0 < 4; ++d0) qr[d0] = *(const bf16x8*)(Qw + d0 * 16); }
  const int sr = tid >> 4, sc = (tid & 15) * 8, vst0 = v_st(sr, sc), vst1 = v_st(32 + sr, sc);
  const int vb0 = (int)(uintptr_t)V_lds + v_rd_base(lane);
  int kof0[4], kof1[4];
#pragma unroll
  for (int d0 = 0; d0 < 4; ++d0) { const int cb = ((cmp * 4 + d0) * 16 + hi * 8) * 2; kof0[d0] = KSWZ(r32, cb); kof1[d0] = KSWZ(32 + r32, cb); }
  bf16x8 vs0, vs1, ks0, ks1;
  const bf16* kpA = Kh + (size_t)sr * LDP + sc; const bf16* kpB = kpA + (size_t)32 * LDP;
  kpA = launder(kpA); kpB = launder(kpB);
#define SLOAD() do { vs0 = *(const bf16x8*)(kpA + 512); vs1 = *(const bf16x8*)(kpB + 512); ks0 = *(const bf16x8*)(kpA); ks1 = *(const bf16x8*)(kpB); \
    kpA += (size_t)64 * LDP; kpB += (size_t)64 * LDP; } while (0)
#define SWRITE(bb) do { *(bf16x8*)(V_lds + (bb) * SHM_V + vst0) = vs0; *(bf16x8*)(V_lds + (bb) * SHM_V + vst1) = vs1; const int kc = sc * 2; \
    *(bf16x8*)(K_lds + (bb) * SHM_K + KSWZ(sr, kc)) = ks0; *(bf16x8*)(K_lds + (bb) * SHM_K + KSWZ(32 + sr, kc)) = ks1; } while (0)
#define RESC(a, o) do { if (__any((a) < 1.f)) { if (hi == 0) al_l[r32] = (a); asm volatile("s_waitcnt lgkmcnt(0)" ::: "memory"); \
    _Pragma("unroll") for (int d = 0; d < 4; ++d) _Pragma("unroll") for (int r = 0; r < 16; ++r) o[d][r] *= al_l[crow(r, hi)]; } } while (0)
  constexpr int NT = SEQ / 64;
#define QKT(P0, P1, KB) do { P0 = f32x16{}; P1 = f32x16{}; \
    _Pragma("unroll") for (int d0 = 0; d0 < 4; ++d0) { \
      const bf16x8 b0 = *reinterpret_cast<const bf16x8*>((KB) + kof0[d0]); const bf16x8 b1 = *reinterpret_cast<const bf16x8*>((KB) + kof1[d0]); \
      P0 = __builtin_amdgcn_mfma_f32_32x32x16_bf16(b0, qr[d0], P0, 0, 0, 0); P1 = __builtin_amdgcn_mfma_f32_32x32x16_bf16(b1, qr[d0], P1, 0, 0, 0); } } while (0)
#define SWAIT() asm volatile("s_waitcnt vmcnt(0)" ::: "memory")
  f32x16 pA0, pA1, pB0, pB1; float mnA, mnB, alA, alB; bf16x8 pa0, pa1, pa2, pa3;
  SLOAD(); SWAIT(); SWRITE(0); __syncthreads();
  QKT(pA0, pA1, K_lds); partialSM(pA0, pA1, m1, mnA, alA);
  SLOAD(); SWAIT(); SWRITE(1); __syncthreads();
#pragma unroll 1
  for (int j = 1; j + 1 < NT; j += 2) {
    SBAR(); QKT(pB0, pB1, K_lds + SHM_K);
    finishSM(pA0, pA1, alA, l1, pa0, pa1, pa2, pa3); SBAR();
    SLOAD(); SBAR();
    pv_d0(o1, vb0, pa0, pa1, pa2, pa3); partialSM(pB0, pB1, m1, mnB, alB);
    __syncthreads(); SWAIT(); SWRITE(0);
    RESC(alB, o1); __syncthreads();
    SBAR(); QKT(pA0, pA1, K_lds);
    finishSM(pB0, pB1, alB, l1, pa0, pa1, pa2, pa3); SBAR();
    SLOAD(); SBAR();
    pv_d0(o1, vb0 + SHM_V, pa0, pa1, pa2, pa3); partialSM(pA0, pA1, m1, mnA, alA);
    __syncthreads(); SWAIT(); SWRITE(1);
    RESC(alA, o1); __syncthreads();
  }
  SBAR(); QKT(pB0, pB1, K_lds + SHM_K);
  finishSM(pA0, pA1, alA, l1, pa0, pa1, pa2, pa3); SBAR();
  pv_d0(o1, vb0, pa0, pa1, pa2, pa3); partialSM(pB0, pB1, m1, mnB, alB);
  __syncthreads(); RESC(alB, o1);
  finishSM(pB0, pB1, alB, l1, pa0, pa1, pa2, pa3); SBAR();
  pv_d0(o1, vb0 + SHM_V, pa0, pa1, pa2, pa3);
  __syncthreads();
#undef QKT
#undef SWAIT
#undef SLOAD
#undef SWRITE
#undef RESC
  if (hi == 0) li_l[r32] = (cmp ? lam : 1.f) / l1;
  asm volatile("s_waitcnt lgkmcnt(0)" ::: "memory");
#pragma unroll
  for (int r = 0; r < 16; ++r) { const float c1 = li_l[crow(r, hi)];
#pragma unroll
    for (int d = 0; d < 4; ++d) o1[d][r] *= c1; }
  float* X = (float*)lds + wq * 4096 + lane;
  if (cmp == 1) {
#pragma unroll
    for (int d = 0; d < 4; ++d)
#pragma unroll
      for (int r = 0; r < 16; ++r) X[(d * 16 + r) * 64] = o1[d][r];
  }
  __syncthreads();
  if (cmp == 0 && do_store) {
    float sw[4];
#pragma unroll
    for (int d = 0; d < 4; ++d) sw[d] = subw[d * 32 + r32] * one_m_li;
    bf16* Ow = PJ + (rowQ + 4 * hi) * LDP + h * 128 + r32;
#pragma unroll
    for (int r = 0; r < 16; ++r) {
      float s = 0;
#pragma unroll
      for (int d = 0; d < 4; ++d) { const float v = o1[d][r] - X[(d * 16 + r) * 64]; o1[d][r] = v; s += v * v; }
      s = red16(s); s += __shfl_xor(s, 16);
      const float rs = rsqrtf(s * (1.f / 128.f) + 1e-5f);
      bf16* orp = launder(Ow + (size_t)((r & 3) + 8 * (r >> 2)) * LDP);
#pragma unroll
      for (int d = 0; d < 4; ++d) *(unsigned short*)&orp[d * 32] = f2bf(o1[d][r] * rs * sw[d]);
    }
  }
  __syncthreads();
}

DEVI void shiftmix8(const bf16* __restrict__ PJ, size_t R, int pos, int col, const float* __restrict__ mu, float* z) {
  float zc[8], zp[8], zn[8];
  unpack8(*(const u32x4*)&PJ[R * LDP + col], zc);
  if (pos > 0) unpack8(*(const u32x4*)&PJ[(R - 1) * LDP + col], zp); else { for (int j = 0; j < 8; ++j) zp[j] = 0.f; }
  if (pos < SEQ - 1) unpack8(*(const u32x4*)&PJ[(R + 1) * LDP + col], zn); else { for (int j = 0; j < 8; ++j) zn[j] = 0.f; }
#pragma unroll
  for (int j = 0; j < 8; ++j) z[j] = zc[j] + mu[j] * (0.5f * (zp[j] + zn[j]) - zc[j]);
}
DEVI void phase_zl(const Params& p, int l) {
  const bf16* PJ = (const bf16*)(WSV(p) + OFF_U); bf16* ZL = (bf16*)(WSV(p) + OFF_ZL);
  const float* mu = p.tshift_mu + (size_t)l * 1920 + 1536;
  for (int idx = blockIdx.x * NTHR + tid_opaque(); idx < NTOK * 48; idx += gridDim.x * NTHR) {
    const int R = idx / 48, ch = idx % 48, j0 = ch * 8, pos = R & (SEQ - 1);
    float m8[8], z[8];
#pragma unroll
    for (int j = 0; j < 8; ++j) m8[j] = mu[j0 + j];
    shiftmix8(PJ, R, pos, 3072 + j0, m8, z);
    if (j0 < 128) { for (int j = 0; j < 8; ++j) z[j] = tanhf(z[j]); }
    else if (j0 >= 256) { for (int j = 0; j < 8; ++j) z[j] = sigmoidf_(z[j]); }
    *(u32x4*)&ZL[(size_t)R * 384 + j0] = pack8(z);
  }
}

DEVI void phase_mix(const Params& p, int l) {
  bf16* PJm = (bf16*)(WSV(p) + OFF_U); bf16* VV = (bf16*)(WSV(p) + OFF_ZL);
  const float* mu = p.tshift_mu + (size_t)l * 1920;
  for (int idx = blockIdx.x * NTHR + tid_opaque(); idx < NTOK * 192; idx += gridDim.x * NTHR) {
    const int R = idx / 192, col = (idx % 192) * 8, pos = R & (SEQ - 1);
    float m8[8], z[8];
#pragma unroll
    for (int j = 0; j < 8; ++j) m8[j] = mu[col + j];
    shiftmix8(PJm, R, pos, 1536 + col, m8, z);
    if (col < 1024) *(u32x4*)&PJm[(size_t)R * LDP + 512 + col] = pack8(z);
    else *(u32x4*)&VV[(size_t)R * 512 + (col - 1024)] = pack8(z);
  }
}

constexpr int SC_T = 16;
constexpr int SC_DIR = 5 * SC_T * 64 + SC_T * 8;
constexpr int SC_BUF = 2 * SC_DIR;
constexpr int SC_SY = 2 * SC_BUF;
struct ScRaw { u32x2 c0, c1, c2, au, om; };
#define SC_BAR() asm volatile("s_waitcnt lgkmcnt(0)\n\ts_barrier" ::: "memory")
template <int MODE>
DEVI void phase_scan(const Params& p, int l, char* lds) {
  const bf16* PJ = (const bf16*)(WSV(p) + OFF_U);
  const bf16* Aa = (const bf16*)(WSV(p) + OFF_A);
  const _Float16* OM = (const _Float16*)(WSV(p) + OFF_OMW);
  _Float16* YH = (_Float16*)(WSV(p) + OFF_H);
  const bf16* VV = (const bf16*)(WSV(p) + OFF_ZL);
  float* L = (float*)lds;
  const int tid = tid_opaque(), wid = tid >> 6, lane = tid & 63, l16 = lane & 15;
  const bool producer = wid >= 4;
  const int stid = tid & 255;
  const int wdir = (wid >> 1) & 1, rowl = (wid & 1) * 4 + (lane >> 4);
  const int si = stid >> 4, sn = (stid & 15) * 4;
  constexpr int NCH = SEQ / SC_T;
  for (int it = blockIdx.x; it < 256; it += gridDim.x) {
    const int q8 = (it >> 3) & 7, bh_ = (it & 7) + 8 * (it >> 6), h = bh_ & 7, b = bh_ >> 3;
    const int cbase = h * 64 + sn;
    float kk4[4], ka4[4];
#pragma unroll
    for (int j = 0; j < 4; ++j) { kk4[j] = p.k_k[l * 512 + cbase + j]; ka4[j] = p.k_a[l * 512 + cbase + j]; }
    f32x2 Sa = {0.f, 0.f}, Sb = {0.f, 0.f};
    ScRaw xa0, xb0, xa1, xb1;
#define SC_LOAD(chk_, d_, RW) do { const int s = (chk_) * SC_T + si; const int pos = (d_) ? (SEQ - 1 - s) : s; const size_t R = (size_t)b * SEQ + pos; \
      const bf16* base = PJ + R * LDP + 512 + cbase; \
      RW.c0 = *(const u32x2*)(base); RW.c1 = *(const u32x2*)(base + 512); RW.c2 = *(const u32x2*)(VV + R * 512 + cbase); \
      RW.au = *(const u32x2*)&Aa[(R * 2 + (d_)) * 512 + cbase]; RW.om = *(const u32x2*)&OM[(R * 2 + (d_)) * 512 + cbase]; } while (0)
#define SC_PROC(buf_, d_, RW) do { float* sd = L + (buf_) * SC_BUF + (d_) * SC_DIR; \
      const float rc[4] = {bflo(RW.c0[0]), bfhi(RW.c0[0]), bflo(RW.c0[1]), bfhi(RW.c0[1])}; \
      const float kc[4] = {bflo(RW.c1[0]), bfhi(RW.c1[0]), bflo(RW.c1[1]), bfhi(RW.c1[1])}; \
      const float a4[4] = {bflo(RW.au[0]), bfhi(RW.au[0]), bflo(RW.au[1]), bfhi(RW.au[1])}; \
      typedef _Float16 h4 __attribute__((ext_vector_type(4))); const h4 om = __builtin_bit_cast(h4, RW.om); \
      float kq[4], ssq = 0.f; \
      _Pragma("unroll") for (int j = 0; j < 4; ++j) { kq[j] = kc[j] * kk4[j]; ssq += kq[j] * kq[j]; } \
      ssq = red16(ssq); \
      const float inv = rsqrtf(fmaxf(ssq, 1e-24f)); \
      f32x4 w4, k4, b4, kd4, r4; \
      _Pragma("unroll") for (int j = 0; j < 4; ++j) { const float kap = kq[j] * inv; \
        w4[j] = 1.f - (float)om[j]; k4[j] = kap; b4[j] = kap * a4[j]; kd4[j] = kc[j] * (1.f + (a4[j] - 1.f) * ka4[j]); r4[j] = rc[j]; } \
      const int o = si * 64 + sn; \
      *(f32x4*)&sd[o] = w4; *(f32x4*)&sd[SC_T * 64 + o] = k4; *(f32x4*)&sd[2 * SC_T * 64 + o] = b4; \
      *(f32x4*)&sd[3 * SC_T * 64 + o] = kd4; *(f32x4*)&sd[4 * SC_T * 64 + o] = r4; \
      if ((sn >> 3) == q8) { f32x4 v4 = {bflo(RW.c2[0]), bfhi(RW.c2[0]), bflo(RW.c2[1]), bfhi(RW.c2[1])}; *(f32x4*)&sd[5 * SC_T * 64 + si * 8 + (sn & 7)] = v4; } } while (0)
#define SC_WRITEOUT2(chk_, sb_) do { const int e = stid >> 7, u = stid & 127, i = u >> 3, rl = u & 7; \
      const float* sy = L + SC_SY + (sb_) * (2 * SC_T * 128) + e * (SC_T * 128) + (i * 8 + rl) * 16; \
      const f32x4 q0 = *(const f32x4*)&sy[0], q1 = *(const f32x4*)&sy[4], q2 = *(const f32x4*)&sy[8], q3 = *(const f32x4*)&sy[12]; \
      const float tot = ((q0[0] + q0[1]) + (q0[2] + q0[3])) + ((q1[0] + q1[1]) + (q1[2] + q1[3])) + ((q2[0] + q2[1]) + (q2[2] + q2[3])) + ((q3[0] + q3[1]) + (q3[2] + q3[3])); \
      const int s = (chk_) * SC_T + i; const int pos = e ? (SEQ - 1 - s) : s; \
      YH[((size_t)e * NTOK + (size_t)b * SEQ + pos) * 512 + h * 64 + q8 * 8 + rl] = (_Float16)(tot * 0.0625f); } while (0)
#define SC_WRITEOUT(chk_) SC_WRITEOUT2(chk_, (chk_) & 1)
    if (producer) {
      SC_LOAD(0, 0, xa0); SC_LOAD(0, 1, xb0); SC_PROC(0, 0, xa0); SC_PROC(0, 1, xb0);
      SC_LOAD(1, 0, xa0); SC_LOAD(1, 1, xb0); SC_LOAD(2, 0, xa1); SC_LOAD(2, 1, xb1);
      SC_BAR();
#pragma unroll 1
      for (int chk = 0; chk < NCH; chk += 2) {
        if (MODE != 2) {
        SC_PROC(1, 0, xa0); SC_PROC(1, 1, xb0);
        { const int cw_ = chk > 0 ? chk - 1 : 0; SC_WRITEOUT2(cw_, (chk + 1) & 1); }
        { const int cl_ = chk + 3 < NCH ? chk + 3 : NCH - 1; SC_LOAD(cl_, 0, xa0); SC_LOAD(cl_, 1, xb0); }
        }
        SC_BAR();
        if (MODE != 2) {
        SC_PROC(0, 0, xa1); SC_PROC(0, 1, xb1);
        SC_WRITEOUT2(chk, 0);
        { const int cl_ = chk + 4 < NCH ? chk + 4 : NCH - 1; SC_LOAD(cl_, 0, xa1); SC_LOAD(cl_, 1, xb1); }
        }
        SC_BAR();
      }
      SC_WRITEOUT(NCH - 1);
    } else {
      SC_BAR();
      __builtin_amdgcn_s_setprio(3);
#pragma unroll 1
      for (int chk = 0; chk < NCH; ++chk) {
        const float* cw = L + (chk & 1) * SC_BUF + wdir * SC_DIR;
        float* sy = L + SC_SY + (chk & 1) * (2 * SC_T * 128) + wdir * (SC_T * 128) + rowl * 16 + l16;
        const float* cl = cw + l16 * 4; const float* cv = cw + 5 * SC_T * 64 + rowl;
        f32x4 w4 = *(const f32x4*)&cl[0], k4 = *(const f32x4*)&cl[SC_T * 64], b4 = *(const f32x4*)&cl[2 * SC_T * 64],
              kd4 = *(const f32x4*)&cl[3 * SC_T * 64], r4 = *(const f32x4*)&cl[4 * SC_T * 64];
        float vv = cv[0], ylast = 0.f;
#pragma unroll 4
        for (int i = 0; i < (MODE == 1 ? 0 : SC_T); ++i) {
          if (i > 0) sy[(i - 1) * 128] = ylast;
          f32x4 w4n = w4, k4n = k4, b4n = b4, kd4n = kd4, r4n = r4; float vvn = vv;
          if (i + 1 < SC_T) {
            const int o = (i + 1) * 64;
            w4n = *(const f32x4*)&cl[o]; k4n = *(const f32x4*)&cl[SC_T * 64 + o]; b4n = *(const f32x4*)&cl[2 * SC_T * 64 + o];
            kd4n = *(const f32x4*)&cl[3 * SC_T * 64 + o]; r4n = *(const f32x4*)&cl[4 * SC_T * 64 + o]; vvn = cv[(i + 1) * 8];
          }
          __builtin_amdgcn_sched_barrier(0);
          const f32x2 ka = {k4[0], k4[1]}, kb = {k4[2], k4[3]}, wa = {w4[0], w4[1]}, wb = {w4[2], w4[3]}, ba = {b4[0], b4[1]}, bb = {b4[2], b4[3]};
          const f32x2 kda = {kd4[0], kd4[1]}, kdb = {kd4[2], kd4[3]}, ra = {r4[0], r4[1]}, rb = {r4[2], r4[3]};
          f32x2 t = Sa * ka; t = Sb * kb + t;
          const float sa = red16(t[0] + t[1]);
          const f32x2 ua = kda * vv - ba * sa, ub = kdb * vv - bb * sa;
          Sa = Sa * wa + ua; Sb = Sb * wb + ub;
          f32x2 yy = Sa * ra; yy = Sb * rb + yy;
          ylast = yy[0] + yy[1];
          w4 = w4n; k4 = k4n; b4 = b4n; kd4 = kd4n; r4 = r4n; vv = vvn;
          __builtin_amdgcn_sched_barrier(0);
        }
        sy[(SC_T - 1) * 128] = ylast;
        SC_BAR();
      }
      __builtin_amdgcn_s_setprio(0);
    }
    __syncthreads();
#undef SC_LOAD
#undef SC_PROC
#undef SC_WRITEOUT
#undef SC_WRITEOUT2
  }
}

DEVI void phase_post(const Params& p, int l) {
  bf16* PJ = (bf16*)(WSV(p) + OFF_U);
  const bf16* Aa = (const bf16*)(WSV(p) + OFF_A);
  const bf16* G = (const bf16*)(WSV(p) + OFF_G);
  const _Float16* YH = (const _Float16*)(WSV(p) + OFF_H);
  const int tid = tid_opaque(), wid = tid >> 6, lane = tid & 63, c0 = lane * 8;
  const bf16* VV = (const bf16*)(WSV(p) + OFF_ZL);
  float ka[8], rk[8], lw[8], lb[8];
#pragma unroll
  for (int j = 0; j < 8; ++j) {
    ka[j] = p.k_a[l * 512 + c0 + j]; rk[j] = p.r_k[l * 512 + c0 + j]; lw[j] = p.lnx_w[l * 512 + c0 + j]; lb[j] = p.lnx_b[l * 512 + c0 + j];
  }
  for (int R = blockIdx.x * 8 + wid; R < NTOK; R += gridDim.x * 8) {
    const int pos = R & (SEQ - 1);
    float y[8];
    { typedef _Float16 h8 __attribute__((ext_vector_type(8)));
      const h8 yf = *(const h8*)&YH[(size_t)R * 512 + c0], yb = *(const h8*)&YH[((size_t)NTOK + R) * 512 + c0];
#pragma unroll
      for (int j = 0; j < 8; ++j) y[j] = ((float)yf[j] + (float)yb[j]) * 16.f; }
    float s1 = 0;
#pragma unroll
    for (int j = 0; j < 8; ++j) s1 += y[j];
    const float mean = red8(s1) * (1.f / 64.f);
    float s2 = 0;
#pragma unroll
    for (int j = 0; j < 8; ++j) { y[j] -= mean; s2 += y[j] * y[j]; }
    const float rstd = rsqrtf(red8(s2) * (1.f / 64.f) + 64e-5f);
    float rr[8], kk[8], vv[8], a0[8], a1[8], g8[8];
    unpack8(*(const u32x4*)&PJ[(size_t)R * LDP + 512 + c0], rr);
    unpack8(*(const u32x4*)&PJ[(size_t)R * LDP + 1024 + c0], kk);
    unpack8(*(const u32x4*)&VV[(size_t)R * 512 + c0], vv);
    unpack8(*(const u32x4*)&Aa[((size_t)R * 2 + 0) * 512 + c0], a0);
    unpack8(*(const u32x4*)&Aa[((size_t)R * 2 + 1) * 512 + c0], a1);
    unpack8(*(const u32x4*)&G[(size_t)R * 512 + c0], g8);
#ifdef NAIVE_G
    { const bf16* ZLp = (const bf16*)(WSV(p) + OFF_ZL) + (size_t)R * 384 + 256; const float* g2 = p.gate_g2 + (size_t)l * 128 * 512 + c0;
      for (int j = 0; j < 8; ++j) g8[j] = 0.f;
      for (int k = 0; k < 128; ++k) { const float sv = bf2f(*(const unsigned short*)&ZLp[k]);
        for (int j = 0; j < 8; ++j) g8[j] += sv * g2[(size_t)k * 512 + j]; } }
#endif
#ifdef NAIVE_G2T
    { const bf16* ZLp = (const bf16*)(WSV(p) + OFF_ZL) + (size_t)R * 384 + 256; const bf16* g2t = (const bf16*)(WSV(p) + OFF_G2T) + (size_t)c0 * 128;
      for (int j = 0; j < 8; ++j) g8[j] = 0.f;
      for (int k = 0; k < 128; ++k) { const float sv = bf2f(*(const unsigned short*)&ZLp[k]);
        for (int j = 0; j < 8; ++j) g8[j] += sv * bf2f(*(const unsigned short*)&g2t[(size_t)j * 128 + k]); } }
#endif
#define FIN(x) (fabsf(x) < 1e30f)
#ifdef IGN_Y
    for (int j = 0; j < 8; ++j) y[j] = 0.01f * j;
#endif
#ifdef IGN_A
    for (int j = 0; j < 8; ++j) { a0[j] = 0.5f; a1[j] = 0.5f; }
#endif
#ifdef IGN_G
    for (int j = 0; j < 8; ++j) { g8[j] = 1.f; }
#endif
#ifdef IGN_RKV
    for (int j = 0; j < 8; ++j) { rr[j] = 0.1f; kk[j] = 0.1f; vv[j] = 0.1f; }
#endif
#ifdef SAN_Y
    for (int j = 0; j < 8; ++j) if (!FIN(y[j])) y[j] = 0.f;
#endif
#ifdef SAN_A
    for (int j = 0; j < 8; ++j) { if (!FIN(a0[j])) a0[j] = 0.f; if (!FIN(a1[j])) a1[j] = 0.f; }
#endif
#ifdef SAN_G
    for (int j = 0; j < 8; ++j) if (!FIN(g8[j])) g8[j] = 0.f;
#endif
#ifdef SAN_RKV
    for (int j = 0; j < 8; ++j) { if (!FIN(rr[j])) rr[j] = 0.f; if (!FIN(kk[j])) kk[j] = 0.f; if (!FIN(vv[j])) vv[j] = 0.f; }
#endif
    float bs = 0;
#pragma unroll
    for (int j = 0; j < 8; ++j) {
      const float kds = kk[j] * ((1.f + (a0[j] - 1.f) * ka[j]) + (1.f + (a1[j] - 1.f) * ka[j]));
      bs += rr[j] * kds * rk[j];
    }
    bs = red8(bs);
    float o[8];
#pragma unroll
    for (int j = 0; j < 8; ++j) o[j] = (y[j] * rstd * lw[j] + lb[j] + bs * vv[j]) * g8[j];
    *(u32x4*)&PJ[(size_t)R * LDP + 512 + c0] = pack8(o);
  }
}

DEVI bool tile_map(int round, int bid, int nb, int nM, int nN, int SM, int SN, int& mt, int& nt) {
  if (nb == 256) {
    const int xcd = bid & 7, j = bid >> 3, nsn = nN / SN, st = round * 8 + xcd;
    if (st >= (nM / SM) * nsn) return false;
    mt = (st / nsn) * SM + j / SN; nt = (st % nsn) * SN + j % SN; return true;
  }
  const int it = round * nb + bid; if (it >= nM * nN) return false;
  mt = it / nN; nt = it % nN; return true;
}

#define WT_IN ((bf16*)(WSV(p) + OFF_WT_IN))
#define WT_OUT ((bf16*)(WSV(p) + OFF_WT_OUT))
#define WT_UP ((bf16*)(WSV(p) + OFF_WT_UP))
#define WT_DOWN ((bf16*)(WSV(p) + OFF_WT_DOWN))
#define W2T ((bf16*)(WSV(p) + OFF_W2T))
#define A2T ((bf16*)(WSV(p) + OFF_A2T))
#define G2T ((bf16*)(WSV(p) + OFF_G2T))
#define PJ ((bf16*)(WSV(p) + OFF_U))
#define U PJ
#define ZL ((bf16*)(WSV(p) + OFF_ZL))
#define H ((bf16*)(WSV(p) + OFF_H))
#define OMW ((_Float16*)(WSV(p) + OFF_OMW))
#define AA ((bf16*)(WSV(p) + OFF_A))
#define GG ((bf16*)(WSV(p) + OFF_G))
#define MODP ((const float*)(WSV(p) + OFF_MOD))
#define cosT ((const float*)(WSV(p) + OFF_COS))
#define sinT ((const float*)(WSV(p) + OFF_SIN))
__global__ void __launch_bounds__(NTHR) fwd_megakernel(Params p) {
  extern __shared__ __attribute__((aligned(16))) char lds[];
  cg::grid_group grid = cg::this_grid();
  const int nb = gridDim.x, bid = blockIdx.x;
  unsigned* gbar = (unsigned*)(p.ws + OFF_BAR); unsigned gtarget = 0;
  grid.sync();
  phase_mod(p, lds);
  phase_rope(p);
  phase_conv(p, 0, lds);
  GSYNC();

  for (int l = 0; l < 2; ++l) {
    const float* xin = (l == 0) ? p.x : p.out;
    const float* modl = launder(MODP + (size_t)l * 4 * 6144);
    if (l > 0) phase_conv(p, l, lds);
    phase_norm(xin, p.norm1 + l * DM, modl, 0, 1024, H);
#ifdef REP_EW
    phase_norm(xin, p.norm1 + l * DM, modl, 0, 1024, H);
#endif
    GSYNC();
#ifdef REP_G1
    for (int rep = 0; rep < 2; ++rep)
#endif
    for (int rnd = 0;; ++rnd) {
      int mt, nt; if (!tile_map(rnd, bid, nb, 128, 14, 16, 2, mt, nt)) break;
      gemm_tile(H, DM, WT_IN, DM, DM, mt * 256, nt * 256, lds,
        [&](f32x16& c0, f32x16& c1, f32x16& c2, f32x16& c3, int m, int nw, int hi) {
          if (nw >= LDP) return;
          bf16* dst = PJ + (size_t)m * LDP + nw + 4 * hi;
          if (nw < 1024) {
            const int pos = m & (SEQ - 1);
            const float* ct = cosT + pos * 32 + 4 * hi; const float* st = sinT + pos * 32 + 4 * hi;
#pragma unroll
            for (int g = 0; g < 4; ++g) {
              const f32x4 cs = *(const f32x4*)(ct + 8 * g), sn = *(const f32x4*)(st + 8 * g);
              *(u32x2*)(dst + 8 * g) = pk4(c0[4 * g] * cs[0] - c1[4 * g] * sn[0], c0[4 * g + 1] * cs[1] - c1[4 * g + 1] * sn[1],
                                           c0[4 * g + 2] * cs[2] - c1[4 * g + 2] * sn[2], c0[4 * g + 3] * cs[3] - c1[4 * g + 3] * sn[3]);
              *(u32x2*)(dst + 32 + 8 * g) = pk4(c0[4 * g] * sn[0] + c1[4 * g] * cs[0], c0[4 * g + 1] * sn[1] + c1[4 * g + 1] * cs[1],
                                                c0[4 * g + 2] * sn[2] + c1[4 * g + 2] * cs[2], c0[4 * g + 3] * sn[3] + c1[4 * g + 3] * cs[3]);
              *(u32x2*)(dst + 64 + 8 * g) = pk4(c2[4 * g] * cs[0] - c3[4 * g] * sn[0], c2[4 * g + 1] * cs[1] - c3[4 * g + 1] * sn[1],
                                                c2[4 * g + 2] * cs[2] - c3[4 * g + 2] * sn[2], c2[4 * g + 3] * cs[3] - c3[4 * g + 3] * sn[3]);
              *(u32x2*)(dst + 96 + 8 * g) = pk4(c2[4 * g] * sn[0] + c3[4 * g] * cs[0], c2[4 * g + 1] * sn[1] + c3[4 * g + 1] * cs[1],
                                                c2[4 * g + 2] * sn[2] + c3[4 * g + 2] * cs[2], c2[4 * g + 3] * sn[3] + c3[4 * g + 3] * cs[3]);
            }
          } else {
#pragma unroll
            for (int g = 0; g < 4; ++g) {
              *(u32x2*)(dst + 8 * g) = pk4(c0[4 * g], c0[4 * g + 1], c0[4 * g + 2], c0[4 * g + 3]);
              *(u32x2*)(dst + 32 + 8 * g) = pk4(c1[4 * g], c1[4 * g + 1], c1[4 * g + 2], c1[4 * g + 3]);
              *(u32x2*)(dst + 64 + 8 * g) = pk4(c2[4 * g], c2[4 * g + 1], c2[4 * g + 2], c2[4 * g + 3]);
              *(u32x2*)(dst + 96 + 8 * g) = pk4(c3[4 * g], c3[4 * g + 1], c3[4 * g + 2], c3[4 * g + 3]);
            }
          }
        });
    }
    GSYNC();
    phase_zl(p, l);
#ifdef REP_EW
    phase_zl(p, l);
#endif
    {
      float s1 = 0, s2 = 0;
      for (int i = 0; i < 64; ++i) { s1 += p.lam_q1[l * 64 + i] * p.lam_k1[l * 64 + i]; s2 += p.lam_q2[l * 64 + i] * p.lam_k2[l * 64 + i]; }
      const float lam_init = 0.8f - 0.6f * expf(-0.3f * (float)l);
      const float lam = expf(s1) - expf(s2) + lam_init;
#ifndef SKIP_ATT
#ifdef REP_ATT
      for (int rep = 0; rep < 2; ++rep) {
      const bool dst_ = rep == 1;
#else
      { const bool dst_ = true;
#endif
      if (nb == 256) {
        const int xcd = bid & 7, jj = bid >> 3;
#pragma unroll 1
        for (int i4 = 0; i4 < 4; ++i4) {
          {
            const int bh = xcd + 8 * (i4 >> 1), qb = jj + 32 * (i4 & 1);
            attn_item(PJ, bh >> 2, bh & 3, qb, lam, 1.f - lam_init, p.subln_w + l * 128, lds, dst_);
          }
        }
      } else {
#pragma unroll 1
        for (int it = bid; it < 1024; it += nb) attn_item(PJ, it >> 8, (it >> 6) & 3, it & 63, lam, 1.f - lam_init, p.subln_w + l * 128, lds, dst_);
      }
      }
#endif
    }
    GSYNC();
#ifdef REP_LORA
    for (int rep = 0; rep < 2; ++rep)
#endif
    for (int it = bid; it < 5 * 256; it += nb) {
      const int g = it / 256, t = it % 256, mt = t >> 1, nt = t & 1, d = g & 1;
      const bf16* Ap; const bf16* Bp; int ldb, KK;
      if (g < 2) { Ap = ZL + d * 64; Bp = W2T + d * 512 * 64; ldb = 64; KK = 64; }
      else if (g < 4) { Ap = ZL + 128 + d * 64; Bp = A2T + d * 512 * 64; ldb = 64; KK = 64; }
      else { Ap = ZL + 256; Bp = G2T; ldb = 128; KK = 128; }
      const float* w0 = p.decay_w0 + (size_t)(l * 2 + d) * 512; const float* a0 = p.icl_a0 + (size_t)(l * 2 + d) * 512;
      gemm_tile(Ap, 384, Bp, ldb, KK, mt * 256, nt * 256, lds,
        [&](f32x16& c0, f32x16& c1, f32x16& c2, f32x16& c3, int m, int nw, int hi) {
          auto tile_ = [&](const f32x16& c, const int j) {
#pragma unroll
            for (int gq = 0; gq < 4; ++gq) {
              const int col = nw + 32 * j + 8 * gq + 4 * hi;
              float o[4];
              if (g < 2) {
                const f32x4 w0c = *(const f32x4*)&w0[col];
#pragma unroll
                for (int e = 0; e < 4; ++e) {
                  const float nx = -(c[4 * gq + e] + w0c[e]);
                  const float sp = fmaxf(nx, 0.f) + __logf(1.f + __expf(-fabsf(nx)));
                  const float ee = __expf(-sp - 0.5f);
                  o[e] = ee < 0.03125f ? ee * (1.f - ee * (0.5f - ee * (1.f / 6.f - ee * (1.f / 24.f)))) : 1.f - __expf(-ee);
                }
                typedef _Float16 h4 __attribute__((ext_vector_type(4)));
                h4 hv = {(_Float16)o[0], (_Float16)o[1], (_Float16)o[2], (_Float16)o[3]};
                *(h4*)&OMW[((size_t)m * 2 + d) * 512 + col] = hv;
              } else if (g < 4) {
                const f32x4 a0c = *(const f32x4*)&a0[col];
#pragma unroll
                for (int e = 0; e < 4; ++e) o[e] = 1.f / (1.f + __expf(-(c[4 * gq + e] + a0c[e])));
                *(u32x2*)&AA[((size_t)m * 2 + d) * 512 + col] = pk4(o[0], o[1], o[2], o[3]);
              } else {
                *(u32x2*)&GG[(size_t)m * 512 + col] = pk4(c[4 * gq], c[4 * gq + 1], c[4 * gq + 2], c[4 * gq + 3]);
              }
            }
                    };
          tile_(c0, 0); tile_(c1, 1); tile_(c2, 2); tile_(c3, 3);

        });
    }
    GSYNC();
    phase_mix(p, l);
#ifdef REP_EW
    phase_mix(p, l);
#endif
    GSYNC();
#ifndef SKIP_SCAN
#ifdef REP_SCAN
    phase_scan<REP_SCAN>(p, l, lds);
#endif
    phase_scan<0>(p, l, lds);
#endif
    GSYNC();
#ifndef SKIP_POST
    phase_post(p, l);
#endif
    GSYNC();
    for (int rnd = 0;; ++rnd) {
      int mt, nt; if (!tile_map(rnd, bid, nb, 128, 4, 8, 4, mt, nt)) break;
      gemm_tile(PJ, LDP, WT_OUT, DM, DM, mt * 256, nt * 256, lds,
        [&](f32x16& c0, f32x16& c1, f32x16& c2, f32x16& c3, int m, int nw, int hi) {
          const int b = m >> 13; const float* gt = modl + b * 6144 + 2048 + nw + 4 * hi;
          const float* xi = xin + (size_t)m * DM + nw + 4 * hi; float* xo = p.out + (size_t)m * DM + nw + 4 * hi;
          auto tile_ = [&](const f32x16& c, const int j) {
#pragma unroll
            for (int g = 0; g < 4; ++g) {
              const f32x4 x4 = *(const f32x4*)(xi + 32 * j + 8 * g), g4 = *(const f32x4*)(gt + 32 * j + 8 * g);
              f32x4 o = {x4[0] + g4[0] * c[4 * g], x4[1] + g4[1] * c[4 * g + 1], x4[2] + g4[2] * c[4 * g + 2], x4[3] + g4[3] * c[4 * g + 3]};
              *(f32x4*)(xo + 32 * j + 8 * g) = o;
            }
                    };
          tile_(c0, 0); tile_(c1, 1); tile_(c2, 2); tile_(c3, 3);

        });
    }
    GSYNC();
    phase_norm(p.out, p.norm2 + l * DM, modl, 3072, 4096, H);
#ifdef REP_EW
    phase_norm(p.out, p.norm2 + l * DM, modl, 3072, 4096, H);
#endif
    GSYNC();
#ifdef REP_UP
    for (int rep = 0; rep < 2; ++rep)
#endif
    for (int rnd = 0;; ++rnd) {
      int mt, nt; if (!tile_map(rnd, bid, nb, 128, 16, 4, 8, mt, nt)) break;
      gemm_tile(H, DM, WT_UP, DM, DM, mt * 256, nt * 256, lds,
        [&](f32x16& c0, f32x16& c1, f32x16& c2, f32x16& c3, int m, int nw, int hi) {
          bf16* dst = U + (size_t)m * DFF + nw + 4 * hi;
          auto tile_ = [&](const f32x16& c, const int j) {
#pragma unroll
            for (int g = 0; g < 4; ++g) {
              const float u0 = fmaxf(c[4 * g], 0.f), u1 = fmaxf(c[4 * g + 1], 0.f), u2 = fmaxf(c[4 * g + 2], 0.f), u3 = fmaxf(c[4 * g + 3], 0.f);
              *(u32x2*)(dst + 32 * j + 8 * g) = pk4(u0 * u0, u1 * u1, u2 * u2, u3 * u3);
            }
                    };
          tile_(c0, 0); tile_(c1, 1); tile_(c2, 2); tile_(c3, 3);

        });
    }
    GSYNC();
    for (int rnd = 0;; ++rnd) {
      int mt, nt; if (!tile_map(rnd, bid, nb, 128, 4, 8, 4, mt, nt)) break;
      gemm_tile(U, DFF, WT_DOWN, DFF, DFF, mt * 256, nt * 256, lds,
        [&](f32x16& c0, f32x16& c1, f32x16& c2, f32x16& c3, int m, int nw, int hi) {
          const int b = m >> 13; const float* gt = modl + b * 6144 + 5120 + nw + 4 * hi;
          float* xo = p.out + (size_t)m * DM + nw + 4 * hi;
          auto tile_ = [&](const f32x16& c, const int j) {
#pragma unroll
            for (int g = 0; g < 4; ++g) {
              const f32x4 x4 = *(const f32x4*)(xo + 32 * j + 8 * g), g4 = *(const f32x4*)(gt + 32 * j + 8 * g);
              f32x4 o = {x4[0] + g4[0] * c[4 * g], x4[1] + g4[1] * c[4 * g + 1], x4[2] + g4[2] * c[4 * g + 2], x4[3] + g4[3] * c[4 * g + 3]};
              *(f32x4*)(xo + 32 * j + 8 * g) = o;
            }
                    };
          tile_(c0, 0); tile_(c1, 1); tile_(c2, 2); tile_(c3, 3);

        });
    }
    GSYNC();
  }
#ifdef REP_BAR
  for (int i = 0; i < 20; ++i) GSYNC();
#endif
  phase_final_norm(p.out, p.norm_f);
}

extern "C" void kernel_launch(void* const* d_in, const int* in_sizes, int n_in, void* d_out, int out_size, void* d_ws, size_t ws_size,
                              hipStream_t stream) {
  static int grid_blocks = 0;
  if (n_in != 27 || ws_size < WS_NEED) { fprintf(stderr, "kernel_launch: bad n_in %d or ws_size %zu (< %zu)\n", n_in, ws_size, (size_t)WS_NEED); return; }
  if (!grid_blocks) {
    int dev = 0, cus = 0, per_cu = 0;
    hipGetDevice(&dev);
    hipDeviceGetAttribute(&cus, hipDeviceAttributeMultiprocessorCount, dev);
    hipFuncSetAttribute((const void*)fwd_megakernel, hipFuncAttributeMaxDynamicSharedMemorySize, LDS_BYTES);
    hipOccupancyMaxActiveBlocksPerMultiprocessor(&per_cu, fwd_megakernel, NTHR, LDS_BYTES);
    if (per_cu < 1) per_cu = 1;
    if (per_cu > 1) per_cu = 1;
    grid_blocks = cus * per_cu;
  }
  Params p{};
  const float** pp = (const float**)&p;
  for (int i = 0; i < 27; ++i) pp[i] = (const float*)d_in[i];
  p.out = (float*)d_out; p.ws = (char*)d_ws;
  for (int i = 0; i < 32; ++i) p.inv_freq[i] = 1.0f / powf(10000.0f, (float)(2 * i) / 64.0f);
  hipMemsetAsync((char*)d_ws + OFF_BAR, 0, 256, stream);
  void* args[] = {&p};
  hipError_t e = hipLaunchCooperativeKernel((void*)fwd_megakernel, dim3(grid_blocks), dim3(NTHR), args, LDS_BYTES, stream);
  if (e != hipSuccess) fprintf(stderr, "cooperative launch failed: %s (grid %d)\n", hipGetErrorString(e), grid_blocks);
}
```

```cpp
#include <hip/hip_runtime.h>
#include <hip/hip_bf16.h>
#include <hip/hip_cooperative_groups.h>
#include <cstdio>
#include <cmath>
namespace cg = cooperative_groups;

#define DEVI __device__ __forceinline__
using bf16 = __hip_bfloat16;
typedef short bf16x8 __attribute__((ext_vector_type(8)));
typedef short s16x4 __attribute__((ext_vector_type(4)));
typedef float f32x16 __attribute__((ext_vector_type(16)));
typedef float f32x4 __attribute__((ext_vector_type(4)));
typedef unsigned u32x4 __attribute__((ext_vector_type(4)));
typedef unsigned u32x2 __attribute__((ext_vector_type(2)));
typedef float f32x2 __attribute__((ext_vector_type(2)));

constexpr int NTOK = 32768, SEQ = 8192, DM = 1024, LDP = 3456, DFF = 4096;
constexpr int NTHR = 512;
constexpr size_t MiB = 1024 * 1024;
constexpr size_t OFF_WT_IN = 0;
constexpr size_t OFF_WT_OUT = OFF_WT_IN + (size_t)3456 * 1024 * 2;
constexpr size_t OFF_WT_UP = OFF_WT_OUT + (size_t)1024 * 1024 * 2;
constexpr size_t OFF_WT_DOWN = OFF_WT_UP + (size_t)4096 * 1024 * 2;
constexpr size_t OFF_W2T = OFF_WT_DOWN + (size_t)4096 * 1024 * 2;
constexpr size_t OFF_A2T = OFF_W2T + (size_t)2 * 512 * 64 * 2;
constexpr size_t OFF_G2T = OFF_A2T + (size_t)2 * 512 * 64 * 2;
constexpr size_t OFF_U = 26 * MiB;
constexpr size_t OFF_ZL = OFF_U + 216 * MiB;
constexpr size_t OFF_H = OFF_U + 256 * MiB;
constexpr size_t OFF_OMW = OFF_H + 64 * MiB;
constexpr size_t OFF_A = OFF_OMW + 64 * MiB;
constexpr size_t OFF_G = OFF_A + 64 * MiB;
constexpr size_t OFF_MOD = OFF_G + 32 * MiB;
constexpr size_t OFF_COS = OFF_MOD + 1 * MiB;
constexpr size_t OFF_SIN = OFF_COS + 1 * MiB;
constexpr size_t OFF_BAR = OFF_SIN + 1 * MiB;
constexpr size_t WS_NEED = OFF_BAR + 1 * MiB;
constexpr int LDS_BYTES = 131072;

struct Params {
  const float *x, *c, *w_ada, *b_ada, *norm1, *norm2, *w_in, *w_out, *lam_q1, *lam_k1, *lam_q2, *lam_k2, *subln_w, *tshift_mu,
      *decay_w0, *decay_w2, *icl_a0, *icl_a2, *gate_g2, *k_k, *k_a, *r_k, *lnx_w, *lnx_b, *w_up, *w_down, *norm_f;
  float* out;
  char* ws;
  float inv_freq[32];
};

DEVI void grid_barrier(unsigned* bar, unsigned& target) {
  asm volatile("s_waitcnt vmcnt(0) lgkmcnt(0)" ::: "memory");
  __syncthreads();
  target += gridDim.x;
  if (threadIdx.x == 0) {
    __builtin_amdgcn_fence(__ATOMIC_RELEASE, "agent");
    asm volatile("s_waitcnt vmcnt(0)" ::: "memory");
    __hip_atomic_fetch_add(bar, 1u, __ATOMIC_RELAXED, __HIP_MEMORY_SCOPE_AGENT);
    while (__hip_atomic_load(bar, __ATOMIC_RELAXED, __HIP_MEMORY_SCOPE_AGENT) < target) __builtin_amdgcn_s_sleep(2);
    __builtin_amdgcn_fence(__ATOMIC_ACQUIRE, "agent");
    asm volatile("s_waitcnt vmcnt(0)" ::: "memory");
  }
  __syncthreads();
}
#define GSYNC() grid_barrier(gbar, gtarget)
struct Params;
#define SBAR() __builtin_amdgcn_sched_barrier(0)
#define GAS __attribute__((address_space(1)))
#define LAS __attribute__((address_space(3)))
template <class T> DEVI T* launder(T* q) { unsigned long long u = (unsigned long long)q; asm volatile("" : "+v"(u)); return (T*)(GAS T*)u; }
DEVI char* ws_launder(char* w) { return launder(w); }
#define WSV(p) ws_launder((p).ws)
DEVI int tid_opaque() { int t = threadIdx.x; asm volatile("" : "+v"(t)); return t; }
DEVI int crow(int r, int hi) { return (r & 3) + 8 * (r >> 2) + 4 * hi; }
DEVI unsigned cvtpk(float lo, float hi) {
  unsigned r; asm volatile("v_cvt_pk_bf16_f32 %0, %1, %2" : "=v"(r) : "v"(lo), "v"(hi)); return r;
}
DEVI unsigned short f2bf(float x) { return (unsigned short)(cvtpk(x, 0.f) & 0xffffu); }
DEVI float bf2f(unsigned short u) { return __uint_as_float(((unsigned)u) << 16); }
DEVI float bflo(unsigned u) { return __uint_as_float(u << 16); }
DEVI float bfhi(unsigned u) { return __uint_as_float(u & 0xffff0000u); }
template <int CTRL> DEVI float dppf(float x) {
  return __builtin_bit_cast(float, __builtin_amdgcn_mov_dpp(__builtin_bit_cast(int, x), CTRL, 0xf, 0xf, true));
}
DEVI float red8(float x) { x += dppf<0xB1>(x); x += dppf<0x4E>(x); x += dppf<0x141>(x); return x; }
DEVI float red16(float x) { x = red8(x); x += dppf<0x128>(x); return x; }
DEVI float red64(float x) { x = red16(x); x += __shfl_xor(x, 16); x += __shfl_xor(x, 32); return x; }
DEVI float sigmoidf_(float x) { return 1.f / (1.f + __expf(-x)); }
DEVI void unpack8(u32x4 v, float* f) {
  f[0] = bflo(v[0]); f[1] = bfhi(v[0]); f[2] = bflo(v[1]); f[3] = bfhi(v[1]);
  f[4] = bflo(v[2]); f[5] = bfhi(v[2]); f[6] = bflo(v[3]); f[7] = bfhi(v[3]);
}
DEVI u32x4 pack8(const float* f) {
  u32x4 w = {cvtpk(f[0], f[1]), cvtpk(f[2], f[3]), cvtpk(f[4], f[5]), cvtpk(f[6], f[7])}; return w;
}

DEVI void phase_mod(const Params& p, char* lds) {
  float* sc = (float*)lds;
  float* red = sc + 4096;
  const int tid = tid_opaque(), w = tid >> 6, lane = tid & 63;
  for (int i = tid; i < 4096; i += NTHR) { float v = p.c[i]; sc[i] = v / (1.f + expf(-v)); }
  __syncthreads();
  float* mod = (float*)(WSV(p) + OFF_MOD);
  for (int it = blockIdx.x; it < 192; it += gridDim.x) {
    const int l = it / 96, col = (it % 96) * 64 + lane;
    const float* W = p.w_ada + (size_t)l * 1024 * 6144 + col;
    float a0 = 0, a1 = 0, a2 = 0, a3 = 0;
    for (int k = w * 128; k < w * 128 + 128; ++k) {
      float wv = W[(size_t)k * 6144];
      a0 += sc[k] * wv; a1 += sc[1024 + k] * wv; a2 += sc[2048 + k] * wv; a3 += sc[3072 + k] * wv;
    }
    red[(w * 4 + 0) * 64 + lane] = a0; red[(w * 4 + 1) * 64 + lane] = a1;
    red[(w * 4 + 2) * 64 + lane] = a2; red[(w * 4 + 3) * 64 + lane] = a3;
    __syncthreads();
    if (tid < 256) {
      const int bb = tid >> 6; float s = 0;
      for (int ww = 0; ww < 8; ++ww) s += red[(ww * 4 + bb) * 64 + lane];
      mod[(l * 4 + bb) * 6144 + col] = s + p.b_ada[l * 6144 + col];
    }
    __syncthreads();
  }
}

DEVI void phase_rope(const Params& p) {
  float* cosT = (float*)(WSV(p) + OFF_COS); float* sinT = (float*)(WSV(p) + OFF_SIN);
  for (int idx = blockIdx.x * NTHR + tid_opaque(); idx < SEQ * 32; idx += gridDim.x * NTHR) {
    const int pos = idx >> 5, i = idx & 31;
    const float ang = (float)pos * p.inv_freq[i];
    double q = (double)ang * 0.15915494309189533577; q -= floor(q);
    const float f = (float)q;
    cosT[idx] = __builtin_amdgcn_cosf(f); sinT[idx] = __builtin_amdgcn_sinf(f);
  }
}

DEVI void conv_tile(const float* __restrict__ src, int ldsrc, bf16* __restrict__ dst, int lddst, int k0, int n0, float* tile) {
  const int tid = tid_opaque();
#pragma unroll
  for (int ps = 0; ps < 2; ++ps) {
    const int k = ps * 32 + (tid >> 4), n = (tid & 15) * 4;
    const f32x4 v = *(const f32x4*)&src[(size_t)(k0 + k) * ldsrc + n0 + n];
    tile[k * 65 + n + 0] = v[0]; tile[k * 65 + n + 1] = v[1]; tile[k * 65 + n + 2] = v[2]; tile[k * 65 + n + 3] = v[3];
  }
  __syncthreads();
  {
    const int n = tid >> 3, kc = (tid & 7) * 8; float f[8];
#pragma unroll
    for (int j = 0; j < 8; ++j) f[j] = tile[(kc + j) * 65 + n];
    *(u32x4*)&dst[(size_t)(n0 + n) * lddst + k0 + kc] = pack8(f);
  }
  __syncthreads();
}
DEVI void phase_conv(const Params& p, int l, char* lds) {
  float* tile = (float*)lds;
  for (int it = blockIdx.x; it < 3216; it += gridDim.x) {
    const float* src; bf16* dst; int K, N, t = it;
    char* wsb = launder(p.ws);
    if (t < 864) { src = p.w_in + (size_t)l * 1024 * 3456; dst = (bf16*)(wsb + OFF_WT_IN); K = 1024; N = 3456; }
    else if ((t -= 864) < 256) { src = p.w_out + (size_t)l * 1024 * 1024; dst = (bf16*)(wsb + OFF_WT_OUT); K = 1024; N = 1024; }
    else if ((t -= 256) < 1024) { src = p.w_up + (size_t)l * 1024 * 4096; dst = (bf16*)(wsb + OFF_WT_UP); K = 1024; N = 4096; }
    else if ((t -= 1024) < 1024) { src = p.w_down + (size_t)l * 4096 * 1024; dst = (bf16*)(wsb + OFF_WT_DOWN); K = 4096; N = 1024; }
    else if ((t -= 1024) < 16) { const int d = t >> 3; t &= 7; src = p.decay_w2 + (size_t)(l * 2 + d) * 64 * 512; dst = (bf16*)(wsb + OFF_W2T) + d * 512 * 64; K = 64; N = 512; }
    else if ((t -= 16) < 16) { const int d = t >> 3; t &= 7; src = p.icl_a2 + (size_t)(l * 2 + d) * 64 * 512; dst = (bf16*)(wsb + OFF_A2T) + d * 512 * 64; K = 64; N = 512; }
    else { t -= 16; src = p.gate_g2 + (size_t)l * 128 * 512; dst = (bf16*)(wsb + OFF_G2T); K = 128; N = 512; }
    const int nt = N / 64; const int kt = t / nt, ntile = t % nt;
    conv_tile(src, N, dst, K, kt * 64, ntile * 64, tile);
  }
}

DEVI void phase_norm(const float* __restrict__ xin, const float* __restrict__ g, const float* __restrict__ modl, int shoff, int scoff,
                     bf16* __restrict__ H) {
  const int tid = tid_opaque(), w = tid >> 6, lane = tid & 63;
  for (int row = blockIdx.x * 8 + w; row < NTOK; row += gridDim.x * 8) {
    const int b = row >> 13; f32x4 v[4]; float ss = 0;
#pragma unroll
    for (int j = 0; j < 4; ++j) { v[j] = *(const f32x4*)&xin[(size_t)row * DM + j * 256 + lane * 4]; ss += v[j][0] * v[j][0] + v[j][1] * v[j][1] + v[j][2] * v[j][2] + v[j][3] * v[j][3]; }
    ss = red64(ss);
    const float rstd = rsqrtf(ss * (1.f / 1024.f) + 1e-6f);
#pragma unroll
    for (int j = 0; j < 4; ++j) {
      const int col = j * 256 + lane * 4;
      const f32x4 g4 = *(const f32x4*)&g[col];
      const f32x4 sc4 = *(const f32x4*)&modl[b * 6144 + scoff + col];
      const f32x4 sh4 = *(const f32x4*)&modl[b * 6144 + shoff + col];
      float o[4];
#pragma unroll
      for (int e = 0; e < 4; ++e) o[e] = v[j][e] * rstd * g4[e] * (1.f + sc4[e]) + sh4[e];
      u32x2 pk = {cvtpk(o[0], o[1]), cvtpk(o[2], o[3])};
      *(u32x2*)&H[(size_t)row * DM + col] = pk;
    }
  }
}
DEVI void phase_final_norm(float* __restrict__ x, const float* __restrict__ g) {
  const int tid = tid_opaque(), w = tid >> 6, lane = tid & 63;
  for (int row = blockIdx.x * 8 + w; row < NTOK; row += gridDim.x * 8) {
    f32x4 v[4]; float ss = 0;
#pragma unroll
    for (int j = 0; j < 4; ++j) { v[j] = *(const f32x4*)&x[(size_t)row * DM + j * 256 + lane * 4]; ss += v[j][0] * v[j][0] + v[j][1] * v[j][1] + v[j][2] * v[j][2] + v[j][3] * v[j][3]; }
    ss = red64(ss);
    const float rstd = rsqrtf(ss * (1.f / 1024.f) + 1e-6f);
#pragma unroll
    for (int j = 0; j < 4; ++j) {
      const int col = j * 256 + lane * 4;
      const f32x4 g4 = *(const f32x4*)&g[col];
      f32x4 o = {v[j][0] * rstd * g4[0], v[j][1] * rstd * g4[1], v[j][2] * rstd * g4[2], v[j][3] * rstd * g4[3]};
#ifdef SANITIZE
      for (int e = 0; e < 4; ++e) if (!(fabsf(o[e]) < 1e30f)) o[e] = 0.f;
#endif
      *(f32x4*)&x[(size_t)row * DM + col] = o;
    }
  }
}

typedef float f32x4v __attribute__((ext_vector_type(4)));
template <class Epi>
DEVI void gemm_tile(const bf16* __restrict__ A, int lda, const bf16* __restrict__ Bt, int ldb, int K, int m0, int n0, char* lds, Epi&& epi) {
  const int tid = tid_opaque(), wid = tid >> 6, lane = tid & 63, l15 = lane & 15, q = lane >> 4;
  const int wm = wid >> 1, wn = wid & 1;
  char* As = lds; char* Bs = lds + 65536;
  f32x4v acc[4][8];
#pragma unroll
  for (int i = 0; i < 4; ++i)
#pragma unroll
    for (int j = 0; j < 8; ++j) acc[i][j] = f32x4v{0.f, 0.f, 0.f, 0.f};
  const int lrow = tid >> 3, lch = tid & 7, gch = lch ^ ((lrow >> 1) & 7);
  const bf16* Ag = launder(A) + (size_t)(m0 + lrow) * lda + gch * 8;
  const bf16* Bg = launder(Bt) + (size_t)(n0 + lrow) * ldb + gch * 8;
#define GLDS(buf, k0) do { char* a_ = As + (buf) * 32768 + wid * 1024; char* b_ = Bs + (buf) * 32768 + wid * 1024; \
    _Pragma("unroll") for (int i_ = 0; i_ < 4; ++i_) { \
      __builtin_amdgcn_global_load_lds((const GAS unsigned*)(Ag + (size_t)(64 * i_) * lda + (k0)), (LAS unsigned*)(a_ + i_ * 8192), 16, 0, 0); \
      __builtin_amdgcn_global_load_lds((const GAS unsigned*)(Bg + (size_t)(64 * i_) * ldb + (k0)), (LAS unsigned*)(b_ + i_ * 8192), 16, 0, 0); } } while (0)
  const int KT = K >> 6;
  const int sw = (l15 >> 1) & 7;
  const int aoff = (wm * 64 + l15) * 128, boff = (wn * 128 + l15) * 128;
  GLDS(0, 0); asm volatile("s_waitcnt vmcnt(0)" ::: "memory"); __syncthreads();
#pragma unroll 2
  for (int kt = 0; kt < KT; ++kt) {
    if (kt + 1 < KT) GLDS((kt + 1) & 1, (kt + 1) * 64);
    const char* Ab = As + (kt & 1) * 32768 + aoff; const char* Bb = Bs + (kt & 1) * 32768 + boff;
#pragma unroll
    for (int s2 = 0; s2 < 2; ++s2) {
      const int ch = ((4 * s2 + q) ^ sw) * 16;
      bf16x8 af[4];
#pragma unroll
      for (int i = 0; i < 4; ++i) af[i] = *(const bf16x8*)(Ab + i * 2048 + ch);
#pragma unroll
      for (int jh = 0; jh < 2; ++jh) {
        bf16x8 bfr[4];
#pragma unroll
        for (int j = 0; j < 4; ++j) bfr[j] = *(const bf16x8*)(Bb + (jh * 4 + j) * 2048 + ch);
#pragma unroll
        for (int i = 0; i < 4; ++i)
#pragma unroll
          for (int j = 0; j < 4; ++j) acc[i][jh * 4 + j] = __builtin_amdgcn_mfma_f32_16x16x32_bf16(bfr[j], af[i], acc[i][jh * 4 + j], 0, 0, 0);
        SBAR();
      }
    }
    asm volatile("s_waitcnt vmcnt(0)" ::: "memory");
    __syncthreads();
  }
#undef GLDS
  const int mw = m0 + wm * 64 + l15, nw = n0 + wn * 128;
#pragma unroll
  for (int i = 0; i < 4; ++i) epi(acc[i][0], acc[i][1], acc[i][2], acc[i][3], acc[i][4], acc[i][5], acc[i][6], acc[i][7], mw + 16 * i, nw, q);
}
#define EPI_ARGS f32x4v c0, f32x4v c1, f32x4v c2, f32x4v c3, f32x4v c4, f32x4v c5, f32x4v c6, f32x4v c7, int m, int nw, int q
#define EPI_TILES(F) do { F(c0, 0); F(c1, 1); F(c2, 2); F(c3, 3); F(c4, 4); F(c5, 5); F(c6, 6); F(c7, 7); } while (0)
DEVI u32x2 pk4(float a, float b, float c, float d) { u32x2 r = {cvtpk(a, b), cvtpk(c, d)}; return r; }

constexpr float ATT_SCALE = 0.125f;
constexpr float ATT_THR = 8.f;
constexpr int SHM_V = 64 * 128 * 2, SHM_K = 64 * 128 * 2;
#define KSWZ(row, colB) ((row) * 256 + ((colB) ^ (((row) & 7) << 4)))
DEVI void partialSM(f32x16& p0, f32x16& p1, float& m_reg, float& mn, float& alpha) {
  constexpr float C = ATT_SCALE * 1.4426950408889634f;
  float pmax = p0[0];
#pragma unroll
  for (int r = 1; r < 16; ++r) pmax = fmaxf(pmax, p0[r]);
#pragma unroll
  for (int r = 0; r < 16; ++r) pmax = fmaxf(pmax, p1[r]);
  { auto rr = __builtin_amdgcn_permlane32_swap(__float_as_uint(pmax), __float_as_uint(pmax), false, false);
    pmax = fmaxf(__uint_as_float(rr[0]), __uint_as_float(rr[1])); }
  if (__builtin_expect(__all(pmax - m_reg <= ATT_THR / ATT_SCALE), 1)) { mn = m_reg; alpha = 1.f; }
  else { mn = fmaxf(m_reg, pmax); alpha = __builtin_amdgcn_exp2f((m_reg - mn) * C); m_reg = mn; }
  const float mnC = -mn * C;
#pragma unroll
  for (int r = 0; r < 16; ++r) p0[r] = __builtin_amdgcn_exp2f(fmaf(p0[r], C, mnC));
#pragma unroll
  for (int r = 0; r < 16; ++r) p1[r] = __builtin_amdgcn_exp2f(fmaf(p1[r], C, mnC));
}
DEVI void finishSM(f32x16& p0, f32x16& p1, float alpha, float& l_reg, bf16x8& pa0, bf16x8& pa1, bf16x8& pa2, bf16x8& pa3) {
  float ps = 0;
#pragma unroll
  for (int r = 0; r < 16; ++r) ps += p0[r];
#pragma unroll
  for (int r = 0; r < 16; ++r) ps += p1[r];
  { auto rr = __builtin_amdgcn_permlane32_swap(__float_as_uint(ps), __float_as_uint(ps), false, false);
    ps = __uint_as_float(rr[0]) + __uint_as_float(rr[1]); }
  l_reg = l_reg * alpha + ps;
#define PK4(P, BASE, OUT) do { unsigned a0 = cvtpk(P[BASE + 0], P[BASE + 1]), a1 = cvtpk(P[BASE + 2], P[BASE + 3]);   \
    unsigned b0 = cvtpk(P[BASE + 4], P[BASE + 5]), b1 = cvtpk(P[BASE + 6], P[BASE + 7]);                              \
    auto r0 = __builtin_amdgcn_permlane32_swap(a0, b0, false, false); auto r1 = __builtin_amdgcn_permlane32_swap(a1, b1, false, false); \
    u32x4 w = {r0[0], r1[0], r0[1], r1[1]}; OUT = *reinterpret_cast<bf16x8*>(&w); } while (0)
  PK4(p0, 0, pa0); PK4(p0, 8, pa1); PK4(p1, 0, pa2); PK4(p1, 8, pa3);
#undef PK4
}
DEVI int v_st(int k, int c) { const int kk = (k & ~0xC) | ((k & 4) << 1) | ((k & 8) >> 1); return ((kk >> 3) * 4 + (c >> 5)) * 512 + ((kk & 7) * 32 + (c & 31)) * 2; }
DEVI int v_rd_base(int lane) { return ((lane & 3) << 3) | (((lane >> 2) & 3) << 6) | (((lane >> 4) & 1) << 5) | (((lane >> 5) & 1) << 8); }
constexpr int v_rd_off(int d0, int ks, int half) { return d0 * 512 + ks * 4096 + half * 2048; }
template <int OFF> DEVI s16x4 tr_read(int vb) {
  s16x4 r; asm volatile("ds_read_b64_tr_b16 %0, %1 offset:%2" : "=&v"(r) : "v"(vb), "i"(OFF) : "memory"); return r;
}
template <int D0> DEVI void pv_one(f32x16& od, int vb, bf16x8 pa0, bf16x8 pa1, bf16x8 pa2, bf16x8 pa3) {
  const s16x4 l0 = tr_read<v_rd_off(D0, 0, 0)>(vb), h0 = tr_read<v_rd_off(D0, 0, 1)>(vb), l1 = tr_read<v_rd_off(D0, 1, 0)>(vb), h1 = tr_read<v_rd_off(D0, 1, 1)>(vb);
  const s16x4 l2 = tr_read<v_rd_off(D0, 2, 0)>(vb), h2 = tr_read<v_rd_off(D0, 2, 1)>(vb), l3 = tr_read<v_rd_off(D0, 3, 0)>(vb), h3 = tr_read<v_rd_off(D0, 3, 1)>(vb);
  asm volatile("s_waitcnt lgkmcnt(0)" ::: "memory"); SBAR();
#define PK(L, H) (bf16x8){L[0], L[1], L[2], L[3], H[0], H[1], H[2], H[3]}
  od = __builtin_amdgcn_mfma_f32_32x32x16_bf16(pa0, PK(l0, h0), od, 0, 0, 0);
  od = __builtin_amdgcn_mfma_f32_32x32x16_bf16(pa1, PK(l1, h1), od, 0, 0, 0);
  od = __builtin_amdgcn_mfma_f32_32x32x16_bf16(pa2, PK(l2, h2), od, 0, 0, 0);
  od = __builtin_amdgcn_mfma_f32_32x32x16_bf16(pa3, PK(l3, h3), od, 0, 0, 0);
#undef PK
}
DEVI void pv_d0(f32x16* o, int vb, bf16x8 pa0, bf16x8 pa1, bf16x8 pa2, bf16x8 pa3) {
  pv_one<0>(o[0], vb, pa0, pa1, pa2, pa3); pv_one<1>(o[1], vb, pa0, pa1, pa2, pa3); pv_one<2>(o[2], vb, pa0, pa1, pa2, pa3); pv_one<3>(o[3], vb, pa0, pa1, pa2, pa3);
}

DEVI void attn_item(bf16* __restrict__ PJ, int b, int h, int qb, float lam, float one_m_li, const float* __restrict__ subw, char* lds, bool do_store = true) {
  const int tid = tid_opaque(), wid = tid >> 6, lane = tid & 63, r32 = lane & 31, hi = lane >> 5;
  const int cmp = wid & 1, wq = wid >> 1;
  char* V_lds = lds; char* K_lds = lds + 2 * SHM_V;
  float* wsl = (float*)(lds + 2 * SHM_V + 2 * SHM_K) + wid * 64; float* li_l = wsl; float* al_l = wsl + 32;
  const size_t rowQ = (size_t)b * SEQ + (size_t)qb * 128 + wq * 32;
  const bf16* Kh = PJ + (size_t)b * SEQ * LDP + 512 + h * 128;
  float m1 = -1e30f, l1 = 0; f32x16 o1[4] = {}; bf16x8 qr[4];
  { const bf16* Qw = PJ + (rowQ + r32) * LDP + h * 128 + cmp * 64 + hi * 8;
#pragma unroll
    for (int d0 = 0; d0 < 4; ++d0) qr[d0] = *(const bf16x8*)(Qw + d0 * 16); }
  const int sr = tid >> 4, sc = (tid & 15) * 8, vst0 = v_st(sr, sc), vst1 = v_st(32 + sr, sc);
  const int vb0 = (int)(uintptr_t)V_lds + v_rd_base(lane);
  int kof0[4], kof1[4];
#pragma unroll
  for (int d0 = 0; d0 < 4; ++d0) { const int cb = ((cmp * 4 + d0) * 16 + hi * 8) * 2; kof0[d0] = KSWZ(r32, cb); kof1[d0] = KSWZ(32 + r32, cb); }
  bf16x8 vs0, vs1, ks0, ks1;
  const bf16* kpA = Kh + (size_t)sr * LDP + sc; const bf16* kpB = kpA + (size_t)32 * LDP;
  kpA = launder(kpA); kpB = launder(kpB);
#define SLOAD() do { vs0 = *(const bf16x8*)(kpA + 512); vs1 = *(const bf16x8*)(kpB + 512); ks0 = *(const bf16x8*)(kpA); ks1 = *(const bf16x8*)(kpB); \
    kpA += (size_t)64 * LDP; kpB += (size_t)64 * LDP; } while (0)
#define SWRITE(bb) do { *(bf16x8*)(V_lds + (bb) * SHM_V + vst0) = vs0; *(bf16x8*)(V_lds + (bb) * SHM_V + vst1) = vs1; const int kc = sc * 2; \
    *(bf16x8*)(K_lds + (bb) * SHM_K + KSWZ(sr, kc)) = ks0; *(bf16x8*)(K_lds + (bb) * SHM_K + KSWZ(32 + sr, kc)) = ks1; } while (0)
#define RESC(a, o) do { if (__any((a) < 1.f)) { if (hi == 0) al_l[r32] = (a); asm volatile("s_waitcnt lgkmcnt(0)" ::: "memory"); \
    _Pragma("unroll") for (int d = 0; d < 4; ++d) _Pragma("unroll") for (int r = 0; r < 16; ++r) o[d][r] *= al_l[crow(r, hi)]; } } while (0)
  constexpr int NT = SEQ / 64;
#define QKT(P0, P1, KB) do { P0 = f32x16{}; P1 = f32x16{}; \
    _Pragma("unroll") for (int d0 = 0; d0 < 4; ++d0) { \
      const bf16x8 b0 = *reinterpret_cast<const bf16x8*>((KB) + kof0[d0]); const bf16x8 b1 = *reinterpret_cast<const bf16x8*>((KB) + kof1[d0]); \
      P0 = __builtin_amdgcn_mfma_f32_32x32x16_bf16(b0, qr[d0], P0, 0, 0, 0); P1 = __builtin_amdgcn_mfma_f32_32x32x16_bf16(b1, qr[d0], P1, 0, 0, 0); } } while (0)
#define SWAIT() asm volatile("s_waitcnt vmcnt(0)" ::: "memory")
  f32x16 pA0, pA1, pB0, pB1; float mnA, mnB, alA, alB; bf16x8 pa0, pa1, pa2, pa3;
  SLOAD(); SWAIT(); SWRITE(0); __syncthreads();
  QKT(pA0, pA1, K_lds); partialSM(pA0, pA1, m1, mnA, alA);
  SLOAD(); SWAIT(); SWRITE(1); __syncthreads();
#pragma unroll 1
  for (int j = 1; j + 1 < NT; j += 2) {
    SBAR(); QKT(pB0, pB1, K_lds + SHM_K);
    finishSM(pA0, pA1, alA, l1, pa0, pa1, pa2, pa3); SBAR();
    SLOAD(); SBAR();
    pv_d0(o1, vb0, pa0, pa1, pa2, pa3); partialSM(pB0, pB1, m1, mnB, alB);
    __syncthreads(); SWAIT(); SWRITE(0);
    RESC(alB, o1); __syncthreads();
    SBAR(); QKT(pA0, pA1, K_lds);
    finishSM(pB0, pB1, alB, l1, pa0, pa1, pa2, pa3); SBAR();
    SLOAD(); SBAR();
    pv_d0(o1, vb0 + SHM_V, pa0, pa1, pa2, pa3); partialSM(pA0, pA1, m1, mnA, alA);
    __syncthreads(); SWAIT(); SWRITE(1);
    RESC(alA, o1); __syncthreads();
  }
  SBAR(); QKT(pB0, pB1, K_lds + SHM_K);
  finishSM(pA0, pA1, alA, l1, pa0, pa1, pa2, pa3); SBAR();
  pv_d0(o1, vb0, pa0, pa1, pa2, pa3); partialSM(pB0, pB1, m1, mnB, alB);
  __syncthreads(); RESC(alB, o1);
  finishSM(pB0, pB1, alB, l1, pa0, pa1, pa2, pa3); SBAR();
  pv_d0(o1, vb0 + SHM_V, pa0, pa1, pa2, pa3);
  __syncthreads();
#undef QKT
#undef SWAIT
#undef SLOAD
#undef SWRITE
#undef RESC
  if (hi == 0) li_l[r32] = (cmp ? lam : 1.f) / l1;
  asm volatile("s_waitcnt lgkmcnt(0)" ::: "memory");
#pragma unroll
  for (int r = 0; r < 16; ++r) { const float c1 = li_l[crow(r, hi)];
#pragma unroll
    for (int d = 0; d < 4; ++d) o1[d][r] *= c1; }
  float* X = (float*)lds + wq * 4096 + lane;
  if (cmp == 1) {
#pragma unroll
    for (int d = 0; d < 4; ++d)
#pragma unroll
      for (int r = 0; r < 16; ++r) X[(d * 16 + r) * 64] = o1[d][r];
  }
  __syncthreads();
  if (cmp == 0 && do_store) {
    float sw[4];
#pragma unroll
    for (int d = 0; d < 4; ++d) sw[d] = subw[d * 32 + r32] * one_m_li;
    bf16* Ow = PJ + (rowQ + 4 * hi) * LDP + h * 128 + r32;
#pragma unroll
    for (int r = 0; r < 16; ++r) {
      float s = 0;
#pragma unroll
      for (int d = 0; d < 4; ++d) { const float v = o1[d][r] - X[(d * 16 + r) * 64]; o1[d][r] = v; s += v * v; }
      s = red16(s); s += __shfl_xor(s, 16);
      const float rs = rsqrtf(s * (1.f / 128.f) + 1e-5f);
      bf16* orp = launder(Ow + (size_t)((r & 3) + 8 * (r >> 2)) * LDP);
#pragma unroll
      for (int d = 0; d < 4; ++d) *(unsigned short*)&orp[d * 32] = f2bf(o1[d][r] * rs * sw[d]);
    }
  }
  __syncthreads();
}

DEVI void shiftmix8(const bf16* __restrict__ PJ, size_t R, int pos, int col, const float* __restrict__ mu, float* z) {
  float zc[8], zp[8], zn[8];
  unpack8(*(const u32x4*)&PJ[R * LDP + col], zc);
  if (pos > 0) unpack8(*(const u32x4*)&PJ[(R - 1) * LDP + col], zp); else { for (int j = 0; j < 8; ++j) zp[j] = 0.f; }
  if (pos < SEQ - 1) unpack8(*(const u32x4*)&PJ[(R + 1) * LDP + col], zn); else { for (int j = 0; j < 8; ++j) zn[j] = 0.f; }
#pragma unroll
  for (int j = 0; j < 8; ++j) z[j] = zc[j] + mu[j] * (0.5f * (zp[j] + zn[j]) - zc[j]);
}
DEVI void phase_zl(const Params& p, int l) {
  const bf16* PJ = (const bf16*)(WSV(p) + OFF_U); bf16* ZL = (bf16*)(WSV(p) + OFF_ZL);
  const float* mu = p.tshift_mu + (size_t)l * 1920 + 1536;
  for (int idx = blockIdx.x * NTHR + tid_opaque(); idx < NTOK * 48; idx += gridDim.x * NTHR) {
    const int R = idx / 48, ch = idx % 48, j0 = ch * 8, pos = R & (SEQ - 1);
    float m8[8], z[8];
#pragma unroll
    for (int j = 0; j < 8; ++j) m8[j] = mu[j0 + j];
    shiftmix8(PJ, R, pos, 3072 + j0, m8, z);
    if (j0 < 128) { for (int j = 0; j < 8; ++j) z[j] = tanhf(z[j]); }
    else if (j0 >= 256) { for (int j = 0; j < 8; ++j) z[j] = sigmoidf_(z[j]); }
    *(u32x4*)&ZL[(size_t)R * 384 + j0] = pack8(z);
  }
}

DEVI void phase_mix(const Params& p, int l) {
  bf16* PJm = (bf16*)(WSV(p) + OFF_U); bf16* VV = (bf16*)(WSV(p) + OFF_ZL);
  const float* mu = p.tshift_mu + (size_t)l * 1920;
  for (int idx = blockIdx.x * NTHR + tid_opaque(); idx < NTOK * 192; idx += gridDim.x * NTHR) {
    const int R = idx / 192, col = (idx % 192) * 8, pos = R & (SEQ - 1);
    float m8[8], z[8];
#pragma unroll
    for (int j = 0; j < 8; ++j) m8[j] = mu[col + j];
    shiftmix8(PJm, R, pos, 1536 + col, m8, z);
    if (col < 1024) *(u32x4*)&PJm[(size_t)R * LDP + 512 + col] = pack8(z);
    else *(u32x4*)&VV[(size_t)R * 512 + (col - 1024)] = pack8(z);
  }
}

constexpr int SC_T = 16;
constexpr int SC_DIR = 5 * SC_T * 64 + SC_T * 8;
constexpr int SC_BUF = 2 * SC_DIR;
constexpr int SC_SY = 2 * SC_BUF;
struct ScRaw { u32x2 c0, c1, c2, au, om; };
#define SC_BAR() asm volatile("s_waitcnt lgkmcnt(0)\n\ts_barrier" ::: "memory")
template <int MODE>
DEVI void phase_scan(const Params& p, int l, char* lds) {
  const bf16* PJ = (const bf16*)(WSV(p) + OFF_U);
  const bf16* Aa = (const bf16*)(WSV(p) + OFF_A);
  const _Float16* OM = (const _Float16*)(WSV(p) + OFF_OMW);
  _Float16* YH = (_Float16*)(WSV(p) + OFF_H);
  const bf16* VV = (const bf16*)(WSV(p) + OFF_ZL);
  float* L = (float*)lds;
  const int tid = tid_opaque(), wid = tid >> 6, lane = tid & 63, l16 = lane & 15;
  const bool producer = wid >= 4;
  const int stid = tid & 255;
  const int wdir = (wid >> 1) & 1, rowl = (wid & 1) * 4 + (lane >> 4);
  const int si = stid >> 4, sn = (stid & 15) * 4;
  constexpr int NCH = SEQ / SC_T;
  for (int it = blockIdx.x; it < 256; it += gridDim.x) {
    const int q8 = (it >> 3) & 7, bh_ = (it & 7) + 8 * (it >> 6), h = bh_ & 7, b = bh_ >> 3;
    const int cbase = h * 64 + sn;
    float kk4[4], ka4[4];
#pragma unroll
    for (int j = 0; j < 4; ++j) { kk4[j] = p.k_k[l * 512 + cbase + j]; ka4[j] = p.k_a[l * 512 + cbase + j]; }
    f32x2 Sa = {0.f, 0.f}, Sb = {0.f, 0.f};
    ScRaw xa0, xb0, xa1, xb1;
#define SC_LOAD(chk_, d_, RW) do { const int s = (chk_) * SC_T + si; const int pos = (d_) ? (SEQ - 1 - s) : s; const size_t R = (size_t)b * SEQ + pos; \
      const bf16* base = PJ + R * LDP + 512 + cbase; \
      RW.c0 = *(const u32x2*)(base); RW.c1 = *(const u32x2*)(base + 512); RW.c2 = *(const u32x2*)(VV + R * 512 + cbase); \
      RW.au = *(const u32x2*)&Aa[(R * 2 + (d_)) * 512 + cbase]; RW.om = *(const u32x2*)&OM[(R * 2 + (d_)) * 512 + cbase]; } while (0)
#define SC_PROC(buf_, d_, RW) do { float* sd = L + (buf_) * SC_BUF + (d_) * SC_DIR; \
      const float rc[4] = {bflo(RW.c0[0]), bfhi(RW.c0[0]), bflo(RW.c0[1]), bfhi(RW.c0[1])}; \
      const float kc[4] = {bflo(RW.c1[0]), bfhi(RW.c1[0]), bflo(RW.c1[1]), bfhi(RW.c1[1])}; \
      const float a4[4] = {bflo(RW.au[0]), bfhi(RW.au[0]), bflo(RW.au[1]), bfhi(RW.au[1])}; \
      typedef _Float16 h4 __attribute__((ext_vector_type(4))); const h4 om = __builtin_bit_cast(h4, RW.om); \
      float kq[4], ssq = 0.f; \
      _Pragma("unroll") for (int j = 0; j < 4; ++j) { kq[j] = kc[j] * kk4[j]; ssq += kq[j] * kq[j]; } \
      ssq = red16(ssq); \
      const float inv = rsqrtf(fmaxf(ssq, 1e-24f)); \
      f32x4 w4, k4, b4, kd4, r4; \
      _Pragma("unroll") for (int j = 0; j < 4; ++j) { const float kap = kq[j] * inv; \
        w4[j] = 1.f - (float)om[j]; k4[j] = kap; b4[j] = kap * a4[j]; kd4[j] = kc[j] * (1.f + (a4[j] - 1.f) * ka4[j]); r4[j] = rc[j]; } \
      const int o = si * 64 + sn; \
      *(f32x4*)&sd[o] = w4; *(f32x4*)&sd[SC_T * 64 + o] = k4; *(f32x4*)&sd[2 * SC_T * 64 + o] = b4; \
      *(f32x4*)&sd[3 * SC_T * 64 + o] = kd4; *(f32x4*)&sd[4 * SC_T * 64 + o] = r4; \
      if ((sn >> 3) == q8) { f32x4 v4 = {bflo(RW.c2[0]), bfhi(RW.c2[0]), bflo(RW.c2[1]), bfhi(RW.c2[1])}; *(f32x4*)&sd[5 * SC_T * 64 + si * 8 + (sn & 7)] = v4; } } while (0)
#define SC_WRITEOUT2(chk_, sb_) do { const int e = stid >> 7, u = stid & 127, i = u >> 3, rl = u & 7; \
      const float* sy = L + SC_SY + (sb_) * (2 * SC_T * 128) + e * (SC_T * 128) + (i * 8 + rl) * 16; \
      const f32x4 q0 = *(const f32x4*)&sy[0], q1 = *(const f32x4*)&sy[4], q2 = *(const f32x4*)&sy[8], q3 = *(const f32x4*)&sy[12]; \
      const float tot = ((q0[0] + q0[1]) + (q0[2] + q0[3])) + ((q1[0] + q1[1]) + (q1[2] + q1[3])) + ((q2[0] + q2[1]) + (q2[2] + q2[3])) + ((q3[0] + q3[1]) + (q3[2] + q3[3])); \
      const int s = (chk_) * SC_T + i; const int pos = e ? (SEQ - 1 - s) : s; \
      YH[((size_t)e * NTOK + (size_t)b * SEQ + pos) * 512 + h * 64 + q8 * 8 + rl] = (_Float16)(tot * 0.0625f); } while (0)
#define SC_WRITEOUT(chk_) SC_WRITEOUT2(chk_, (chk_) & 1)
    if (producer) {
      SC_LOAD(0, 0, xa0); SC_LOAD(0, 1, xb0); SC_PROC(0, 0, xa0); SC_PROC(0, 1, xb0);
      SC_LOAD(1, 0, xa0); SC_LOAD(1, 1, xb0); SC_LOAD(2, 0, xa1); SC_LOAD(2, 1, xb1);
      SC_BAR();
#pragma unroll 1
      for (int chk = 0; chk < NCH; chk += 2) {
        if (MODE != 2) {
        SC_PROC(1, 0, xa0); SC_PROC(1, 1, xb0);
        { const int cw_ = chk > 0 ? chk - 1 : 0; SC_WRITEOUT2(cw_, (chk + 1) & 1); }
        { const int cl_ = chk + 3 < NCH ? chk + 3 : NCH - 1; SC_LOAD(cl_, 0, xa0); SC_LOAD(cl_, 1, xb0); }
        }
        SC_BAR();
        if (MODE != 2) {
        SC_PROC(0, 0, xa1); SC_PROC(0, 1, xb1);
        SC_WRITEOUT2(chk, 0);
        { const int cl_ = chk + 4 < NCH ? chk + 4 : NCH - 1; SC_LOAD(cl_, 0, xa1); SC_LOAD(cl_, 1, xb1); }
        }
        SC_BAR();
      }
      SC_WRITEOUT(NCH - 1);
    } else {
      SC_BAR();
      __builtin_amdgcn_s_setprio(3);
#pragma unroll 1
      for (int chk = 0; chk < NCH; ++chk) {
        const float* cw = L + (chk & 1) * SC_BUF + wdir * SC_DIR;
        float* sy = L + SC_SY + (chk & 1) * (2 * SC_T * 128) + wdir * (SC_T * 128) + rowl * 16 + l16;
        const float* cl = cw + l16 * 4; const float* cv = cw + 5 * SC_T * 64 + rowl;
        f32x4 w4 = *(const f32x4*)&cl[0], k4 = *(const f32x4*)&cl[SC_T * 64], b4 = *(const f32x4*)&cl[2 * SC_T * 64],
              kd4 = *(const f32x4*)&cl[3 * SC_T * 64], r4 = *(const f32x4*)&cl[4 * SC_T * 64];
        float vv = cv[0], ylast = 0.f;
#pragma unroll 4
        for (int i = 0; i < (MODE == 1 ? 0 : SC_T); ++i) {
          if (i > 0) sy[(i - 1) * 128] = ylast;
          f32x4 w4n = w4, k4n = k4, b4n = b4, kd4n = kd4, r4n = r4; float vvn = vv;
          if (i + 1 < SC_T) {
            const int o = (i + 1) * 64;
            w4n = *(const f32x4*)&cl[o]; k4n = *(const f32x4*)&cl[SC_T * 64 + o]; b4n = *(const f32x4*)&cl[2 * SC_T * 64 + o];
            kd4n = *(const f32x4*)&cl[3 * SC_T * 64 + o]; r4n = *(const f32x4*)&cl[4 * SC_T * 64 + o]; vvn = cv[(i + 1) * 8];
          }
          __builtin_amdgcn_sched_barrier(0);
          const f32x2 ka = {k4[0], k4[1]}, kb = {k4[2], k4[3]}, wa = {w4[0], w4[1]}, wb = {w4[2], w4[3]}, ba = {b4[0], b4[1]}, bb = {b4[2], b4[3]};
          const f32x2 kda = {kd4[0], kd4[1]}, kdb = {kd4[2], kd4[3]}, ra = {r4[0], r4[1]}, rb = {r4[2], r4[3]};
          f32x2 t = Sa * ka; t = Sb * kb + t;
          const float sa = red16(t[0] + t[1]);
          const f32x2 ua = kda * vv - ba * sa, ub = kdb * vv - bb * sa;
          Sa = Sa * wa + ua; Sb = Sb * wb + ub;
          f32x2 yy = Sa * ra; yy = Sb * rb + yy;
          ylast = yy[0] + yy[1];
          w4 = w4n; k4 = k4n; b4 = b4n; kd4 = kd4n; r4 = r4n; vv = vvn;
          __builtin_amdgcn_sched_barrier(0);
        }
        sy[(SC_T - 1) * 128] = ylast;
        SC_BAR();
      }
      __builtin_amdgcn_s_setprio(0);
    }
    __syncthreads();
#undef SC_LOAD
#undef SC_PROC
#undef SC_WRITEOUT
#undef SC_WRITEOUT2
  }
}

DEVI void phase_post(const Params& p, int l) {
  bf16* PJ = (bf16*)(WSV(p) + OFF_U);
  const bf16* Aa = (const bf16*)(WSV(p) + OFF_A);
  const bf16* G = (const bf16*)(WSV(p) + OFF_G);
  const _Float16* YH = (const _Float16*)(WSV(p) + OFF_H);
  const int tid = tid_opaque(), wid = tid >> 6, lane = tid & 63, c0 = lane * 8;
  const bf16* VV = (const bf16*)(WSV(p) + OFF_ZL);
  float ka[8], rk[8], lw[8], lb[8];
#pragma unroll
  for (int j = 0; j < 8; ++j) {
    ka[j] = p.k_a[l * 512 + c0 + j]; rk[j] = p.r_k[l * 512 + c0 + j]; lw[j] = p.lnx_w[l * 512 + c0 + j]; lb[j] = p.lnx_b[l * 512 + c0 + j];
  }
  for (int R = blockIdx.x * 8 + wid; R < NTOK; R += gridDim.x * 8) {
    const int pos = R & (SEQ - 1);
    float y[8];
    { typedef _Float16 h8 __attribute__((ext_vector_type(8)));
      const h8 yf = *(const h8*)&YH[(size_t)R * 512 + c0], yb = *(const h8*)&YH[((size_t)NTOK + R) * 512 + c0];
#pragma unroll
      for (int j = 0; j < 8; ++j) y[j] = ((float)yf[j] + (float)yb[j]) * 16.f; }
    float s1 = 0;
#pragma unroll
    for (int j = 0; j < 8; ++j) s1 += y[j];
    const float mean = red8(s1) * (1.f / 64.f);
    float s2 = 0;
#pragma unroll
    for (int j = 0; j < 8; ++j) { y[j] -= mean; s2 += y[j] * y[j]; }
    const float rstd = rsqrtf(red8(s2) * (1.f / 64.f) + 64e-5f);
    float rr[8], kk[8], vv[8], a0[8], a1[8], g8[8];
    unpack8(*(const u32x4*)&PJ[(size_t)R * LDP + 512 + c0], rr);
    unpack8(*(const u32x4*)&PJ[(size_t)R * LDP + 1024 + c0], kk);
    unpack8(*(const u32x4*)&VV[(size_t)R * 512 + c0], vv);
    unpack8(*(const u32x4*)&Aa[((size_t)R * 2 + 0) * 512 + c0], a0);
    unpack8(*(const u32x4*)&Aa[((size_t)R * 2 + 1) * 512 + c0], a1);
    unpack8(*(const u32x4*)&G[(size_t)R * 512 + c0], g8);
#ifdef NAIVE_G
    { const bf16* ZLp = (const bf16*)(WSV(p) + OFF_ZL) + (size_t)R * 384 + 256; const float* g2 = p.gate_g2 + (size_t)l * 128 * 512 + c0;
      for (int j = 0; j < 8; ++j) g8[j] = 0.f;
      for (int k = 0; k < 128; ++k) { const float sv = bf2f(*(const unsigned short*)&ZLp[k]);
        for (int j = 0; j < 8; ++j) g8[j] += sv * g2[(size_t)k * 512 + j]; } }
#endif
#ifdef NAIVE_G2T
    { const bf16* ZLp = (const bf16*)(WSV(p) + OFF_ZL) + (size_t)R * 384 + 256; const bf16* g2t = (const bf16*)(WSV(p) + OFF_G2T) + (size_t)c0 * 128;
      for (int j = 0; j < 8; ++j) g8[j] = 0.f;
      for (int k = 0; k < 128; ++k) { const float sv = bf2f(*(const unsigned short*)&ZLp[k]);
        for (int j = 0; j < 8; ++j) g8[j] += sv * bf2f(*(const unsigned short*)&g2t[(size_t)j * 128 + k]); } }
#endif
#define FIN(x) (fabsf(x) < 1e30f)
#ifdef IGN_Y
    for (int j = 0; j < 8; ++j) y[j] = 0.01f * j;
#endif
#ifdef IGN_A
    for (int j = 0; j < 8; ++j) { a0[j] = 0.5f; a1[j] = 0.5f; }
#endif
#ifdef IGN_G
    for (int j = 0; j < 8; ++j) { g8[j] = 1.f; }
#endif
#ifdef IGN_RKV
    for (int j = 0; j < 8; ++j) { rr[j] = 0.1f; kk[j] = 0.1f; vv[j] = 0.1f; }
#endif
#ifdef SAN_Y
    for (int j = 0; j < 8; ++j) if (!FIN(y[j])) y[j] = 0.f;
#endif
#ifdef SAN_A
    for (int j = 0; j < 8; ++j) { if (!FIN(a0[j])) a0[j] = 0.f; if (!FIN(a1[j])) a1[j] = 0.f; }
#endif
#ifdef SAN_G
    for (int j = 0; j < 8; ++j) if (!FIN(g8[j])) g8[j] = 0.f;
#endif
#ifdef SAN_RKV
    for (int j = 0; j < 8; ++j) { if (!FIN(rr[j])) rr[j] = 0.f; if (!FIN(kk[j])) kk[j] = 0.f; if (!FIN(vv[j])) vv[j] = 0.f; }
#endif
    float bs = 0;
#pragma unroll
    for (int j = 0; j < 8; ++j) {
      const float kds = kk[j] * ((1.f + (a0[j] - 1.f) * ka[j]) + (1.f + (a1[j] - 1.f) * ka[j]));
      bs += rr[j] * kds * rk[j];
    }
    bs = red8(bs);
    float o[8];
#pragma unroll
    for (int j = 0; j < 8; ++j) o[j] = (y[j] * rstd * lw[j] + lb[j] + bs * vv[j]) * g8[j];
    *(u32x4*)&PJ[(size_t)R * LDP + 512 + c0] = pack8(o);
  }
}

DEVI bool tile_map(int round, int bid, int nb, int nM, int nN, int SM, int SN, int& mt, int& nt) {
  if (nb == 256) {
    const int xcd = bid & 7, j = bid >> 3, nsn = nN / SN, st = round * 8 + xcd;
    if (st >= (nM / SM) * nsn) return false;
    mt = (st / nsn) * SM + j / SN; nt = (st % nsn) * SN + j % SN; return true;
  }
  const int it = round * nb + bid; if (it >= nM * nN) return false;
  mt = it / nN; nt = it % nN; return true;
}

#define WT_IN ((bf16*)(WSV(p) + OFF_WT_IN))
#define WT_OUT ((bf16*)(WSV(p) + OFF_WT_OUT))
#define WT_UP ((bf16*)(WSV(p) + OFF_WT_UP))
#define WT_DOWN ((bf16*)(WSV(p) + OFF_WT_DOWN))
#define W2T ((bf16*)(WSV(p) + OFF_W2T))
#define A2T ((bf16*)(WSV(p) + OFF_A2T))
#define G2T ((bf16*)(WSV(p) + OFF_G2T))
#define PJ ((bf16*)(WSV(p) + OFF_U))
#define U PJ
#define ZL ((bf16*)(WSV(p) + OFF_ZL))
#define H ((bf16*)(WSV(p) + OFF_H))
#define OMW ((_Float16*)(WSV(p) + OFF_OMW))
#define AA ((bf16*)(WSV(p) + OFF_A))
#define GG ((bf16*)(WSV(p) + OFF_G))
#define MODP ((const float*)(WSV(p) + OFF_MOD))
#define cosT ((const float*)(WSV(p) + OFF_COS))
#define sinT ((const float*)(WSV(p) + OFF_SIN))
__global__ void __launch_bounds__(NTHR) fwd_megakernel(Params p) {
  extern __shared__ __attribute__((aligned(16))) char lds[];
  cg::grid_group grid = cg::this_grid();
  const int nb = gridDim.x, bid = blockIdx.x;
  unsigned* gbar = (unsigned*)(p.ws + OFF_BAR); unsigned gtarget = 0;
  grid.sync();
  phase_mod(p, lds);
  phase_rope(p);
  phase_conv(p, 0, lds);
  GSYNC();

  for (int l = 0; l < 2; ++l) {
    const float* xin = (l == 0) ? p.x : p.out;
    const float* modl = launder(MODP + (size_t)l * 4 * 6144);
    if (l > 0) phase_conv(p, l, lds);
    phase_norm(xin, p.norm1 + l * DM, modl, 0, 1024, H);
#ifdef REP_EW
    phase_norm(xin, p.norm1 + l * DM, modl, 0, 1024, H);
#endif
    GSYNC();
#ifdef REP_G1
    for (int rep = 0; rep < 2; ++rep)
#endif
    for (int rnd = 0;; ++rnd) {
      int mt, nt; if (!tile_map(rnd, bid, nb, 128, 14, 16, 2, mt, nt)) break;
      gemm_tile(H, DM, WT_IN, DM, DM, mt * 256, nt * 256, lds,
        [&](EPI_ARGS) {
          if (nw >= LDP) return;
          bf16* dst = PJ + (size_t)m * LDP + nw + 4 * q;
          if (nw < 1024) {
            const int pos = m & (SEQ - 1);
            const float* ct = cosT + pos * 32 + 4 * q; const float* st = sinT + pos * 32 + 4 * q;
#define ROPE(T1, T2, IDX, OFF) do { const f32x4 cs = *(const f32x4*)(ct + (IDX)), sn = *(const f32x4*)(st + (IDX)); \
              *(u32x2*)(dst + (OFF)) = pk4(T1[0] * cs[0] - T2[0] * sn[0], T1[1] * cs[1] - T2[1] * sn[1], T1[2] * cs[2] - T2[2] * sn[2], T1[3] * cs[3] - T2[3] * sn[3]); \
              *(u32x2*)(dst + (OFF) + 32) = pk4(T1[0] * sn[0] + T2[0] * cs[0], T1[1] * sn[1] + T2[1] * cs[1], T1[2] * sn[2] + T2[2] * cs[2], T1[3] * sn[3] + T2[3] * cs[3]); } while (0)
            ROPE(c0, c2, 0, 0); ROPE(c1, c3, 16, 16); ROPE(c4, c6, 0, 64); ROPE(c5, c7, 16, 80);
#undef ROPE
          } else {
#define PLAIN(C, J) *(u32x2*)(dst + 16 * (J)) = pk4(C[0], C[1], C[2], C[3])
            EPI_TILES(PLAIN);
#undef PLAIN
          }
        });
    }
    GSYNC();
    phase_zl(p, l);
#ifdef REP_EW
    phase_zl(p, l);
#endif
    {
      float s1 = 0, s2 = 0;
      for (int i = 0; i < 64; ++i) { s1 += p.lam_q1[l * 64 + i] * p.lam_k1[l * 64 + i]; s2 += p.lam_q2[l * 64 + i] * p.lam_k2[l * 64 + i]; }
      const float lam_init = 0.8f - 0.6f * expf(-0.3f * (float)l);
      const float lam = expf(s1) - expf(s2) + lam_init;
#ifndef SKIP_ATT
#ifdef REP_ATT
      for (int rep = 0; rep < 2; ++rep) {
      const bool dst_ = rep == 1;
#else
      { const bool dst_ = true;
#endif
      if (nb == 256) {
        const int xcd = bid & 7, jj = bid >> 3;
#pragma unroll 1
        for (int i4 = 0; i4 < 4; ++i4) {
          {
            const int bh = xcd + 8 * (i4 >> 1), qb = jj + 32 * (i4 & 1);
            attn_item(PJ, bh >> 2, bh & 3, qb, lam, 1.f - lam_init, p.subln_w + l * 128, lds, dst_);
          }
        }
      } else {
#pragma unroll 1
        for (int it = bid; it < 1024; it += nb) attn_item(PJ, it >> 8, (it >> 6) & 3, it & 63, lam, 1.f - lam_init, p.subln_w + l * 128, lds, dst_);
      }
      }
#endif
    }
    GSYNC();
#ifdef REP_LORA
    for (int rep = 0; rep < 2; ++rep)
#endif
    for (int it = bid; it < 5 * 256; it += nb) {
      const int g = it / 256, t = it % 256, mt = t >> 1, nt = t & 1, d = g & 1;
      const bf16* Ap; const bf16* Bp; int ldb, KK;
      if (g < 2) { Ap = ZL + d * 64; Bp = W2T + d * 512 * 64; ldb = 64; KK = 64; }
      else if (g < 4) { Ap = ZL + 128 + d * 64; Bp = A2T + d * 512 * 64; ldb = 64; KK = 64; }
      else { Ap = ZL + 256; Bp = G2T; ldb = 128; KK = 128; }
      const float* w0 = p.decay_w0 + (size_t)(l * 2 + d) * 512; const float* a0 = p.icl_a0 + (size_t)(l * 2 + d) * 512;
      gemm_tile(Ap, 384, Bp, ldb, KK, mt * 256, nt * 256, lds,
        [&](EPI_ARGS) {
          auto tile_ = [&](const f32x4v c, const int j) {
            const int col = nw + 16 * j + 4 * q;
            float o[4];
            if (g < 2) {
              const f32x4 w0c = *(const f32x4*)&w0[col];
#pragma unroll
              for (int e = 0; e < 4; ++e) {
                const float nx = -(c[e] + w0c[e]);
                const float sp = fmaxf(nx, 0.f) + __logf(1.f + __expf(-fabsf(nx)));
                const float ee = __expf(-sp - 0.5f);
                o[e] = ee < 0.03125f ? ee * (1.f - ee * (0.5f - ee * (1.f / 6.f - ee * (1.f / 24.f)))) : 1.f - __expf(-ee);
              }
              typedef _Float16 h4 __attribute__((ext_vector_type(4)));
              h4 hv = {(_Float16)o[0], (_Float16)o[1], (_Float16)o[2], (_Float16)o[3]};
              *(h4*)&OMW[((size_t)m * 2 + d) * 512 + col] = hv;
            } else if (g < 4) {
              const f32x4 a0c = *(const f32x4*)&a0[col];
#pragma unroll
              for (int e = 0; e < 4; ++e) o[e] = 1.f / (1.f + __expf(-(c[e] + a0c[e])));
              *(u32x2*)&AA[((size_t)m * 2 + d) * 512 + col] = pk4(o[0], o[1], o[2], o[3]);
            } else {
              *(u32x2*)&GG[(size_t)m * 512 + col] = pk4(c[0], c[1], c[2], c[3]);
            }
          };
          EPI_TILES(tile_);
        });
    }
    GSYNC();
    phase_mix(p, l);
#ifdef REP_EW
    phase_mix(p, l);
#endif
    GSYNC();
#ifndef SKIP_SCAN
#ifdef REP_SCAN
    phase_scan<REP_SCAN>(p, l, lds);
#endif
    phase_scan<0>(p, l, lds);
#endif
    GSYNC();
#ifndef SKIP_POST
    phase_post(p, l);
#endif
    GSYNC();
    for (int rnd = 0;; ++rnd) {
      int mt, nt; if (!tile_map(rnd, bid, nb, 128, 4, 8, 4, mt, nt)) break;
      gemm_tile(PJ, LDP, WT_OUT, DM, DM, mt * 256, nt * 256, lds,
        [&](EPI_ARGS) {
          const int b = m >> 13; const float* gt = modl + b * 6144 + 2048 + nw + 4 * q;
          const float* xi = xin + (size_t)m * DM + nw + 4 * q; float* xo = p.out + (size_t)m * DM + nw + 4 * q;
          auto tile_ = [&](const f32x4v c, const int j) {
            const f32x4 x4 = *(const f32x4*)(xi + 16 * j), g4 = *(const f32x4*)(gt + 16 * j);
            f32x4 o = {x4[0] + g4[0] * c[0], x4[1] + g4[1] * c[1], x4[2] + g4[2] * c[2], x4[3] + g4[3] * c[3]};
            *(f32x4*)(xo + 16 * j) = o;
          };
          EPI_TILES(tile_);
        });
    }
    GSYNC();
    phase_norm(p.out, p.norm2 + l * DM, modl, 3072, 4096, H);
#ifdef REP_EW
    phase_norm(p.out, p.norm2 + l * DM, modl, 3072, 4096, H);
#endif
    GSYNC();
#ifdef REP_UP
    for (int rep = 0; rep < 2; ++rep)
#endif
    for (int rnd = 0;; ++rnd) {
      int mt, nt; if (!tile_map(rnd, bid, nb, 128, 16, 4, 8, mt, nt)) break;
      gemm_tile(H, DM, WT_UP, DM, DM, mt * 256, nt * 256, lds,
        [&](EPI_ARGS) {
          bf16* dst = U + (size_t)m * DFF + nw + 4 * q;
          auto tile_ = [&](const f32x4v c, const int j) {
            const float u0 = fmaxf(c[0], 0.f), u1 = fmaxf(c[1], 0.f), u2 = fmaxf(c[2], 0.f), u3 = fmaxf(c[3], 0.f);
            *(u32x2*)(dst + 16 * j) = pk4(u0 * u0, u1 * u1, u2 * u2, u3 * u3);
          };
          EPI_TILES(tile_);
        });
    }
    GSYNC();
    for (int rnd = 0;; ++rnd) {
      int mt, nt; if (!tile_map(rnd, bid, nb, 128, 4, 8, 4, mt, nt)) break;
      gemm_tile(U, DFF, WT_DOWN, DFF, DFF, mt * 256, nt * 256, lds,
        [&](EPI_ARGS) {
          const int b = m >> 13; const float* gt = modl + b * 6144 + 5120 + nw + 4 * q;
          float* xo = p.out + (size_t)m * DM + nw + 4 * q;
          auto tile_ = [&](const f32x4v c, const int j) {
            const f32x4 x4 = *(const f32x4*)(xo + 16 * j), g4 = *(const f32x4*)(gt + 16 * j);
            f32x4 o = {x4[0] + g4[0] * c[0], x4[1] + g4[1] * c[1], x4[2] + g4[2] * c[2], x4[3] + g4[3] * c[3]};
            *(f32x4*)(xo + 16 * j) = o;
          };
          EPI_TILES(tile_);
        });
    }
    GSYNC();
  }
#ifdef REP_BAR
  for (int i = 0; i < 20; ++i) GSYNC();
#endif
  phase_final_norm(p.out, p.norm_f);
}

extern "C" void kernel_launch(void* const* d_in, const int* in_sizes, int n_in, void* d_out, int out_size, void* d_ws, size_t ws_size,
                              hipStream_t stream) {
  static int grid_blocks = 0;
  if (n_in != 27 || ws_size < WS_NEED) { fprintf(stderr, "kernel_launch: bad n_in %d or ws_size %zu (< %zu)\n", n_in, ws_size, (size_t)WS_NEED); return; }
  if (!grid_blocks) {
    int dev = 0, cus = 0, per_cu = 0;
    hipGetDevice(&dev);
    hipDeviceGetAttribute(&cus, hipDeviceAttributeMultiprocessorCount, dev);
    hipFuncSetAttribute((const void*)fwd_megakernel, hipFuncAttributeMaxDynamicSharedMemorySize, LDS_BYTES);
    hipOccupancyMaxActiveBlocksPerMultiprocessor(&per_cu, fwd_megakernel, NTHR, LDS_BYTES);
    if (per_cu < 1) per_cu = 1;
    if (per_cu > 1) per_cu = 1;
    grid_blocks = cus * per_cu;
  }
  Params p{};
  const float** pp = (const float**)&p;
  for (int i = 0; i < 27; ++i) pp[i] = (const float*)d_in[i];
  p.out = (float*)d_out; p.ws = (char*)d_ws;
  for (int i = 0; i < 32; ++i) p.inv_freq[i] = 1.0f / powf(10000.0f, (float)(2 * i) / 64.0f);
  hipMemsetAsync((char*)d_ws + OFF_BAR, 0, 256, stream);
  void* args[] = {&p};
  hipError_t e = hipLaunchCooperativeKernel((void*)fwd_megakernel, dim3(grid_blocks), dim3(NTHR), args, LDS_BYTES, stream);
  if (e != hipSuccess) fprintf(stderr, "cooperative launch failed: %s (grid %d)\n", hipGetErrorString(e), grid_blocks);
}
```

```cpp
#include <hip/hip_runtime.h>
#include <hip/hip_bf16.h>
#include <hip/hip_cooperative_groups.h>
#include <cstdio>
#include <cmath>
namespace cg = cooperative_groups;

#define DEVI __device__ __forceinline__
using bf16 = __hip_bfloat16;
typedef short bf16x8 __attribute__((ext_vector_type(8)));
typedef short s16x4 __attribute__((ext_vector_type(4)));
typedef float f32x16 __attribute__((ext_vector_type(16)));
typedef float f32x4 __attribute__((ext_vector_type(4)));
typedef unsigned u32x4 __attribute__((ext_vector_type(4)));
typedef unsigned u32x2 __attribute__((ext_vector_type(2)));
typedef float f32x2 __attribute__((ext_vector_type(2)));

constexpr int NTOK = 32768, SEQ = 8192, DM = 1024, LDP = 3456, DFF = 4096;
constexpr int NTHR = 512;
constexpr size_t MiB = 1024 * 1024;
constexpr size_t OFF_WT_IN = 0;
constexpr size_t OFF_WT_OUT = OFF_WT_IN + (size_t)3456 * 1024 * 2;
constexpr size_t OFF_WT_UP = OFF_WT_OUT + (size_t)1024 * 1024 * 2;
constexpr size_t OFF_WT_DOWN = OFF_WT_UP + (size_t)4096 * 1024 * 2;
constexpr size_t OFF_W2T = OFF_WT_DOWN + (size_t)4096 * 1024 * 2;
constexpr size_t OFF_A2T = OFF_W2T + (size_t)2 * 512 * 64 * 2;
constexpr size_t OFF_G2T = OFF_A2T + (size_t)2 * 512 * 64 * 2;
constexpr size_t OFF_U = 26 * MiB;
constexpr size_t OFF_ZL = OFF_U + 216 * MiB;
constexpr size_t OFF_H = OFF_U + 256 * MiB;
constexpr size_t OFF_OMW = OFF_H + 64 * MiB;
constexpr size_t OFF_A = OFF_OMW + 64 * MiB;
constexpr size_t OFF_G = OFF_A + 64 * MiB;
constexpr size_t OFF_MOD = OFF_G + 32 * MiB;
constexpr size_t OFF_COS = OFF_MOD + 1 * MiB;
constexpr size_t OFF_SIN = OFF_COS + 1 * MiB;
constexpr size_t OFF_BAR = OFF_SIN + 1 * MiB;
constexpr size_t WS_NEED = OFF_BAR + 1 * MiB;
constexpr int LDS_BYTES = 131072;

struct Params {
  const float *x, *c, *w_ada, *b_ada, *norm1, *norm2, *w_in, *w_out, *lam_q1, *lam_k1, *lam_q2, *lam_k2, *subln_w, *tshift_mu,
      *decay_w0, *decay_w2, *icl_a0, *icl_a2, *gate_g2, *k_k, *k_a, *r_k, *lnx_w, *lnx_b, *w_up, *w_down, *norm_f;
  float* out;
  char* ws;
  float inv_freq[32];
};

DEVI void grid_barrier(unsigned* bar, unsigned& target) {
  asm volatile("s_waitcnt vmcnt(0) lgkmcnt(0)" ::: "memory");
  __syncthreads();
  target += gridDim.x;
  if (threadIdx.x == 0) {
    __builtin_amdgcn_fence(__ATOMIC_RELEASE, "agent");
    asm volatile("s_waitcnt vmcnt(0)" ::: "memory");
    __hip_atomic_fetch_add(bar, 1u, __ATOMIC_RELAXED, __HIP_MEMORY_SCOPE_AGENT);
    while (__hip_atomic_load(bar, __ATOMIC_RELAXED, __HIP_MEMORY_SCOPE_AGENT) < target) __builtin_amdgcn_s_sleep(2);
    __builtin_amdgcn_fence(__ATOMIC_ACQUIRE, "agent");
    asm volatile("s_waitcnt vmcnt(0)" ::: "memory");
  }
  __syncthreads();
}
#define GSYNC() grid_barrier(gbar, gtarget)
struct Params;
#define SBAR() __builtin_amdgcn_sched_barrier(0)
#define GAS __attribute__((address_space(1)))
#define LAS __attribute__((address_space(3)))
template <class T> DEVI T* launder(T* q) { unsigned long long u = (unsigned long long)q; asm volatile("" : "+v"(u)); return (T*)(GAS T*)u; }
DEVI char* ws_launder(char* w) { return launder(w); }
#define WSV(p) ws_launder((p).ws)
DEVI int tid_opaque() { int t = threadIdx.x; asm volatile("" : "+v"(t)); return t; }
DEVI int crow(int r, int hi) { return (r & 3) + 8 * (r >> 2) + 4 * hi; }
DEVI unsigned cvtpk(float lo, float hi) {
  unsigned r; asm volatile("v_cvt_pk_bf16_f32 %0, %1, %2" : "=v"(r) : "v"(lo), "v"(hi)); return r;
}
DEVI unsigned short f2bf(float x) { return (unsigned short)(cvtpk(x, 0.f) & 0xffffu); }
DEVI float bf2f(unsigned short u) { return __uint_as_float(((unsigned)u) << 16); }
DEVI float bflo(unsigned u) { return __uint_as_float(u << 16); }
DEVI float bfhi(unsigned u) { return __uint_as_float(u & 0xffff0000u); }
template <int CTRL> DEVI float dppf(float x) {
  return __builtin_bit_cast(float, __builtin_amdgcn_mov_dpp(__builtin_bit_cast(int, x), CTRL, 0xf, 0xf, true));
}
DEVI float red8(float x) { x += dppf<0xB1>(x); x += dppf<0x4E>(x); x += dppf<0x141>(x); return x; }
DEVI float red16(float x) { x = red8(x); x += dppf<0x128>(x); return x; }
DEVI float red64(float x) { x = red16(x); x += __shfl_xor(x, 16); x += __shfl_xor(x, 32); return x; }
DEVI float sigmoidf_(float x) { return __builtin_amdgcn_rcpf(1.f + __expf(-x)); }
DEVI void unpack8(u32x4 v, float* f) {
  f[0] = bflo(v[0]); f[1] = bfhi(v[0]); f[2] = bflo(v[1]); f[3] = bfhi(v[1]);
  f[4] = bflo(v[2]); f[5] = bfhi(v[2]); f[6] = bflo(v[3]); f[7] = bfhi(v[3]);
}
DEVI u32x4 pack8(const float* f) {
  u32x4 w = {cvtpk(f[0], f[1]), cvtpk(f[2], f[3]), cvtpk(f[4], f[5]), cvtpk(f[6], f[7])}; return w;
}

DEVI void phase_mod(const Params& p, char* lds) {
  float* sc = (float*)lds;
  float* red = sc + 4096;
  const int tid = tid_opaque(), w = tid >> 6, lane = tid & 63;
  for (int i = tid; i < 4096; i += NTHR) { float v = p.c[i]; sc[i] = v / (1.f + expf(-v)); }
  __syncthreads();
  float* mod = (float*)(WSV(p) + OFF_MOD);
  for (int it = blockIdx.x; it < 192; it += gridDim.x) {
    const int l = it / 96, col = (it % 96) * 64 + lane;
    const float* W = p.w_ada + (size_t)l * 1024 * 6144 + col;
    float a0 = 0, a1 = 0, a2 = 0, a3 = 0;
#pragma unroll 1
    for (int kb = w * 128; kb < w * 128 + 128; kb += 16) {
      float wv[16];
#pragma unroll
      for (int j = 0; j < 16; ++j) wv[j] = W[(size_t)(kb + j) * 6144];
#pragma unroll
      for (int j = 0; j < 16; ++j) { const int k = kb + j; a0 += sc[k] * wv[j]; a1 += sc[1024 + k] * wv[j]; a2 += sc[2048 + k] * wv[j]; a3 += sc[3072 + k] * wv[j]; }
    }
    red[(w * 4 + 0) * 64 + lane] = a0; red[(w * 4 + 1) * 64 + lane] = a1;
    red[(w * 4 + 2) * 64 + lane] = a2; red[(w * 4 + 3) * 64 + lane] = a3;
    __syncthreads();
    if (tid < 256) {
      const int bb = tid >> 6; float s = 0;
      for (int ww = 0; ww < 8; ++ww) s += red[(ww * 4 + bb) * 64 + lane];
      mod[(l * 4 + bb) * 6144 + col] = s + p.b_ada[l * 6144 + col];
    }
    __syncthreads();
  }
}

DEVI void phase_rope(const Params& p) {
  float* cosT = (float*)(WSV(p) + OFF_COS); float* sinT = (float*)(WSV(p) + OFF_SIN);
  for (int idx = blockIdx.x * NTHR + tid_opaque(); idx < SEQ * 32; idx += gridDim.x * NTHR) {
    const int pos = idx >> 5, i = idx & 31;
    const float ang = (float)pos * p.inv_freq[i];
    double q = (double)ang * 0.15915494309189533577; q -= floor(q);
    const float f = (float)q;
    cosT[idx] = __builtin_amdgcn_cosf(f); sinT[idx] = __builtin_amdgcn_sinf(f);
  }
}

struct ConvJob { const float* src; bf16* dst; int ldsrc, lddst, k0, n0; };
DEVI bool conv_job(const Params& p, int l, int it, ConvJob& j) {
  if (it >= 3216) return false;
  const float* src; bf16* dst; int K, N, t = it;
  char* wsb = launder(p.ws);
  if (t < 864) { src = p.w_in + (size_t)l * 1024 * 3456; dst = (bf16*)(wsb + OFF_WT_IN); K = 1024; N = 3456; }
  else if ((t -= 864) < 256) { src = p.w_out + (size_t)l * 1024 * 1024; dst = (bf16*)(wsb + OFF_WT_OUT); K = 1024; N = 1024; }
  else if ((t -= 256) < 1024) { src = p.w_up + (size_t)l * 1024 * 4096; dst = (bf16*)(wsb + OFF_WT_UP); K = 1024; N = 4096; }
  else if ((t -= 1024) < 1024) { src = p.w_down + (size_t)l * 4096 * 1024; dst = (bf16*)(wsb + OFF_WT_DOWN); K = 4096; N = 1024; }
  else if ((t -= 1024) < 16) { const int d = t >> 3; t &= 7; src = p.decay_w2 + (size_t)(l * 2 + d) * 64 * 512; dst = (bf16*)(wsb + OFF_W2T) + d * 512 * 64; K = 64; N = 512; }
  else if ((t -= 16) < 16) { const int d = t >> 3; t &= 7; src = p.icl_a2 + (size_t)(l * 2 + d) * 64 * 512; dst = (bf16*)(wsb + OFF_A2T) + d * 512 * 64; K = 64; N = 512; }
  else { t -= 16; src = p.gate_g2 + (size_t)l * 128 * 512; dst = (bf16*)(wsb + OFF_G2T); K = 128; N = 512; }
  const int nt = N / 64;
  j.src = src; j.dst = dst; j.ldsrc = N; j.lddst = K; j.k0 = (t / nt) * 64; j.n0 = (t % nt) * 64;
  return true;
}
DEVI void phase_conv(const Params& p, int l, char* lds) {
  float* tile = (float*)lds;
  const int tid = tid_opaque();
  const int lk = tid >> 4, ln = (tid & 15) * 4;
  ConvJob cur, nxt; f32x4 v0, v1, w0 = {0.f, 0.f, 0.f, 0.f}, w1 = {0.f, 0.f, 0.f, 0.f};
  int it = blockIdx.x;
  bool have = conv_job(p, l, it, cur);
  if (have) { v0 = *(const f32x4*)&cur.src[(size_t)(cur.k0 + lk) * cur.ldsrc + cur.n0 + ln]; v1 = *(const f32x4*)&cur.src[(size_t)(cur.k0 + 32 + lk) * cur.ldsrc + cur.n0 + ln]; }
  while (have) {
    const bool hn = conv_job(p, l, it + gridDim.x, nxt);
    if (hn) { w0 = *(const f32x4*)&nxt.src[(size_t)(nxt.k0 + lk) * nxt.ldsrc + nxt.n0 + ln]; w1 = *(const f32x4*)&nxt.src[(size_t)(nxt.k0 + 32 + lk) * nxt.ldsrc + nxt.n0 + ln]; }
    tile[lk * 65 + ln + 0] = v0[0]; tile[lk * 65 + ln + 1] = v0[1]; tile[lk * 65 + ln + 2] = v0[2]; tile[lk * 65 + ln + 3] = v0[3];
    tile[(32 + lk) * 65 + ln + 0] = v1[0]; tile[(32 + lk) * 65 + ln + 1] = v1[1]; tile[(32 + lk) * 65 + ln + 2] = v1[2]; tile[(32 + lk) * 65 + ln + 3] = v1[3];
    __syncthreads();
    {
      const int n = tid >> 3, kc = (tid & 7) * 8; float f[8];
#pragma unroll
      for (int j = 0; j < 8; ++j) f[j] = tile[(kc + j) * 65 + n];
      *(u32x4*)&cur.dst[(size_t)(cur.n0 + n) * cur.lddst + cur.k0 + kc] = pack8(f);
    }
    __syncthreads();
    cur = nxt; v0 = w0; v1 = w1; have = hn; it += gridDim.x;
  }
}

DEVI void phase_norm(const float* __restrict__ xin, const float* __restrict__ g, const float* __restrict__ modl, int shoff, int scoff,
                     bf16* __restrict__ H) {
  const int tid = tid_opaque(), w = tid >> 6, lane = tid & 63;
  for (int row = blockIdx.x * 8 + w; row < NTOK; row += gridDim.x * 8) {
    const int b = row >> 13; f32x4 v[4]; float ss = 0;
#pragma unroll
    for (int j = 0; j < 4; ++j) { v[j] = *(const f32x4*)&xin[(size_t)row * DM + j * 256 + lane * 4]; ss += v[j][0] * v[j][0] + v[j][1] * v[j][1] + v[j][2] * v[j][2] + v[j][3] * v[j][3]; }
    ss = red64(ss);
    const float rstd = rsqrtf(ss * (1.f / 1024.f) + 1e-6f);
#pragma unroll
    for (int j = 0; j < 4; ++j) {
      const int col = j * 256 + lane * 4;
      const f32x4 g4 = *(const f32x4*)&g[col];
      const f32x4 sc4 = *(const f32x4*)&modl[b * 6144 + scoff + col];
      const f32x4 sh4 = *(const f32x4*)&modl[b * 6144 + shoff + col];
      float o[4];
#pragma unroll
      for (int e = 0; e < 4; ++e) o[e] = v[j][e] * rstd * g4[e] * (1.f + sc4[e]) + sh4[e];
      u32x2 pk = {cvtpk(o[0], o[1]), cvtpk(o[2], o[3])};
      *(u32x2*)&H[(size_t)row * DM + col] = pk;
    }
  }
}
DEVI void phase_final_norm(float* __restrict__ x, const float* __restrict__ g) {
  const int tid = tid_opaque(), w = tid >> 6, lane = tid & 63;
  for (int row = blockIdx.x * 8 + w; row < NTOK; row += gridDim.x * 8) {
    f32x4 v[4]; float ss = 0;
#pragma unroll
    for (int j = 0; j < 4; ++j) { v[j] = *(const f32x4*)&x[(size_t)row * DM + j * 256 + lane * 4]; ss += v[j][0] * v[j][0] + v[j][1] * v[j][1] + v[j][2] * v[j][2] + v[j][3] * v[j][3]; }
    ss = red64(ss);
    const float rstd = rsqrtf(ss * (1.f / 1024.f) + 1e-6f);
#pragma unroll
    for (int j = 0; j < 4; ++j) {
      const int col = j * 256 + lane * 4;
      const f32x4 g4 = *(const f32x4*)&g[col];
      f32x4 o = {v[j][0] * rstd * g4[0], v[j][1] * rstd * g4[1], v[j][2] * rstd * g4[2], v[j][3] * rstd * g4[3]};
#ifdef SANITIZE
      for (int e = 0; e < 4; ++e) if (!(fabsf(o[e]) < 1e30f)) o[e] = 0.f;
#endif
      *(f32x4*)&x[(size_t)row * DM + col] = o;
    }
  }
}

typedef float f32x4v __attribute__((ext_vector_type(4)));
template <class Epi>
DEVI void gemm_tile(const bf16* __restrict__ A, int lda, const bf16* __restrict__ Bt, int ldb, int K, int m0, int n0, char* lds, Epi&& epi) {
  const int tid = tid_opaque(), wid = tid >> 6, lane = tid & 63, l15 = lane & 15, q = lane >> 4;
  const int wm = wid >> 1, wn = wid & 1;
  char* As = lds; char* Bs = lds + 65536;
  f32x4v acc[4][8];
#pragma unroll
  for (int i = 0; i < 4; ++i)
#pragma unroll
    for (int j = 0; j < 8; ++j) acc[i][j] = f32x4v{0.f, 0.f, 0.f, 0.f};
  const int lrow = tid >> 3, lch = tid & 7, gch = lch ^ ((lrow >> 1) & 7);
  const bf16* Ag = launder(A) + (size_t)(m0 + lrow) * lda + gch * 8;
  const bf16* Bg = launder(Bt) + (size_t)(n0 + lrow) * ldb + gch * 8;
#define GLDS(buf, k0) do { char* a_ = As + (buf) * 32768 + wid * 1024; char* b_ = Bs + (buf) * 32768 + wid * 1024; \
    _Pragma("unroll") for (int i_ = 0; i_ < 4; ++i_) { \
      __builtin_amdgcn_global_load_lds((const GAS unsigned*)(Ag + (size_t)(64 * i_) * lda + (k0)), (LAS unsigned*)(a_ + i_ * 8192), 16, 0, 0); \
      __builtin_amdgcn_global_load_lds((const GAS unsigned*)(Bg + (size_t)(64 * i_) * ldb + (k0)), (LAS unsigned*)(b_ + i_ * 8192), 16, 0, 0); } } while (0)
  const int KT = K >> 6;
  const int sw = (l15 >> 1) & 7;
  const int aoff = (wm * 64 + l15) * 128, boff = (wn * 128 + l15) * 128;
  GLDS(0, 0); asm volatile("s_waitcnt vmcnt(0)" ::: "memory"); __syncthreads();
#pragma unroll 2
  for (int kt = 0; kt < KT; ++kt) {
    if (kt + 1 < KT) GLDS((kt + 1) & 1, (kt + 1) * 64);
    const char* Ab = As + (kt & 1) * 32768 + aoff; const char* Bb = Bs + (kt & 1) * 32768 + boff;
#pragma unroll
    for (int s2 = 0; s2 < 2; ++s2) {
      const int ch = ((4 * s2 + q) ^ sw) * 16;
      bf16x8 af[4];
#pragma unroll
      for (int i = 0; i < 4; ++i) af[i] = *(const bf16x8*)(Ab + i * 2048 + ch);
#pragma unroll
      for (int jh = 0; jh < 2; ++jh) {
        bf16x8 bfr[4];
#pragma unroll
        for (int j = 0; j < 4; ++j) bfr[j] = *(const bf16x8*)(Bb + (jh * 4 + j) * 2048 + ch);
#pragma unroll
        for (int i = 0; i < 4; ++i)
#pragma unroll
          for (int j = 0; j < 4; ++j) acc[i][jh * 4 + j] = __builtin_amdgcn_mfma_f32_16x16x32_bf16(bfr[j], af[i], acc[i][jh * 4 + j], 0, 0, 0);
        SBAR();
      }
    }
    asm volatile("s_waitcnt vmcnt(0)" ::: "memory");
    __syncthreads();
  }
#undef GLDS
  const int mw = m0 + wm * 64 + l15, nw = n0 + wn * 128;
#pragma unroll
  for (int i = 0; i < 4; ++i) epi(acc[i][0], acc[i][1], acc[i][2], acc[i][3], acc[i][4], acc[i][5], acc[i][6], acc[i][7], mw + 16 * i, nw, q);
}
#define EPI_ARGS f32x4v c0, f32x4v c1, f32x4v c2, f32x4v c3, f32x4v c4, f32x4v c5, f32x4v c6, f32x4v c7, int m, int nw, int q
#define EPI_TILES(F) do { F(c0, 0); F(c1, 1); F(c2, 2); F(c3, 3); F(c4, 4); F(c5, 5); F(c6, 6); F(c7, 7); } while (0)
DEVI u32x2 pk4(float a, float b, float c, float d) { u32x2 r = {cvtpk(a, b), cvtpk(c, d)}; return r; }

constexpr float ATT_SCALE = 0.125f;
constexpr float ATT_THR = 8.f;
constexpr int SHM_V = 64 * 128 * 2, SHM_K = 64 * 128 * 2;
#define KSWZ(row, colB) ((row) * 256 + ((colB) ^ (((row) & 7) << 4)))
DEVI void partialSM(f32x16& p0, f32x16& p1, float& m_reg, float& mn, float& alpha) {
  constexpr float C = ATT_SCALE * 1.4426950408889634f;
  float pmax = p0[0];
#pragma unroll
  for (int r = 1; r < 16; ++r) pmax = fmaxf(pmax, p0[r]);
#pragma unroll
  for (int r = 0; r < 16; ++r) pmax = fmaxf(pmax, p1[r]);
  { auto rr = __builtin_amdgcn_permlane32_swap(__float_as_uint(pmax), __float_as_uint(pmax), false, false);
    pmax = fmaxf(__uint_as_float(rr[0]), __uint_as_float(rr[1])); }
  if (__builtin_expect(__all(pmax - m_reg <= ATT_THR / ATT_SCALE), 1)) { mn = m_reg; alpha = 1.f; }
  else { mn = fmaxf(m_reg, pmax); alpha = __builtin_amdgcn_exp2f((m_reg - mn) * C); m_reg = mn; }
  const float mnC = -mn * C;
#pragma unroll
  for (int r = 0; r < 16; ++r) p0[r] = __builtin_amdgcn_exp2f(fmaf(p0[r], C, mnC));
#pragma unroll
  for (int r = 0; r < 16; ++r) p1[r] = __builtin_amdgcn_exp2f(fmaf(p1[r], C, mnC));
}
DEVI void finishSM(f32x16& p0, f32x16& p1, float alpha, float& l_reg, bf16x8& pa0, bf16x8& pa1, bf16x8& pa2, bf16x8& pa3) {
  float ps = 0;
#pragma unroll
  for (int r = 0; r < 16; ++r) ps += p0[r];
#pragma unroll
  for (int r = 0; r < 16; ++r) ps += p1[r];
  { auto rr = __builtin_amdgcn_permlane32_swap(__float_as_uint(ps), __float_as_uint(ps), false, false);
    ps = __uint_as_float(rr[0]) + __uint_as_float(rr[1]); }
  l_reg = l_reg * alpha + ps;
#define PK4(P, BASE, OUT) do { unsigned a0 = cvtpk(P[BASE + 0], P[BASE + 1]), a1 = cvtpk(P[BASE + 2], P[BASE + 3]);   \
    unsigned b0 = cvtpk(P[BASE + 4], P[BASE + 5]), b1 = cvtpk(P[BASE + 6], P[BASE + 7]);                              \
    auto r0 = __builtin_amdgcn_permlane32_swap(a0, b0, false, false); auto r1 = __builtin_amdgcn_permlane32_swap(a1, b1, false, false); \
    u32x4 w = {r0[0], r1[0], r0[1], r1[1]}; OUT = *reinterpret_cast<bf16x8*>(&w); } while (0)
  PK4(p0, 0, pa0); PK4(p0, 8, pa1); PK4(p1, 0, pa2); PK4(p1, 8, pa3);
#undef PK4
}
DEVI int v_st(int k, int c) { const int kk = (k & ~0xC) | ((k & 4) << 1) | ((k & 8) >> 1); return ((kk >> 3) * 4 + (c >> 5)) * 512 + ((kk & 7) * 32 + (c & 31)) * 2; }
DEVI int v_rd_base(int lane) { return ((lane & 3) << 3) | (((lane >> 2) & 3) << 6) | (((lane >> 4) & 1) << 5) | (((lane >> 5) & 1) << 8); }
constexpr int v_rd_off(int d0, int ks, int half) { return d0 * 512 + ks * 4096 + half * 2048; }
template <int OFF> DEVI s16x4 tr_read(int vb) {
  s16x4 r; asm volatile("ds_read_b64_tr_b16 %0, %1 offset:%2" : "=&v"(r) : "v"(vb), "i"(OFF) : "memory"); return r;
}
template <int D0> DEVI void pv_one(f32x16& od, int vb, bf16x8 pa0, bf16x8 pa1, bf16x8 pa2, bf16x8 pa3) {
  const s16x4 l0 = tr_read<v_rd_off(D0, 0, 0)>(vb), h0 = tr_read<v_rd_off(D0, 0, 1)>(vb), l1 = tr_read<v_rd_off(D0, 1, 0)>(vb), h1 = tr_read<v_rd_off(D0, 1, 1)>(vb);
  const s16x4 l2 = tr_read<v_rd_off(D0, 2, 0)>(vb), h2 = tr_read<v_rd_off(D0, 2, 1)>(vb), l3 = tr_read<v_rd_off(D0, 3, 0)>(vb), h3 = tr_read<v_rd_off(D0, 3, 1)>(vb);
  asm volatile("s_waitcnt lgkmcnt(0)" ::: "memory"); SBAR();
#define PK(L, H) (bf16x8){L[0], L[1], L[2], L[3], H[0], H[1], H[2], H[3]}
  od = __builtin_amdgcn_mfma_f32_32x32x16_bf16(pa0, PK(l0, h0), od, 0, 0, 0);
  od = __builtin_amdgcn_mfma_f32_32x32x16_bf16(pa1, PK(l1, h1), od, 0, 0, 0);
  od = __builtin_amdgcn_mfma_f32_32x32x16_bf16(pa2, PK(l2, h2), od, 0, 0, 0);
  od = __builtin_amdgcn_mfma_f32_32x32x16_bf16(pa3, PK(l3, h3), od, 0, 0, 0);
#undef PK
}
DEVI void pv_d0(f32x16* o, int vb, bf16x8 pa0, bf16x8 pa1, bf16x8 pa2, bf16x8 pa3) {
  pv_one<0>(o[0], vb, pa0, pa1, pa2, pa3); pv_one<1>(o[1], vb, pa0, pa1, pa2, pa3); pv_one<2>(o[2], vb, pa0, pa1, pa2, pa3); pv_one<3>(o[3], vb, pa0, pa1, pa2, pa3);
}

DEVI void attn_item(bf16* __restrict__ PJ, int b, int h, int qb, float lam, float one_m_li, const float* __restrict__ subw, char* lds, bool do_store = true) {
  const int tid = tid_opaque(), wid = tid >> 6, lane = tid & 63, r32 = lane & 31, hi = lane >> 5;
  const int cmp = wid & 1, wq = wid >> 1;
  char* V_lds = lds; char* K_lds = lds + 2 * SHM_V;
  float* wsl = (float*)(lds + 2 * SHM_V + 2 * SHM_K) + wid * 64; float* li_l = wsl; float* al_l = wsl + 32;
  const size_t rowQ = (size_t)b * SEQ + (size_t)qb * 128 + wq * 32;
  const bf16* Kh = PJ + (size_t)b * SEQ * LDP + 512 + h * 128;
  float m1 = -1e30f, l1 = 0; f32x16 o1[4] = {}; bf16x8 qr[4];
  { const bf16* Qw = PJ + (rowQ + r32) * LDP + h * 128 + cmp * 64 + hi * 8;
#pragma unroll
    for (int d0 = 0; d0 < 4; ++d0) qr[d0] = *(const bf16x8*)(Qw + d0 * 16); }
  const int sr = tid >> 4, sc = (tid & 15) * 8, vst0 = v_st(sr, sc), vst1 = v_st(32 + sr, sc);
  const int vb0 = (int)(uintptr_t)V_lds + v_rd_base(lane);
  int kof0[4], kof1[4];
#pragma unroll
  for (int d0 = 0; d0 < 4; ++d0) { const int cb = ((cmp * 4 + d0) * 16 + hi * 8) * 2; kof0[d0] = KSWZ(r32, cb); kof1[d0] = KSWZ(32 + r32, cb); }
  bf16x8 vs0, vs1, ks0, ks1;
  const bf16* kpA = Kh + (size_t)sr * LDP + sc; const bf16* kpB = kpA + (size_t)32 * LDP;
  kpA = launder(kpA); kpB = launder(kpB);
#define SLOAD() do { vs0 = *(const bf16x8*)(kpA + 512); vs1 = *(const bf16x8*)(kpB + 512); ks0 = *(const bf16x8*)(kpA); ks1 = *(const bf16x8*)(kpB); \
    kpA += (size_t)64 * LDP; kpB += (size_t)64 * LDP; } while (0)
#define SWRITE(bb) do { *(bf16x8*)(V_lds + (bb) * SHM_V + vst0) = vs0; *(bf16x8*)(V_lds + (bb) * SHM_V + vst1) = vs1; const int kc = sc * 2; \
    *(bf16x8*)(K_lds + (bb) * SHM_K + KSWZ(sr, kc)) = ks0; *(bf16x8*)(K_lds + (bb) * SHM_K + KSWZ(32 + sr, kc)) = ks1; } while (0)
#define RESC(a, o) do { if (__any((a) < 1.f)) { if (hi == 0) al_l[r32] = (a); asm volatile("s_waitcnt lgkmcnt(0)" ::: "memory"); \
    _Pragma("unroll") for (int d = 0; d < 4; ++d) _Pragma("unroll") for (int r = 0; r < 16; ++r) o[d][r] *= al_l[crow(r, hi)]; } } while (0)
  constexpr int NT = SEQ / 64;
#define QKT(P0, P1, KB) do { P0 = f32x16{}; P1 = f32x16{}; \
    _Pragma("unroll") for (int d0 = 0; d0 < 4; ++d0) { \
      const bf16x8 b0 = *reinterpret_cast<const bf16x8*>((KB) + kof0[d0]); const bf16x8 b1 = *reinterpret_cast<const bf16x8*>((KB) + kof1[d0]); \
      P0 = __builtin_amdgcn_mfma_f32_32x32x16_bf16(b0, qr[d0], P0, 0, 0, 0); P1 = __builtin_amdgcn_mfma_f32_32x32x16_bf16(b1, qr[d0], P1, 0, 0, 0); } } while (0)
#define SWAIT() asm volatile("s_waitcnt vmcnt(0)" ::: "memory")
  f32x16 pA0, pA1, pB0, pB1; float mnA, mnB, alA, alB; bf16x8 pa0, pa1, pa2, pa3;
  SLOAD(); SWAIT(); SWRITE(0); __syncthreads();
  QKT(pA0, pA1, K_lds); partialSM(pA0, pA1, m1, mnA, alA);
  SLOAD(); SWAIT(); SWRITE(1); __syncthreads();
#pragma unroll 1
  for (int j = 1; j + 1 < NT; j += 2) {
    QKT(pB0, pB1, K_lds + SHM_K);
    finishSM(pA0, pA1, alA, l1, pa0, pa1, pa2, pa3);
    SLOAD();
    pv_d0(o1, vb0, pa0, pa1, pa2, pa3); partialSM(pB0, pB1, m1, mnB, alB);
    __syncthreads(); SWAIT(); SWRITE(0);
    RESC(alB, o1); __syncthreads();
    QKT(pA0, pA1, K_lds);
    finishSM(pB0, pB1, alB, l1, pa0, pa1, pa2, pa3);
    SLOAD();
    pv_d0(o1, vb0 + SHM_V, pa0, pa1, pa2, pa3); partialSM(pA0, pA1, m1, mnA, alA);
    __syncthreads(); SWAIT(); SWRITE(1);
    RESC(alA, o1); __syncthreads();
  }
  QKT(pB0, pB1, K_lds + SHM_K);
  finishSM(pA0, pA1, alA, l1, pa0, pa1, pa2, pa3);
  pv_d0(o1, vb0, pa0, pa1, pa2, pa3); partialSM(pB0, pB1, m1, mnB, alB);
  __syncthreads(); RESC(alB, o1);
  finishSM(pB0, pB1, alB, l1, pa0, pa1, pa2, pa3);
  pv_d0(o1, vb0 + SHM_V, pa0, pa1, pa2, pa3);
  __syncthreads();
#undef QKT
#undef SWAIT
#undef SLOAD
#undef SWRITE
#undef RESC
  if (hi == 0) li_l[r32] = (cmp ? lam : 1.f) / l1;
  asm volatile("s_waitcnt lgkmcnt(0)" ::: "memory");
#pragma unroll
  for (int r = 0; r < 16; ++r) { const float c1 = li_l[crow(r, hi)];
#pragma unroll
    for (int d = 0; d < 4; ++d) o1[d][r] *= c1; }
  float* X = (float*)lds + wq * 4096 + lane;
  if (cmp == 1) {
#pragma unroll
    for (int d = 0; d < 4; ++d)
#pragma unroll
      for (int r = 0; r < 16; ++r) X[(d * 16 + r) * 64] = o1[d][r];
  }
  __syncthreads();
  if (cmp == 0 && do_store) {
    float sw[4];
#pragma unroll
    for (int d = 0; d < 4; ++d) sw[d] = subw[d * 32 + r32] * one_m_li;
    bf16* Ow = PJ + (rowQ + 4 * hi) * LDP + h * 128 + r32;
#pragma unroll
    for (int r = 0; r < 16; ++r) {
      float s = 0;
#pragma unroll
      for (int d = 0; d < 4; ++d) { const float v = o1[d][r] - X[(d * 16 + r) * 64]; o1[d][r] = v; s += v * v; }
      s = red16(s); s += __shfl_xor(s, 16);
      const float rs = rsqrtf(s * (1.f / 128.f) + 1e-5f);
      bf16* orp = launder(Ow + (size_t)((r & 3) + 8 * (r >> 2)) * LDP);
#pragma unroll
      for (int d = 0; d < 4; ++d) *(unsigned short*)&orp[d * 32] = f2bf(o1[d][r] * rs * sw[d]);
    }
  }
  __syncthreads();
}

DEVI void shiftmix8(const bf16* __restrict__ PJ, size_t R, int pos, int col, const float* __restrict__ mu, float* z) {
  float zc[8], zp[8], zn[8];
  unpack8(*(const u32x4*)&PJ[R * LDP + col], zc);
  if (pos > 0) unpack8(*(const u32x4*)&PJ[(R - 1) * LDP + col], zp); else { for (int j = 0; j < 8; ++j) zp[j] = 0.f; }
  if (pos < SEQ - 1) unpack8(*(const u32x4*)&PJ[(R + 1) * LDP + col], zn); else { for (int j = 0; j < 8; ++j) zn[j] = 0.f; }
#pragma unroll
  for (int j = 0; j < 8; ++j) z[j] = zc[j] + mu[j] * (0.5f * (zp[j] + zn[j]) - zc[j]);
}
DEVI void phase_zl(const Params& p, int l) {
  const bf16* PJ = (const bf16*)(WSV(p) + OFF_U); bf16* ZL = (bf16*)(WSV(p) + OFF_ZL);
  const float* mu = p.tshift_mu + (size_t)l * 1920 + 1536;
  for (int idx = blockIdx.x * NTHR + tid_opaque(); idx < NTOK * 48; idx += gridDim.x * NTHR) {
    const int R = idx / 48, ch = idx % 48, j0 = ch * 8, pos = R & (SEQ - 1);
    float m8[8], z[8];
#pragma unroll
    for (int j = 0; j < 8; ++j) m8[j] = mu[j0 + j];
    shiftmix8(PJ, R, pos, 3072 + j0, m8, z);
    if (j0 < 128) { for (int j = 0; j < 8; ++j) z[j] = tanhf(z[j]); }
    else if (j0 >= 256) { for (int j = 0; j < 8; ++j) z[j] = sigmoidf_(z[j]); }
    *(u32x4*)&ZL[(size_t)R * 384 + j0] = pack8(z);
  }
}

DEVI void phase_mix(const Params& p, int l) {
  bf16* PJm = (bf16*)(WSV(p) + OFF_U); bf16* VV = (bf16*)(WSV(p) + OFF_ZL);
  const float* mu = p.tshift_mu + (size_t)l * 1920;
  for (int idx = blockIdx.x * NTHR + tid_opaque(); idx < NTOK * 192; idx += gridDim.x * NTHR) {
    const int R = idx / 192, col = (idx % 192) * 8, pos = R & (SEQ - 1);
    float m8[8], z[8];
#pragma unroll
    for (int j = 0; j < 8; ++j) m8[j] = mu[col + j];
    shiftmix8(PJm, R, pos, 1536 + col, m8, z);
    if (col < 1024) *(u32x4*)&PJm[(size_t)R * LDP + 512 + col] = pack8(z);
    else *(u32x4*)&VV[(size_t)R * 512 + (col - 1024)] = pack8(z);
  }
}

constexpr int SC_T = 16;
constexpr int SC_DIR = 5 * SC_T * 64 + SC_T * 8;
constexpr int SC_BUF = 2 * SC_DIR;
constexpr int SC_SY = 2 * SC_BUF;
struct ScRaw { u32x2 c0, c1, c2, au, om; };
#define SC_BAR() asm volatile("s_waitcnt lgkmcnt(0)\n\ts_barrier" ::: "memory")
template <int MODE>
DEVI void phase_scan(const Params& p, int l, char* lds) {
  const bf16* PJ = (const bf16*)(WSV(p) + OFF_U);
  const bf16* Aa = (const bf16*)(WSV(p) + OFF_A);
  const _Float16* OM = (const _Float16*)(WSV(p) + OFF_OMW);
  _Float16* YH = (_Float16*)(WSV(p) + OFF_H);
  const bf16* VV = (const bf16*)(WSV(p) + OFF_ZL);
  float* L = (float*)lds;
  const int tid = tid_opaque(), wid = tid >> 6, lane = tid & 63, l16 = lane & 15;
  const bool producer = wid >= 4;
  const int stid = tid & 255;
  const int wdir = (wid >> 1) & 1, rowl = (wid & 1) * 4 + (lane >> 4);
  const int si = stid >> 4, sn = (stid & 15) * 4;
  constexpr int NCH = SEQ / SC_T;
  for (int it = blockIdx.x; it < 256; it += gridDim.x) {
    const int q8 = (it >> 3) & 7, bh_ = (it & 7) + 8 * (it >> 6), h = bh_ & 7, b = bh_ >> 3;
    const int cbase = h * 64 + sn;
    float kk4[4], ka4[4];
#pragma unroll
    for (int j = 0; j < 4; ++j) { kk4[j] = p.k_k[l * 512 + cbase + j]; ka4[j] = p.k_a[l * 512 + cbase + j]; }
    f32x2 Sa = {0.f, 0.f}, Sb = {0.f, 0.f};
    ScRaw xa0, xb0, xa1, xb1;
#define SC_LOAD(chk_, d_, RW) do { const int s = (chk_) * SC_T + si; const int pos = (d_) ? (SEQ - 1 - s) : s; const size_t R = (size_t)b * SEQ + pos; \
      const bf16* base = PJ + R * LDP + 512 + cbase; \
      RW.c0 = *(const u32x2*)(base); RW.c1 = *(const u32x2*)(base + 512); RW.c2 = *(const u32x2*)(VV + R * 512 + cbase); \
      RW.au = *(const u32x2*)&Aa[(R * 2 + (d_)) * 512 + cbase]; RW.om = *(const u32x2*)&OM[(R * 2 + (d_)) * 512 + cbase]; } while (0)
#define SC_PROC(buf_, d_, RW) do { float* sd = L + (buf_) * SC_BUF + (d_) * SC_DIR; \
      const float rc[4] = {bflo(RW.c0[0]), bfhi(RW.c0[0]), bflo(RW.c0[1]), bfhi(RW.c0[1])}; \
      const float kc[4] = {bflo(RW.c1[0]), bfhi(RW.c1[0]), bflo(RW.c1[1]), bfhi(RW.c1[1])}; \
      const float a4[4] = {bflo(RW.au[0]), bfhi(RW.au[0]), bflo(RW.au[1]), bfhi(RW.au[1])}; \
      typedef _Float16 h4 __attribute__((ext_vector_type(4))); const h4 om = __builtin_bit_cast(h4, RW.om); \
      float kq[4], ssq = 0.f; \
      _Pragma("unroll") for (int j = 0; j < 4; ++j) { kq[j] = kc[j] * kk4[j]; ssq += kq[j] * kq[j]; } \
      ssq = red16(ssq); \
      const float inv = rsqrtf(fmaxf(ssq, 1e-24f)); \
      f32x4 w4, k4, b4, kd4, r4; \
      _Pragma("unroll") for (int j = 0; j < 4; ++j) { const float kap = kq[j] * inv; \
        w4[j] = 1.f - (float)om[j]; k4[j] = kap; b4[j] = kap * a4[j]; kd4[j] = kc[j] * (1.f + (a4[j] - 1.f) * ka4[j]); r4[j] = rc[j]; } \
      const int o = si * 64 + sn; \
      *(f32x4*)&sd[o] = w4; *(f32x4*)&sd[SC_T * 64 + o] = k4; *(f32x4*)&sd[2 * SC_T * 64 + o] = b4; \
      *(f32x4*)&sd[3 * SC_T * 64 + o] = kd4; *(f32x4*)&sd[4 * SC_T * 64 + o] = r4; \
      if ((sn >> 3) == q8) { f32x4 v4 = {bflo(RW.c2[0]), bfhi(RW.c2[0]), bflo(RW.c2[1]), bfhi(RW.c2[1])}; *(f32x4*)&sd[5 * SC_T * 64 + si * 8 + (sn & 7)] = v4; } } while (0)
#define SC_WRITEOUT2(chk_, sb_) do { const int e = stid >> 7, u = stid & 127, i = u >> 3, rl = u & 7; \
      const float* sy = L + SC_SY + (sb_) * (2 * SC_T * 128) + e * (SC_T * 128) + (i * 8 + rl) * 16; \
      const f32x4 q0 = *(const f32x4*)&sy[0], q1 = *(const f32x4*)&sy[4], q2 = *(const f32x4*)&sy[8], q3 = *(const f32x4*)&sy[12]; \
      const float tot = ((q0[0] + q0[1]) + (q0[2] + q0[3])) + ((q1[0] + q1[1]) + (q1[2] + q1[3])) + ((q2[0] + q2[1]) + (q2[2] + q2[3])) + ((q3[0] + q3[1]) + (q3[2] + q3[3])); \
      const int s = (chk_) * SC_T + i; const int pos = e ? (SEQ - 1 - s) : s; \
      YH[((size_t)e * NTOK + (size_t)b * SEQ + pos) * 512 + h * 64 + q8 * 8 + rl] = (_Float16)(tot * 0.0625f); } while (0)
#define SC_WRITEOUT(chk_) SC_WRITEOUT2(chk_, (chk_) & 1)
    if (producer) {
      SC_LOAD(0, 0, xa0); SC_LOAD(0, 1, xb0); SC_PROC(0, 0, xa0); SC_PROC(0, 1, xb0);
      SC_LOAD(1, 0, xa0); SC_LOAD(1, 1, xb0); SC_LOAD(2, 0, xa1); SC_LOAD(2, 1, xb1);
      SC_BAR();
#pragma unroll 1
      for (int chk = 0; chk < NCH; chk += 2) {
        if (MODE != 2) {
        SC_PROC(1, 0, xa0); SC_PROC(1, 1, xb0);
        { const int cw_ = chk > 0 ? chk - 1 : 0; SC_WRITEOUT2(cw_, (chk + 1) & 1); }
        { const int cl_ = chk + 3 < NCH ? chk + 3 : NCH - 1; SC_LOAD(cl_, 0, xa0); SC_LOAD(cl_, 1, xb0); }
        }
        SC_BAR();
        if (MODE != 2) {
        SC_PROC(0, 0, xa1); SC_PROC(0, 1, xb1);
        SC_WRITEOUT2(chk, 0);
        { const int cl_ = chk + 4 < NCH ? chk + 4 : NCH - 1; SC_LOAD(cl_, 0, xa1); SC_LOAD(cl_, 1, xb1); }
        }
        SC_BAR();
      }
      SC_WRITEOUT(NCH - 1);
    } else {
      SC_BAR();
      __builtin_amdgcn_s_setprio(3);
#pragma unroll 1
      for (int chk = 0; chk < NCH; ++chk) {
        const float* cw = L + (chk & 1) * SC_BUF + wdir * SC_DIR;
        float* sy = L + SC_SY + (chk & 1) * (2 * SC_T * 128) + wdir * (SC_T * 128) + rowl * 16 + l16;
        const float* cl = cw + l16 * 4; const float* cv = cw + 5 * SC_T * 64 + rowl;
        f32x4 w4 = *(const f32x4*)&cl[0], k4 = *(const f32x4*)&cl[SC_T * 64], b4 = *(const f32x4*)&cl[2 * SC_T * 64],
              kd4 = *(const f32x4*)&cl[3 * SC_T * 64], r4 = *(const f32x4*)&cl[4 * SC_T * 64];
        float vv = cv[0], ylast = 0.f;
#pragma unroll 4
        for (int i = 0; i < (MODE == 1 ? 0 : SC_T); ++i) {
          if (i > 0) sy[(i - 1) * 128] = ylast;
          f32x4 w4n = w4, k4n = k4, b4n = b4, kd4n = kd4, r4n = r4; float vvn = vv;
          if (i + 1 < SC_T) {
            const int o = (i + 1) * 64;
            w4n = *(const f32x4*)&cl[o]; k4n = *(const f32x4*)&cl[SC_T * 64 + o]; b4n = *(const f32x4*)&cl[2 * SC_T * 64 + o];
            kd4n = *(const f32x4*)&cl[3 * SC_T * 64 + o]; r4n = *(const f32x4*)&cl[4 * SC_T * 64 + o]; vvn = cv[(i + 1) * 8];
          }
          __builtin_amdgcn_sched_barrier(0);
          const f32x2 ka = {k4[0], k4[1]}, kb = {k4[2], k4[3]}, wa = {w4[0], w4[1]}, wb = {w4[2], w4[3]}, ba = {b4[0], b4[1]}, bb = {b4[2], b4[3]};
          const f32x2 kda = {kd4[0], kd4[1]}, kdb = {kd4[2], kd4[3]}, ra = {r4[0], r4[1]}, rb = {r4[2], r4[3]};
          f32x2 t = Sa * ka; t = Sb * kb + t;
          const float sa = red16(t[0] + t[1]);
          const f32x2 ua = kda * vv - ba * sa, ub = kdb * vv - bb * sa;
          Sa = Sa * wa + ua; Sb = Sb * wb + ub;
          f32x2 yy = Sa * ra; yy = Sb * rb + yy;
          ylast = yy[0] + yy[1];
          w4 = w4n; k4 = k4n; b4 = b4n; kd4 = kd4n; r4 = r4n; vv = vvn;
          __builtin_amdgcn_sched_barrier(0);
        }
        sy[(SC_T - 1) * 128] = ylast;
        SC_BAR();
      }
      __builtin_amdgcn_s_setprio(0);
    }
    __syncthreads();
#undef SC_LOAD
#undef SC_PROC
#undef SC_WRITEOUT
#undef SC_WRITEOUT2
  }
}

DEVI void phase_post(const Params& p, int l) {
  bf16* PJ = (bf16*)(WSV(p) + OFF_U);
  const bf16* Aa = (const bf16*)(WSV(p) + OFF_A);
  const bf16* G = (const bf16*)(WSV(p) + OFF_G);
  const _Float16* YH = (const _Float16*)(WSV(p) + OFF_H);
  const int tid = tid_opaque(), wid = tid >> 6, lane = tid & 63, c0 = lane * 8;
  const bf16* VV = (const bf16*)(WSV(p) + OFF_ZL);
  float ka[8], rk[8], lw[8], lb[8];
#pragma unroll
  for (int j = 0; j < 8; ++j) {
    ka[j] = p.k_a[l * 512 + c0 + j]; rk[j] = p.r_k[l * 512 + c0 + j]; lw[j] = p.lnx_w[l * 512 + c0 + j]; lb[j] = p.lnx_b[l * 512 + c0 + j];
  }
  for (int R = blockIdx.x * 8 + wid; R < NTOK; R += gridDim.x * 8) {
    const int pos = R & (SEQ - 1);
    float y[8];
    { typedef _Float16 h8 __attribute__((ext_vector_type(8)));
      const h8 yf = *(const h8*)&YH[(size_t)R * 512 + c0], yb = *(const h8*)&YH[((size_t)NTOK + R) * 512 + c0];
#pragma unroll
      for (int j = 0; j < 8; ++j) y[j] = ((float)yf[j] + (float)yb[j]) * 16.f; }
    float s1 = 0;
#pragma unroll
    for (int j = 0; j < 8; ++j) s1 += y[j];
    const float mean = red8(s1) * (1.f / 64.f);
    float s2 = 0;
#pragma unroll
    for (int j = 0; j < 8; ++j) { y[j] -= mean; s2 += y[j] * y[j]; }
    const float rstd = rsqrtf(red8(s2) * (1.f / 64.f) + 64e-5f);
    float rr[8], kk[8], vv[8], a0[8], a1[8], g8[8];
    unpack8(*(const u32x4*)&PJ[(size_t)R * LDP + 512 + c0], rr);
    unpack8(*(const u32x4*)&PJ[(size_t)R * LDP + 1024 + c0], kk);
    unpack8(*(const u32x4*)&VV[(size_t)R * 512 + c0], vv);
    unpack8(*(const u32x4*)&Aa[((size_t)R * 2 + 0) * 512 + c0], a0);
    unpack8(*(const u32x4*)&Aa[((size_t)R * 2 + 1) * 512 + c0], a1);
    unpack8(*(const u32x4*)&G[(size_t)R * 512 + c0], g8);
#ifdef NAIVE_G
    { const bf16* ZLp = (const bf16*)(WSV(p) + OFF_ZL) + (size_t)R * 384 + 256; const float* g2 = p.gate_g2 + (size_t)l * 128 * 512 + c0;
      for (int j = 0; j < 8; ++j) g8[j] = 0.f;
      for (int k = 0; k < 128; ++k) { const float sv = bf2f(*(const unsigned short*)&ZLp[k]);
        for (int j = 0; j < 8; ++j) g8[j] += sv * g2[(size_t)k * 512 + j]; } }
#endif
#ifdef NAIVE_G2T
    { const bf16* ZLp = (const bf16*)(WSV(p) + OFF_ZL) + (size_t)R * 384 + 256; const bf16* g2t = (const bf16*)(WSV(p) + OFF_G2T) + (size_t)c0 * 128;
      for (int j = 0; j < 8; ++j) g8[j] = 0.f;
      for (int k = 0; k < 128; ++k) { const float sv = bf2f(*(const unsigned short*)&ZLp[k]);
        for (int j = 0; j < 8; ++j) g8[j] += sv * bf2f(*(const unsigned short*)&g2t[(size_t)j * 128 + k]); } }
#endif
#define FIN(x) (fabsf(x) < 1e30f)
#ifdef IGN_Y
    for (int j = 0; j < 8; ++j) y[j] = 0.01f * j;
#endif
#ifdef IGN_A
    for (int j = 0; j < 8; ++j) { a0[j] = 0.5f; a1[j] = 0.5f; }
#endif
#ifdef IGN_G
    for (int j = 0; j < 8; ++j) { g8[j] = 1.f; }
#endif
#ifdef IGN_RKV
    for (int j = 0; j < 8; ++j) { rr[j] = 0.1f; kk[j] = 0.1f; vv[j] = 0.1f; }
#endif
#ifdef SAN_Y
    for (int j = 0; j < 8; ++j) if (!FIN(y[j])) y[j] = 0.f;
#endif
#ifdef SAN_A
    for (int j = 0; j < 8; ++j) { if (!FIN(a0[j])) a0[j] = 0.f; if (!FIN(a1[j])) a1[j] = 0.f; }
#endif
#ifdef SAN_G
    for (int j = 0; j < 8; ++j) if (!FIN(g8[j])) g8[j] = 0.f;
#endif
#ifdef SAN_RKV
    for (int j = 0; j < 8; ++j) { if (!FIN(rr[j])) rr[j] = 0.f; if (!FIN(kk[j])) kk[j] = 0.f; if (!FIN(vv[j])) vv[j] = 0.f; }
#endif
    float bs = 0;
#pragma unroll
    for (int j = 0; j < 8; ++j) {
      const float kds = kk[j] * ((1.f + (a0[j] - 1.f) * ka[j]) + (1.f + (a1[j] - 1.f) * ka[j]));
      bs += rr[j] * kds * rk[j];
    }
    bs = red8(bs);
    float o[8];
#pragma unroll
    for (int j = 0; j < 8; ++j) o[j] = (y[j] * rstd * lw[j] + lb[j] + bs * vv[j]) * g8[j];
    *(u32x4*)&PJ[(size_t)R * LDP + 512 + c0] = pack8(o);
  }
}

DEVI bool tile_map(int round, int bid, int nb, int nM, int nN, int SM, int SN, int& mt, int& nt) {
  if (nb == 256) {
    const int xcd = bid & 7, j = bid >> 3, nsn = nN / SN, st = round * 8 + xcd;
    if (st >= (nM / SM) * nsn) return false;
    mt = (st / nsn) * SM + j / SN; nt = (st % nsn) * SN + j % SN; return true;
  }
  const int it = round * nb + bid; if (it >= nM * nN) return false;
  mt = it / nN; nt = it % nN; return true;
}

#define WT_IN ((bf16*)(WSV(p) + OFF_WT_IN))
#define WT_OUT ((bf16*)(WSV(p) + OFF_WT_OUT))
#define WT_UP ((bf16*)(WSV(p) + OFF_WT_UP))
#define WT_DOWN ((bf16*)(WSV(p) + OFF_WT_DOWN))
#define W2T ((bf16*)(WSV(p) + OFF_W2T))
#define A2T ((bf16*)(WSV(p) + OFF_A2T))
#define G2T ((bf16*)(WSV(p) + OFF_G2T))
#define PJ ((bf16*)(WSV(p) + OFF_U))
#define U PJ
#define ZL ((bf16*)(WSV(p) + OFF_ZL))
#define H ((bf16*)(WSV(p) + OFF_H))
#define OMW ((_Float16*)(WSV(p) + OFF_OMW))
#define AA ((bf16*)(WSV(p) + OFF_A))
#define GG ((bf16*)(WSV(p) + OFF_G))
#define MODP ((const float*)(WSV(p) + OFF_MOD))
#define cosT ((const float*)(WSV(p) + OFF_COS))
#define sinT ((const float*)(WSV(p) + OFF_SIN))
__global__ void __launch_bounds__(NTHR) fwd_megakernel(Params p) {
  extern __shared__ __attribute__((aligned(16))) char lds[];
  cg::grid_group grid = cg::this_grid();
  const int nb = gridDim.x, bid = blockIdx.x;
  unsigned* gbar = (unsigned*)(p.ws + OFF_BAR); unsigned gtarget = 0;
  grid.sync();
  phase_mod(p, lds);
  phase_rope(p);
  phase_conv(p, 0, lds);
  GSYNC();

  for (int l = 0; l < 2; ++l) {
    const float* xin = (l == 0) ? p.x : p.out;
    const float* modl = launder(MODP + (size_t)l * 4 * 6144);
    if (l > 0) phase_conv(p, l, lds);
    phase_norm(xin, p.norm1 + l * DM, modl, 0, 1024, H);
#ifdef REP_EW
    phase_norm(xin, p.norm1 + l * DM, modl, 0, 1024, H);
#endif
    GSYNC();
#ifdef REP_G1
    for (int rep = 0; rep < 2; ++rep)
#endif
    for (int rnd = 0;; ++rnd) {
      int mt, nt; if (!tile_map(rnd, bid, nb, 128, 14, 16, 2, mt, nt)) break;
      gemm_tile(H, DM, WT_IN, DM, DM, mt * 256, nt * 256, lds,
        [&](EPI_ARGS) {
          if (nw >= LDP) return;
          bf16* dst = PJ + (size_t)m * LDP + nw + 4 * q;
          if (nw < 1024) {
            const int pos = m & (SEQ - 1);
            const float* ct = cosT + pos * 32 + 4 * q; const float* st = sinT + pos * 32 + 4 * q;
#define ROPE(T1, T2, IDX, OFF) do { const f32x4 cs = *(const f32x4*)(ct + (IDX)), sn = *(const f32x4*)(st + (IDX)); \
              *(u32x2*)(dst + (OFF)) = pk4(T1[0] * cs[0] - T2[0] * sn[0], T1[1] * cs[1] - T2[1] * sn[1], T1[2] * cs[2] - T2[2] * sn[2], T1[3] * cs[3] - T2[3] * sn[3]); \
              *(u32x2*)(dst + (OFF) + 32) = pk4(T1[0] * sn[0] + T2[0] * cs[0], T1[1] * sn[1] + T2[1] * cs[1], T1[2] * sn[2] + T2[2] * cs[2], T1[3] * sn[3] + T2[3] * cs[3]); } while (0)
            ROPE(c0, c2, 0, 0); ROPE(c1, c3, 16, 16); ROPE(c4, c6, 0, 64); ROPE(c5, c7, 16, 80);
#undef ROPE
          } else {
#define PLAIN(C, J) *(u32x2*)(dst + 16 * (J)) = pk4(C[0], C[1], C[2], C[3])
            EPI_TILES(PLAIN);
#undef PLAIN
          }
        });
    }
    GSYNC();
    phase_zl(p, l);
#ifdef REP_EW
    phase_zl(p, l);
#endif
    {
      float s1 = 0, s2 = 0;
      for (int i = 0; i < 64; ++i) { s1 += p.lam_q1[l * 64 + i] * p.lam_k1[l * 64 + i]; s2 += p.lam_q2[l * 64 + i] * p.lam_k2[l * 64 + i]; }
      const float lam_init = 0.8f - 0.6f * expf(-0.3f * (float)l);
      const float lam = expf(s1) - expf(s2) + lam_init;
#ifndef SKIP_ATT
#ifdef REP_ATT
      for (int rep = 0; rep < 2; ++rep) {
      const bool dst_ = rep == 1;
#else
      { const bool dst_ = true;
#endif
      if (nb == 256) {
        const int xcd = bid & 7, jj = bid >> 3;
#pragma unroll 1
        for (int i4 = 0; i4 < 4; ++i4) {
          {
            const int bh = xcd + 8 * (i4 >> 1), qb = jj + 32 * (i4 & 1);
            attn_item(PJ, bh >> 2, bh & 3, qb, lam, 1.f - lam_init, p.subln_w + l * 128, lds, dst_);
          }
        }
      } else {
#pragma unroll 1
        for (int it = bid; it < 1024; it += nb) attn_item(PJ, it >> 8, (it >> 6) & 3, it & 63, lam, 1.f - lam_init, p.subln_w + l * 128, lds, dst_);
      }
      }
#endif
    }
    GSYNC();
#ifdef REP_LORA
    for (int rep = 0; rep < 2; ++rep)
#endif
    for (int it = bid; it < 5 * 256; it += nb) {
      const int g = it / 256, t = it % 256, mt = t >> 1, nt = t & 1, d = g & 1;
      const bf16* Ap; const bf16* Bp; int ldb, KK;
      if (g < 2) { Ap = ZL + d * 64; Bp = W2T + d * 512 * 64; ldb = 64; KK = 64; }
      else if (g < 4) { Ap = ZL + 128 + d * 64; Bp = A2T + d * 512 * 64; ldb = 64; KK = 64; }
      else { Ap = ZL + 256; Bp = G2T; ldb = 128; KK = 128; }
      const float* w0 = p.decay_w0 + (size_t)(l * 2 + d) * 512; const float* a0 = p.icl_a0 + (size_t)(l * 2 + d) * 512;
      gemm_tile(Ap, 384, Bp, ldb, KK, mt * 256, nt * 256, lds,
        [&](EPI_ARGS) {
          auto tile_ = [&](const f32x4v c, const int j) {
            const int col = nw + 16 * j + 4 * q;
            float o[4];
            if (g < 2) {
              const f32x4 w0c = *(const f32x4*)&w0[col];
#pragma unroll
              for (int e = 0; e < 4; ++e) {
                const float ee = 0.60653065971263342f * __builtin_amdgcn_rcpf(1.f + __expf(-(c[e] + w0c[e])));
                o[e] = ee < 0.03125f ? ee * (1.f - ee * (0.5f - ee * (1.f / 6.f - ee * (1.f / 24.f)))) : 1.f - __expf(-ee);
              }
              typedef _Float16 h4 __attribute__((ext_vector_type(4)));
              h4 hv = {(_Float16)o[0], (_Float16)o[1], (_Float16)o[2], (_Float16)o[3]};
              *(h4*)&OMW[((size_t)m * 2 + d) * 512 + col] = hv;
            } else if (g < 4) {
              const f32x4 a0c = *(const f32x4*)&a0[col];
#pragma unroll
              for (int e = 0; e < 4; ++e) o[e] = __builtin_amdgcn_rcpf(1.f + __expf(-(c[e] + a0c[e])));
              *(u32x2*)&AA[((size_t)m * 2 + d) * 512 + col] = pk4(o[0], o[1], o[2], o[3]);
            } else {
              *(u32x2*)&GG[(size_t)m * 512 + col] = pk4(c[0], c[1], c[2], c[3]);
            }
          };
          EPI_TILES(tile_);
        });
    }
    GSYNC();
    phase_mix(p, l);
#ifdef REP_EW
    phase_mix(p, l);
#endif
    GSYNC();
#ifndef SKIP_SCAN
#ifdef REP_SCAN
    phase_scan<REP_SCAN>(p, l, lds);
#endif
    phase_scan<0>(p, l, lds);
#endif
    GSYNC();
#ifndef SKIP_POST
    phase_post(p, l);
#endif
    GSYNC();
    for (int rnd = 0;; ++rnd) {
      int mt, nt; if (!tile_map(rnd, bid, nb, 128, 4, 8, 4, mt, nt)) break;
      gemm_tile(PJ, LDP, WT_OUT, DM, DM, mt * 256, nt * 256, lds,
        [&](EPI_ARGS) {
          const int b = m >> 13; const float* gt = modl + b * 6144 + 2048 + nw + 4 * q;
          const float* xi = xin + (size_t)m * DM + nw + 4 * q; float* xo = p.out + (size_t)m * DM + nw + 4 * q;
          auto tile_ = [&](const f32x4v c, const int j) {
            const f32x4 x4 = *(const f32x4*)(xi + 16 * j), g4 = *(const f32x4*)(gt + 16 * j);
            f32x4 o = {x4[0] + g4[0] * c[0], x4[1] + g4[1] * c[1], x4[2] + g4[2] * c[2], x4[3] + g4[3] * c[3]};
            *(f32x4*)(xo + 16 * j) = o;
          };
          EPI_TILES(tile_);
        });
    }
    GSYNC();
    phase_norm(p.out, p.norm2 + l * DM, modl, 3072, 4096, H);
#ifdef REP_EW
    phase_norm(p.out, p.norm2 + l * DM, modl, 3072, 4096, H);
#endif
    GSYNC();
#ifdef REP_UP
    for (int rep = 0; rep < 2; ++rep)
#endif
    for (int rnd = 0;; ++rnd) {
      int mt, nt; if (!tile_map(rnd, bid, nb, 128, 16, 4, 8, mt, nt)) break;
      gemm_tile(H, DM, WT_UP, DM, DM, mt * 256, nt * 256, lds,
        [&](EPI_ARGS) {
          bf16* dst = U + (size_t)m * DFF + nw + 4 * q;
          auto tile_ = [&](const f32x4v c, const int j) {
            const float u0 = fmaxf(c[0], 0.f), u1 = fmaxf(c[1], 0.f), u2 = fmaxf(c[2], 0.f), u3 = fmaxf(c[3], 0.f);
            *(u32x2*)(dst + 16 * j) = pk4(u0 * u0, u1 * u1, u2 * u2, u3 * u3);
          };
          EPI_TILES(tile_);
        });
    }
    GSYNC();
    for (int rnd = 0;; ++rnd) {
      int mt, nt; if (!tile_map(rnd, bid, nb, 128, 4, 8, 4, mt, nt)) break;
      gemm_tile(U, DFF, WT_DOWN, DFF, DFF, mt * 256, nt * 256, lds,
        [&](EPI_ARGS) {
          const int b = m >> 13; const float* gt = modl + b * 6144 + 5120 + nw + 4 * q;
          float* xo = p.out + (size_t)m * DM + nw + 4 * q;
          auto tile_ = [&](const f32x4v c, const int j) {
            const f32x4 x4 = *(const f32x4*)(xo + 16 * j), g4 = *(const f32x4*)(gt + 16 * j);
            f32x4 o = {x4[0] + g4[0] * c[0], x4[1] + g4[1] * c[1], x4[2] + g4[2] * c[2], x4[3] + g4[3] * c[3]};
            *(f32x4*)(xo + 16 * j) = o;
          };
          EPI_TILES(tile_);
        });
    }
    GSYNC();
  }
#ifdef REP_BAR
  for (int i = 0; i < 20; ++i) GSYNC();
#endif
  phase_final_norm(p.out, p.norm_f);
}

extern "C" void kernel_launch(void* const* d_in, const int* in_sizes, int n_in, void* d_out, int out_size, void* d_ws, size_t ws_size,
                              hipStream_t stream) {
  static int grid_blocks = 0;
  if (n_in != 27 || ws_size < WS_NEED) { fprintf(stderr, "kernel_launch: bad n_in %d or ws_size %zu (< %zu)\n", n_in, ws_size, (size_t)WS_NEED); return; }
  if (!grid_blocks) {
    int dev = 0, cus = 0, per_cu = 0;
    hipGetDevice(&dev);
    hipDeviceGetAttribute(&cus, hipDeviceAttributeMultiprocessorCount, dev);
    hipFuncSetAttribute((const void*)fwd_megakernel, hipFuncAttributeMaxDynamicSharedMemorySize, LDS_BYTES);
    hipOccupancyMaxActiveBlocksPerMultiprocessor(&per_cu, fwd_megakernel, NTHR, LDS_BYTES);
    if (per_cu < 1) per_cu = 1;
    if (per_cu > 1) per_cu = 1;
    grid_blocks = cus * per_cu;
  }
  Params p{};
  const float** pp = (const float**)&p;
  for (int i = 0; i < 27; ++i) pp[i] = (const float*)d_in[i];
  p.out = (float*)d_out; p.ws = (char*)d_ws;
  for (int i = 0; i < 32; ++i) p.inv_freq[i] = 1.0f / powf(10000.0f, (float)(2 * i) / 64.0f);
  hipMemsetAsync((char*)d_ws + OFF_BAR, 0, 256, stream);
  void* args[] = {&p};
  hipError_t e = hipLaunchCooperativeKernel((void*)fwd_megakernel, dim3(grid_blocks), dim3(NTHR), args, LDS_BYTES, stream);
  if (e != hipSuccess) fprintf(stderr, "cooperative launch failed: %s (grid %d)\n", hipGetErrorString(e), grid_blocks);
}
```

```cpp
#include <hip/hip_runtime.h>
#include <hip/hip_bf16.h>
#include <hip/hip_cooperative_groups.h>
#include <cstdio>
#include <cmath>
namespace cg = cooperative_groups;

#define DEVI __device__ __forceinline__
using bf16 = __hip_bfloat16;
typedef short bf16x8 __attribute__((ext_vector_type(8)));
typedef short s16x4 __attribute__((ext_vector_type(4)));
typedef float f32x16 __attribute__((ext_vector_type(16)));
typedef float f32x4 __attribute__((ext_vector_type(4)));
typedef unsigned u32x4 __attribute__((ext_vector_type(4)));
typedef unsigned u32x2 __attribute__((ext_vector_type(2)));
typedef float f32x2 __attribute__((ext_vector_type(2)));

constexpr int NTOK = 32768, SEQ = 8192, DM = 1024, LDP = 3456, DFF = 4096;
constexpr int NTHR = 512;
constexpr size_t MiB = 1024 * 1024;
constexpr size_t OFF_WT_IN = 0;
constexpr size_t OFF_WT_OUT = OFF_WT_IN + (size_t)3456 * 1024 * 2;
constexpr size_t OFF_WT_UP = OFF_WT_OUT + (size_t)1024 * 1024 * 2;
constexpr size_t OFF_WT_DOWN = OFF_WT_UP + (size_t)4096 * 1024 * 2;
constexpr size_t OFF_W2T = OFF_WT_DOWN + (size_t)4096 * 1024 * 2;
constexpr size_t OFF_A2T = OFF_W2T + (size_t)2 * 512 * 64 * 2;
constexpr size_t OFF_G2T = OFF_A2T + (size_t)2 * 512 * 64 * 2;
constexpr size_t OFF_U = 26 * MiB;
constexpr size_t OFF_ZL = OFF_U + 216 * MiB;
constexpr size_t OFF_H = OFF_U + 256 * MiB;
constexpr size_t OFF_OMW = OFF_H + 64 * MiB;
constexpr size_t OFF_A = OFF_OMW + 64 * MiB;
constexpr size_t OFF_G = OFF_A + 64 * MiB;
constexpr size_t OFF_MOD = OFF_G + 32 * MiB;
constexpr size_t OFF_COS = OFF_MOD + 1 * MiB;
constexpr size_t OFF_SIN = OFF_COS + 1 * MiB;
constexpr size_t OFF_BAR = OFF_SIN + 1 * MiB;
constexpr size_t WS_NEED = OFF_BAR + 1 * MiB;
constexpr int LDS_BYTES = 131072;

struct Params {
  const float *x, *c, *w_ada, *b_ada, *norm1, *norm2, *w_in, *w_out, *lam_q1, *lam_k1, *lam_q2, *lam_k2, *subln_w, *tshift_mu,
      *decay_w0, *decay_w2, *icl_a0, *icl_a2, *gate_g2, *k_k, *k_a, *r_k, *lnx_w, *lnx_b, *w_up, *w_down, *norm_f;
  float* out;
  char* ws;
  float inv_freq[32];
};

DEVI void grid_barrier(unsigned* bar, unsigned& target) {
  asm volatile("s_waitcnt vmcnt(0) lgkmcnt(0)" ::: "memory");
  __syncthreads();
  target += gridDim.x;
  if (threadIdx.x == 0) {
    __builtin_amdgcn_fence(__ATOMIC_RELEASE, "agent");
    asm volatile("s_waitcnt vmcnt(0)" ::: "memory");
    __hip_atomic_fetch_add(bar, 1u, __ATOMIC_RELAXED, __HIP_MEMORY_SCOPE_AGENT);
    while (__hip_atomic_load(bar, __ATOMIC_RELAXED, __HIP_MEMORY_SCOPE_AGENT) < target) __builtin_amdgcn_s_sleep(2);
    __builtin_amdgcn_fence(__ATOMIC_ACQUIRE, "agent");
    asm volatile("s_waitcnt vmcnt(0)" ::: "memory");
  }
  __syncthreads();
}
#define GSYNC() grid_barrier(gbar, gtarget)
struct Params;
#define SBAR() __builtin_amdgcn_sched_barrier(0)
#define GAS __attribute__((address_space(1)))
#define LAS __attribute__((address_space(3)))
template <class T> DEVI T* launder(T* q) { unsigned long long u = (unsigned long long)q; asm volatile("" : "+v"(u)); return (T*)(GAS T*)u; }
DEVI char* ws_launder(char* w) { return launder(w); }
#define WSV(p) ws_launder((p).ws)
DEVI int tid_opaque() { int t = threadIdx.x; asm volatile("" : "+v"(t)); return t; }
DEVI int crow(int r, int hi) { return (r & 3) + 8 * (r >> 2) + 4 * hi; }
DEVI unsigned cvtpk(float lo, float hi) {
  unsigned r; asm volatile("v_cvt_pk_bf16_f32 %0, %1, %2" : "=v"(r) : "v"(lo), "v"(hi)); return r;
}
DEVI unsigned short f2bf(float x) { return (unsigned short)(cvtpk(x, 0.f) & 0xffffu); }
DEVI float bf2f(unsigned short u) { return __uint_as_float(((unsigned)u) << 16); }
DEVI float bflo(unsigned u) { return __uint_as_float(u << 16); }
DEVI float bfhi(unsigned u) { return __uint_as_float(u & 0xffff0000u); }
template <int CTRL> DEVI float dppf(float x) {
  return __builtin_bit_cast(float, __builtin_amdgcn_mov_dpp(__builtin_bit_cast(int, x), CTRL, 0xf, 0xf, true));
}
DEVI float red8(float x) { x += dppf<0xB1>(x); x += dppf<0x4E>(x); x += dppf<0x141>(x); return x; }
DEVI float red16(float x) { x = red8(x); x += dppf<0x128>(x); return x; }
DEVI float red64(float x) { x = red16(x); x += __shfl_xor(x, 16); x += __shfl_xor(x, 32); return x; }
DEVI float sigmoidf_(float x) { return __builtin_amdgcn_rcpf(1.f + __expf(-x)); }
DEVI void unpack8(u32x4 v, float* f) {
  f[0] = bflo(v[0]); f[1] = bfhi(v[0]); f[2] = bflo(v[1]); f[3] = bfhi(v[1]);
  f[4] = bflo(v[2]); f[5] = bfhi(v[2]); f[6] = bflo(v[3]); f[7] = bfhi(v[3]);
}
DEVI u32x4 pack8(const float* f) {
  u32x4 w = {cvtpk(f[0], f[1]), cvtpk(f[2], f[3]), cvtpk(f[4], f[5]), cvtpk(f[6], f[7])}; return w;
}

DEVI void phase_mod(const Params& p, char* lds) {
  float* sc = (float*)lds;
  float* red = sc + 4096;
  const int tid = tid_opaque(), w = tid >> 6, lane = tid & 63;
  for (int i = tid; i < 4096; i += NTHR) { float v = p.c[i]; sc[i] = v / (1.f + expf(-v)); }
  __syncthreads();
  float* mod = (float*)(WSV(p) + OFF_MOD);
  for (int it = blockIdx.x; it < 192; it += gridDim.x) {
    const int l = it / 96, col = (it % 96) * 64 + lane;
    const float* W = p.w_ada + (size_t)l * 1024 * 6144 + col;
    float a0 = 0, a1 = 0, a2 = 0, a3 = 0;
#pragma unroll 1
    for (int kb = w * 128; kb < w * 128 + 128; kb += 16) {
      float wv[16];
#pragma unroll
      for (int j = 0; j < 16; ++j) wv[j] = W[(size_t)(kb + j) * 6144];
#pragma unroll
      for (int j = 0; j < 16; ++j) { const int k = kb + j; a0 += sc[k] * wv[j]; a1 += sc[1024 + k] * wv[j]; a2 += sc[2048 + k] * wv[j]; a3 += sc[3072 + k] * wv[j]; }
    }
    red[(w * 4 + 0) * 64 + lane] = a0; red[(w * 4 + 1) * 64 + lane] = a1;
    red[(w * 4 + 2) * 64 + lane] = a2; red[(w * 4 + 3) * 64 + lane] = a3;
    __syncthreads();
    if (tid < 256) {
      const int bb = tid >> 6; float s = 0;
      for (int ww = 0; ww < 8; ++ww) s += red[(ww * 4 + bb) * 64 + lane];
      mod[(l * 4 + bb) * 6144 + col] = s + p.b_ada[l * 6144 + col];
    }
    __syncthreads();
  }
}

DEVI void phase_rope(const Params& p) {
  float* cosT = (float*)(WSV(p) + OFF_COS); float* sinT = (float*)(WSV(p) + OFF_SIN);
  for (int idx = blockIdx.x * NTHR + tid_opaque(); idx < SEQ * 32; idx += gridDim.x * NTHR) {
    const int pos = idx >> 5, i = idx & 31;
    const float ang = (float)pos * p.inv_freq[i];
    double q = (double)ang * 0.15915494309189533577; q -= floor(q);
    const float f = (float)q;
    cosT[idx] = __builtin_amdgcn_cosf(f); sinT[idx] = __builtin_amdgcn_sinf(f);
  }
}

struct ConvJob { const float* src; bf16* dst; int ldsrc, lddst, k0, n0; };
DEVI bool conv_job(const Params& p, int l, int it, ConvJob& j) {
  if (it >= 3216) return false;
  const float* src; bf16* dst; int K, N, t = it;
  char* wsb = launder(p.ws);
  if (t < 864) { src = p.w_in + (size_t)l * 1024 * 3456; dst = (bf16*)(wsb + OFF_WT_IN); K = 1024; N = 3456; }
  else if ((t -= 864) < 256) { src = p.w_out + (size_t)l * 1024 * 1024; dst = (bf16*)(wsb + OFF_WT_OUT); K = 1024; N = 1024; }
  else if ((t -= 256) < 1024) { src = p.w_up + (size_t)l * 1024 * 4096; dst = (bf16*)(wsb + OFF_WT_UP); K = 1024; N = 4096; }
  else if ((t -= 1024) < 1024) { src = p.w_down + (size_t)l * 4096 * 1024; dst = (bf16*)(wsb + OFF_WT_DOWN); K = 4096; N = 1024; }
  else if ((t -= 1024) < 16) { const int d = t >> 3; t &= 7; src = p.decay_w2 + (size_t)(l * 2 + d) * 64 * 512; dst = (bf16*)(wsb + OFF_W2T) + d * 512 * 64; K = 64; N = 512; }
  else if ((t -= 16) < 16) { const int d = t >> 3; t &= 7; src = p.icl_a2 + (size_t)(l * 2 + d) * 64 * 512; dst = (bf16*)(wsb + OFF_A2T) + d * 512 * 64; K = 64; N = 512; }
  else { t -= 16; src = p.gate_g2 + (size_t)l * 128 * 512; dst = (bf16*)(wsb + OFF_G2T); K = 128; N = 512; }
  const int nt = N / 64;
  j.src = src; j.dst = dst; j.ldsrc = N; j.lddst = K; j.k0 = (t / nt) * 64; j.n0 = (t % nt) * 64;
  return true;
}
DEVI void phase_conv(const Params& p, int l, char* lds) {
  float* tile = (float*)lds;
  const int tid = tid_opaque();
  const int lk = tid >> 4, ln = (tid & 15) * 4;
  ConvJob cur, nxt; f32x4 v0, v1, w0 = {0.f, 0.f, 0.f, 0.f}, w1 = {0.f, 0.f, 0.f, 0.f};
  int it = blockIdx.x;
  bool have = conv_job(p, l, it, cur);
  if (have) { v0 = *(const f32x4*)&cur.src[(size_t)(cur.k0 + lk) * cur.ldsrc + cur.n0 + ln]; v1 = *(const f32x4*)&cur.src[(size_t)(cur.k0 + 32 + lk) * cur.ldsrc + cur.n0 + ln]; }
  while (have) {
    const bool hn = conv_job(p, l, it + gridDim.x, nxt);
    if (hn) { w0 = *(const f32x4*)&nxt.src[(size_t)(nxt.k0 + lk) * nxt.ldsrc + nxt.n0 + ln]; w1 = *(const f32x4*)&nxt.src[(size_t)(nxt.k0 + 32 + lk) * nxt.ldsrc + nxt.n0 + ln]; }
    tile[lk * 65 + ln + 0] = v0[0]; tile[lk * 65 + ln + 1] = v0[1]; tile[lk * 65 + ln + 2] = v0[2]; tile[lk * 65 + ln + 3] = v0[3];
    tile[(32 + lk) * 65 + ln + 0] = v1[0]; tile[(32 + lk) * 65 + ln + 1] = v1[1]; tile[(32 + lk) * 65 + ln + 2] = v1[2]; tile[(32 + lk) * 65 + ln + 3] = v1[3];
    __syncthreads();
    {
      const int n = tid >> 3, kc = (tid & 7) * 8; float f[8];
#pragma unroll
      for (int j = 0; j < 8; ++j) f[j] = tile[(kc + j) * 65 + n];
      *(u32x4*)&cur.dst[(size_t)(cur.n0 + n) * cur.lddst + cur.k0 + kc] = pack8(f);
    }
    __syncthreads();
    cur = nxt; v0 = w0; v1 = w1; have = hn; it += gridDim.x;
  }
}

DEVI void phase_norm(const float* __restrict__ xin, const float* __restrict__ g, const float* __restrict__ modl, int shoff, int scoff,
                     bf16* __restrict__ H) {
  const int tid = tid_opaque(), w = tid >> 6, lane = tid & 63;
  for (int row = blockIdx.x * 8 + w; row < NTOK; row += gridDim.x * 8) {
    const int b = row >> 13; f32x4 v[4]; float ss = 0;
#pragma unroll
    for (int j = 0; j < 4; ++j) { v[j] = *(const f32x4*)&xin[(size_t)row * DM + j * 256 + lane * 4]; ss += v[j][0] * v[j][0] + v[j][1] * v[j][1] + v[j][2] * v[j][2] + v[j][3] * v[j][3]; }
    ss = red64(ss);
    const float rstd = rsqrtf(ss * (1.f / 1024.f) + 1e-6f);
#pragma unroll
    for (int j = 0; j < 4; ++j) {
      const int col = j * 256 + lane * 4;
      const f32x4 g4 = *(const f32x4*)&g[col];
      const f32x4 sc4 = *(const f32x4*)&modl[b * 6144 + scoff + col];
      const f32x4 sh4 = *(const f32x4*)&modl[b * 6144 + shoff + col];
      float o[4];
#pragma unroll
      for (int e = 0; e < 4; ++e) o[e] = v[j][e] * rstd * g4[e] * (1.f + sc4[e]) + sh4[e];
      u32x2 pk = {cvtpk(o[0], o[1]), cvtpk(o[2], o[3])};
      *(u32x2*)&H[(size_t)row * DM + col] = pk;
    }
  }
}
DEVI void phase_final_norm(float* __restrict__ x, const float* __restrict__ g) {
  const int tid = tid_opaque(), w = tid >> 6, lane = tid & 63;
  for (int row = blockIdx.x * 8 + w; row < NTOK; row += gridDim.x * 8) {
    f32x4 v[4]; float ss = 0;
#pragma unroll
    for (int j = 0; j < 4; ++j) { v[j] = *(const f32x4*)&x[(size_t)row * DM + j * 256 + lane * 4]; ss += v[j][0] * v[j][0] + v[j][1] * v[j][1] + v[j][2] * v[j][2] + v[j][3] * v[j][3]; }
    ss = red64(ss);
    const float rstd = rsqrtf(ss * (1.f / 1024.f) + 1e-6f);
#pragma unroll
    for (int j = 0; j < 4; ++j) {
      const int col = j * 256 + lane * 4;
      const f32x4 g4 = *(const f32x4*)&g[col];
      f32x4 o = {v[j][0] * rstd * g4[0], v[j][1] * rstd * g4[1], v[j][2] * rstd * g4[2], v[j][3] * rstd * g4[3]};
#ifdef SANITIZE
      for (int e = 0; e < 4; ++e) if (!(fabsf(o[e]) < 1e30f)) o[e] = 0.f;
#endif
      *(f32x4*)&x[(size_t)row * DM + col] = o;
    }
  }
}

typedef float f32x4v __attribute__((ext_vector_type(4)));
template <class Epi>
DEVI void gemm_tile(const bf16* __restrict__ A, int lda, const bf16* __restrict__ Bt, int ldb, int K, int m0, int n0, char* lds, Epi&& epi) {
  const int tid = tid_opaque(), wid = tid >> 6, lane = tid & 63, l15 = lane & 15, q = lane >> 4;
  const int wm = wid >> 1, wn = wid & 1;
  char* As = lds; char* Bs = lds + 65536;
  f32x4v acc[4][8];
#pragma unroll
  for (int i = 0; i < 4; ++i)
#pragma unroll
    for (int j = 0; j < 8; ++j) acc[i][j] = f32x4v{0.f, 0.f, 0.f, 0.f};
  const int lrow = tid >> 3, lch = tid & 7, gch = lch ^ ((lrow >> 1) & 7);
  const bf16* Ag = launder(A) + (size_t)(m0 + lrow) * lda + gch * 8;
  const bf16* Bg = launder(Bt) + (size_t)(n0 + lrow) * ldb + gch * 8;
#define GLDS(buf, k0) do { char* a_ = As + (buf) * 32768 + wid * 1024; char* b_ = Bs + (buf) * 32768 + wid * 1024; \
    _Pragma("unroll") for (int i_ = 0; i_ < 4; ++i_) { \
      __builtin_amdgcn_global_load_lds((const GAS unsigned*)(Ag + (size_t)(64 * i_) * lda + (k0)), (LAS unsigned*)(a_ + i_ * 8192), 16, 0, 0); \
      __builtin_amdgcn_global_load_lds((const GAS unsigned*)(Bg + (size_t)(64 * i_) * ldb + (k0)), (LAS unsigned*)(b_ + i_ * 8192), 16, 0, 0); } } while (0)
  const int KT = K >> 6;
  const int sw = (l15 >> 1) & 7;
  const int aoff = (wm * 64 + l15) * 128, boff = (wn * 128 + l15) * 128;
  GLDS(0, 0); asm volatile("s_waitcnt vmcnt(0)" ::: "memory"); __syncthreads();
#pragma unroll 2
  for (int kt = 0; kt < KT; ++kt) {
    if (kt + 1 < KT) GLDS((kt + 1) & 1, (kt + 1) * 64);
    const char* Ab = As + (kt & 1) * 32768 + aoff; const char* Bb = Bs + (kt & 1) * 32768 + boff;
#pragma unroll
    for (int s2 = 0; s2 < 2; ++s2) {
      const int ch = ((4 * s2 + q) ^ sw) * 16;
      bf16x8 af[4];
#pragma unroll
      for (int i = 0; i < 4; ++i) af[i] = *(const bf16x8*)(Ab + i * 2048 + ch);
#pragma unroll
      for (int jh = 0; jh < 2; ++jh) {
        bf16x8 bfr[4];
#pragma unroll
        for (int j = 0; j < 4; ++j) bfr[j] = *(const bf16x8*)(Bb + (jh * 4 + j) * 2048 + ch);
#pragma unroll
        for (int i = 0; i < 4; ++i)
#pragma unroll
          for (int j = 0; j < 4; ++j) acc[i][jh * 4 + j] = __builtin_amdgcn_mfma_f32_16x16x32_bf16(bfr[j], af[i], acc[i][jh * 4 + j], 0, 0, 0);
        SBAR();
      }
    }
    asm volatile("s_waitcnt vmcnt(0)" ::: "memory");
    __syncthreads();
  }
#undef GLDS
  const int mw = m0 + wm * 64 + l15, nw = n0 + wn * 128;
#pragma unroll
  for (int i = 0; i < 4; ++i) epi(acc[i][0], acc[i][1], acc[i][2], acc[i][3], acc[i][4], acc[i][5], acc[i][6], acc[i][7], mw + 16 * i, nw, q);
}
#define EPI_ARGS f32x4v c0, f32x4v c1, f32x4v c2, f32x4v c3, f32x4v c4, f32x4v c5, f32x4v c6, f32x4v c7, int m, int nw, int q
#define EPI_TILES(F) do { F(c0, 0); F(c1, 1); F(c2, 2); F(c3, 3); F(c4, 4); F(c5, 5); F(c6, 6); F(c7, 7); } while (0)
DEVI u32x2 pk4(float a, float b, float c, float d) { u32x2 r = {cvtpk(a, b), cvtpk(c, d)}; return r; }

constexpr float ATT_SCALE = 0.125f;
constexpr float ATT_THR = 8.f;
constexpr int SHM_V = 64 * 128 * 2, SHM_K = 64 * 128 * 2;
#define KSWZ(row, colB) ((row) * 256 + ((colB) ^ (((row) & 7) << 4)))
DEVI void partialSM(f32x16& p0, f32x16& p1, float& m_reg, float& mn, float& alpha) {
  constexpr float C = ATT_SCALE * 1.4426950408889634f;
  float pmax = p0[0];
#pragma unroll
  for (int r = 1; r < 16; ++r) pmax = fmaxf(pmax, p0[r]);
#pragma unroll
  for (int r = 0; r < 16; ++r) pmax = fmaxf(pmax, p1[r]);
  { auto rr = __builtin_amdgcn_permlane32_swap(__float_as_uint(pmax), __float_as_uint(pmax), false, false);
    pmax = fmaxf(__uint_as_float(rr[0]), __uint_as_float(rr[1])); }
  if (__builtin_expect(__all(pmax - m_reg <= ATT_THR / ATT_SCALE), 1)) { mn = m_reg; alpha = 1.f; }
  else { mn = fmaxf(m_reg, pmax); alpha = __builtin_amdgcn_exp2f((m_reg - mn) * C); m_reg = mn; }
  const float mnC = -mn * C;
#pragma unroll
  for (int r = 0; r < 16; ++r) p0[r] = __builtin_amdgcn_exp2f(fmaf(p0[r], C, mnC));
#pragma unroll
  for (int r = 0; r < 16; ++r) p1[r] = __builtin_amdgcn_exp2f(fmaf(p1[r], C, mnC));
}
DEVI void finishSM(f32x16& p0, f32x16& p1, float alpha, float& l_reg, bf16x8& pa0, bf16x8& pa1, bf16x8& pa2, bf16x8& pa3) {
  float ps = 0;
#pragma unroll
  for (int r = 0; r < 16; ++r) ps += p0[r];
#pragma unroll
  for (int r = 0; r < 16; ++r) ps += p1[r];
  { auto rr = __builtin_amdgcn_permlane32_swap(__float_as_uint(ps), __float_as_uint(ps), false, false);
    ps = __uint_as_float(rr[0]) + __uint_as_float(rr[1]); }
  l_reg = l_reg * alpha + ps;
#define PK4(P, BASE, OUT) do { unsigned a0 = cvtpk(P[BASE + 0], P[BASE + 1]), a1 = cvtpk(P[BASE + 2], P[BASE + 3]);   \
    unsigned b0 = cvtpk(P[BASE + 4], P[BASE + 5]), b1 = cvtpk(P[BASE + 6], P[BASE + 7]);                              \
    auto r0 = __builtin_amdgcn_permlane32_swap(a0, b0, false, false); auto r1 = __builtin_amdgcn_permlane32_swap(a1, b1, false, false); \
    u32x4 w = {r0[0], r1[0], r0[1], r1[1]}; OUT = *reinterpret_cast<bf16x8*>(&w); } while (0)
  PK4(p0, 0, pa0); PK4(p0, 8, pa1); PK4(p1, 0, pa2); PK4(p1, 8, pa3);
#undef PK4
}
DEVI int v_st(int k, int c) { const int kk = (k & ~0xC) | ((k & 4) << 1) | ((k & 8) >> 1); return ((kk >> 3) * 4 + (c >> 5)) * 512 + ((kk & 7) * 32 + (c & 31)) * 2; }
DEVI int v_rd_base(int lane) { return ((lane & 3) << 3) | (((lane >> 2) & 3) << 6) | (((lane >> 4) & 1) << 5) | (((lane >> 5) & 1) << 8); }
constexpr int v_rd_off(int d0, int ks, int half) { return d0 * 512 + ks * 4096 + half * 2048; }
template <int OFF> DEVI s16x4 tr_read(int vb) {
  s16x4 r; asm volatile("ds_read_b64_tr_b16 %0, %1 offset:%2" : "=&v"(r) : "v"(vb), "i"(OFF) : "memory"); return r;
}
template <int D0> DEVI void pv_one(f32x16& od, int vb, bf16x8 pa0, bf16x8 pa1, bf16x8 pa2, bf16x8 pa3) {
  const s16x4 l0 = tr_read<v_rd_off(D0, 0, 0)>(vb), h0 = tr_read<v_rd_off(D0, 0, 1)>(vb), l1 = tr_read<v_rd_off(D0, 1, 0)>(vb), h1 = tr_read<v_rd_off(D0, 1, 1)>(vb);
  const s16x4 l2 = tr_read<v_rd_off(D0, 2, 0)>(vb), h2 = tr_read<v_rd_off(D0, 2, 1)>(vb), l3 = tr_read<v_rd_off(D0, 3, 0)>(vb), h3 = tr_read<v_rd_off(D0, 3, 1)>(vb);
  asm volatile("s_waitcnt lgkmcnt(0)" ::: "memory"); SBAR();
#define PK(L, H) (bf16x8){L[0], L[1], L[2], L[3], H[0], H[1], H[2], H[3]}
  od = __builtin_amdgcn_mfma_f32_32x32x16_bf16(pa0, PK(l0, h0), od, 0, 0, 0);
  od = __builtin_amdgcn_mfma_f32_32x32x16_bf16(pa1, PK(l1, h1), od, 0, 0, 0);
  od = __builtin_amdgcn_mfma_f32_32x32x16_bf16(pa2, PK(l2, h2), od, 0, 0, 0);
  od = __builtin_amdgcn_mfma_f32_32x32x16_bf16(pa3, PK(l3, h3), od, 0, 0, 0);
#undef PK
}
DEVI void pv_d0(f32x16* o, int vb, bf16x8 pa0, bf16x8 pa1, bf16x8 pa2, bf16x8 pa3) {
  pv_one<0>(o[0], vb, pa0, pa1, pa2, pa3); pv_one<1>(o[1], vb, pa0, pa1, pa2, pa3); pv_one<2>(o[2], vb, pa0, pa1, pa2, pa3); pv_one<3>(o[3], vb, pa0, pa1, pa2, pa3);
}

DEVI void attn_item(bf16* __restrict__ PJ, int b, int h, int qb, float lam, float one_m_li, const float* __restrict__ subw, char* lds, bool do_store = true) {
  const int tid = tid_opaque(), wid = tid >> 6, lane = tid & 63, r32 = lane & 31, hi = lane >> 5;
  const int cmp = wid & 1, wq = wid >> 1;
  char* V_lds = lds; char* K_lds = lds + 2 * SHM_V;
  float* wsl = (float*)(lds + 2 * SHM_V + 2 * SHM_K) + wid * 64; float* li_l = wsl; float* al_l = wsl + 32;
  const size_t rowQ = (size_t)b * SEQ + (size_t)qb * 128 + wq * 32;
  const bf16* Kh = PJ + (size_t)b * SEQ * LDP + 512 + h * 128;
  float m1 = -1e30f, l1 = 0; f32x16 o1[4] = {}; bf16x8 qr[4];
  { const bf16* Qw = PJ + (rowQ + r32) * LDP + h * 128 + cmp * 64 + hi * 8;
#pragma unroll
    for (int d0 = 0; d0 < 4; ++d0) qr[d0] = *(const bf16x8*)(Qw + d0 * 16); }
  const int sr = tid >> 4, sc = (tid & 15) * 8, vst0 = v_st(sr, sc), vst1 = v_st(32 + sr, sc);
  const int vb0 = (int)(uintptr_t)V_lds + v_rd_base(lane);
  int kof0[4], kof1[4];
#pragma unroll
  for (int d0 = 0; d0 < 4; ++d0) { const int cb = ((cmp * 4 + d0) * 16 + hi * 8) * 2; kof0[d0] = KSWZ(r32, cb); kof1[d0] = KSWZ(32 + r32, cb); }
  bf16x8 vs0, vs1, ks0, ks1;
  const bf16* kpA = Kh + (size_t)sr * LDP + sc; const bf16* kpB = kpA + (size_t)32 * LDP;
  kpA = launder(kpA); kpB = launder(kpB);
#define SLOAD() do { vs0 = *(const bf16x8*)(kpA + 512); vs1 = *(const bf16x8*)(kpB + 512); ks0 = *(const bf16x8*)(kpA); ks1 = *(const bf16x8*)(kpB); \
    kpA += (size_t)64 * LDP; kpB += (size_t)64 * LDP; } while (0)
#define SWRITE(bb) do { *(bf16x8*)(V_lds + (bb) * SHM_V + vst0) = vs0; *(bf16x8*)(V_lds + (bb) * SHM_V + vst1) = vs1; const int kc = sc * 2; \
    *(bf16x8*)(K_lds + (bb) * SHM_K + KSWZ(sr, kc)) = ks0; *(bf16x8*)(K_lds + (bb) * SHM_K + KSWZ(32 + sr, kc)) = ks1; } while (0)
#define RESC(a, o) do { if (__any((a) < 1.f)) { if (hi == 0) al_l[r32] = (a); asm volatile("s_waitcnt lgkmcnt(0)" ::: "memory"); \
    _Pragma("unroll") for (int d = 0; d < 4; ++d) _Pragma("unroll") for (int r = 0; r < 16; ++r) o[d][r] *= al_l[crow(r, hi)]; } } while (0)
  constexpr int NT = SEQ / 64;
#define QKT(P0, P1, KB) do { P0 = f32x16{}; P1 = f32x16{}; \
    _Pragma("unroll") for (int d0 = 0; d0 < 4; ++d0) { \
      const bf16x8 b0 = *reinterpret_cast<const bf16x8*>((KB) + kof0[d0]); const bf16x8 b1 = *reinterpret_cast<const bf16x8*>((KB) + kof1[d0]); \
      P0 = __builtin_amdgcn_mfma_f32_32x32x16_bf16(b0, qr[d0], P0, 0, 0, 0); P1 = __builtin_amdgcn_mfma_f32_32x32x16_bf16(b1, qr[d0], P1, 0, 0, 0); } } while (0)
#define SWAIT() asm volatile("s_waitcnt vmcnt(0)" ::: "memory")
  f32x16 pA0, pA1, pB0, pB1; float mnA, mnB, alA, alB; bf16x8 pa0, pa1, pa2, pa3;
  SLOAD(); SWAIT(); SWRITE(0); __syncthreads();
  QKT(pA0, pA1, K_lds); partialSM(pA0, pA1, m1, mnA, alA);
  SLOAD(); SWAIT(); SWRITE(1); __syncthreads();
#pragma unroll 1
  for (int j = 1; j + 1 < NT; j += 2) {
    SBAR(); QKT(pB0, pB1, K_lds + SHM_K);
    finishSM(pA0, pA1, alA, l1, pa0, pa1, pa2, pa3); SBAR();
    SLOAD(); SBAR();
    pv_d0(o1, vb0, pa0, pa1, pa2, pa3); partialSM(pB0, pB1, m1, mnB, alB);
    __syncthreads(); SWAIT(); SWRITE(0);
    RESC(alB, o1); __syncthreads();
    SBAR(); QKT(pA0, pA1, K_lds);
    finishSM(pB0, pB1, alB, l1, pa0, pa1, pa2, pa3); SBAR();
    SLOAD(); SBAR();
    pv_d0(o1, vb0 + SHM_V, pa0, pa1, pa2, pa3); partialSM(pA0, pA1, m1, mnA, alA);
    __syncthreads(); SWAIT(); SWRITE(1);
    RESC(alA, o1); __syncthreads();
  }
  SBAR(); QKT(pB0, pB1, K_lds + SHM_K);
  finishSM(pA0, pA1, alA, l1, pa0, pa1, pa2, pa3); SBAR();
  pv_d0(o1, vb0, pa0, pa1, pa2, pa3); partialSM(pB0, pB1, m1, mnB, alB);
  __syncthreads(); RESC(alB, o1);
  finishSM(pB0, pB1, alB, l1, pa0, pa1, pa2, pa3); SBAR();
  pv_d0(o1, vb0 + SHM_V, pa0, pa1, pa2, pa3);
  __syncthreads();
#undef QKT
#undef SWAIT
#undef SLOAD
#undef SWRITE
#undef RESC
  if (hi == 0) li_l[r32] = (cmp ? lam : 1.f) / l1;
  asm volatile("s_waitcnt lgkmcnt(0)" ::: "memory");
#pragma unroll
  for (int r = 0; r < 16; ++r) { const float c1 = li_l[crow(r, hi)];
#pragma unroll
    for (int d = 0; d < 4; ++d) o1[d][r] *= c1; }
  float* X = (float*)lds + wq * 4096 + lane;
  if (cmp == 1) {
#pragma unroll
    for (int d = 0; d < 4; ++d)
#pragma unroll
      for (int r = 0; r < 16; ++r) X[(d * 16 + r) * 64] = o1[d][r];
  }
  __syncthreads();
  if (cmp == 0 && do_store) {
    float sw[4];
#pragma unroll
    for (int d = 0; d < 4; ++d) sw[d] = subw[d * 32 + r32] * one_m_li;
    bf16* Ow = PJ + (rowQ + 4 * hi) * LDP + h * 128 + r32;
#pragma unroll
    for (int r = 0; r < 16; ++r) {
      float s = 0;
#pragma unroll
      for (int d = 0; d < 4; ++d) { const float v = o1[d][r] - X[(d * 16 + r) * 64]; o1[d][r] = v; s += v * v; }
      s = red16(s); s += __shfl_xor(s, 16);
      const float rs = rsqrtf(s * (1.f / 128.f) + 1e-5f);
      bf16* orp = launder(Ow + (size_t)((r & 3) + 8 * (r >> 2)) * LDP);
#pragma unroll
      for (int d = 0; d < 4; ++d) *(unsigned short*)&orp[d * 32] = f2bf(o1[d][r] * rs * sw[d]);
    }
  }
  __syncthreads();
}

DEVI void shiftmix8(const bf16* __restrict__ PJ, size_t R, int pos, int col, const float* __restrict__ mu, float* z) {
  float zc[8], zp[8], zn[8];
  unpack8(*(const u32x4*)&PJ[R * LDP + col], zc);
  if (pos > 0) unpack8(*(const u32x4*)&PJ[(R - 1) * LDP + col], zp); else { for (int j = 0; j < 8; ++j) zp[j] = 0.f; }
  if (pos < SEQ - 1) unpack8(*(const u32x4*)&PJ[(R + 1) * LDP + col], zn); else { for (int j = 0; j < 8; ++j) zn[j] = 0.f; }
#pragma unroll
  for (int j = 0; j < 8; ++j) z[j] = zc[j] + mu[j] * (0.5f * (zp[j] + zn[j]) - zc[j]);
}
DEVI void phase_zl(const Params& p, int l) {
  const bf16* PJ = (const bf16*)(WSV(p) + OFF_U); bf16* ZL = (bf16*)(WSV(p) + OFF_ZL);
  const float* mu = p.tshift_mu + (size_t)l * 1920 + 1536;
  for (int idx = blockIdx.x * NTHR + tid_opaque(); idx < NTOK * 48; idx += gridDim.x * NTHR) {
    const int R = idx / 48, ch = idx % 48, j0 = ch * 8, pos = R & (SEQ - 1);
    float m8[8], z[8];
#pragma unroll
    for (int j = 0; j < 8; ++j) m8[j] = mu[j0 + j];
    shiftmix8(PJ, R, pos, 3072 + j0, m8, z);
    if (j0 < 128) { for (int j = 0; j < 8; ++j) z[j] = tanhf(z[j]); }
    else if (j0 >= 256) { for (int j = 0; j < 8; ++j) z[j] = sigmoidf_(z[j]); }
    *(u32x4*)&ZL[(size_t)R * 384 + j0] = pack8(z);
  }
}

DEVI void phase_mix(const Params& p, int l) {
  bf16* PJm = (bf16*)(WSV(p) + OFF_U); bf16* VV = (bf16*)(WSV(p) + OFF_ZL);
  const float* mu = p.tshift_mu + (size_t)l * 1920;
  for (int idx = blockIdx.x * NTHR + tid_opaque(); idx < NTOK * 192; idx += gridDim.x * NTHR) {
    const int R = idx / 192, col = (idx % 192) * 8, pos = R & (SEQ - 1);
    float m8[8], z[8];
#pragma unroll
    for (int j = 0; j < 8; ++j) m8[j] = mu[col + j];
    shiftmix8(PJm, R, pos, 1536 + col, m8, z);
    if (col < 1024) *(u32x4*)&PJm[(size_t)R * LDP + 512 + col] = pack8(z);
    else *(u32x4*)&VV[(size_t)R * 512 + (col - 1024)] = pack8(z);
  }
}

constexpr int SC_T = 16;
constexpr int SC_DIR = 5 * SC_T * 64 + SC_T * 8;
constexpr int SC_BUF = 2 * SC_DIR;
constexpr int SC_SY = 2 * SC_BUF;
struct ScRaw { u32x2 c0, c1, c2, au, om; };
#define SC_BAR() asm volatile("s_waitcnt lgkmcnt(0)\n\ts_barrier" ::: "memory")
template <int MODE>
DEVI void phase_scan(const Params& p, int l, char* lds) {
  const bf16* PJ = (const bf16*)(WSV(p) + OFF_U);
  const bf16* Aa = (const bf16*)(WSV(p) + OFF_A);
  const _Float16* OM = (const _Float16*)(WSV(p) + OFF_OMW);
  _Float16* YH = (_Float16*)(WSV(p) + OFF_H);
  const bf16* VV = (const bf16*)(WSV(p) + OFF_ZL);
  float* L = (float*)lds;
  const int tid = tid_opaque(), wid = tid >> 6, lane = tid & 63, l16 = lane & 15;
  const bool producer = wid >= 4;
  const int stid = tid & 255;
  const int wdir = (wid >> 1) & 1, rowl = (wid & 1) * 4 + (lane >> 4);
  const int si = stid >> 4, sn = (stid & 15) * 4;
  constexpr int NCH = SEQ / SC_T;
  for (int it = blockIdx.x; it < 256; it += gridDim.x) {
    const int q8 = (it >> 3) & 7, bh_ = (it & 7) + 8 * (it >> 6), h = bh_ & 7, b = bh_ >> 3;
    const int cbase = h * 64 + sn;
    float kk4[4], ka4[4];
#pragma unroll
    for (int j = 0; j < 4; ++j) { kk4[j] = p.k_k[l * 512 + cbase + j]; ka4[j] = p.k_a[l * 512 + cbase + j]; }
    f32x2 Sa = {0.f, 0.f}, Sb = {0.f, 0.f};
    ScRaw xa0, xb0, xa1, xb1;
#define SC_LOAD(chk_, d_, RW) do { const int s = (chk_) * SC_T + si; const int pos = (d_) ? (SEQ - 1 - s) : s; const size_t R = (size_t)b * SEQ + pos; \
      const bf16* base = PJ + R * LDP + 512 + cbase; \
      RW.c0 = *(const u32x2*)(base); RW.c1 = *(const u32x2*)(base + 512); RW.c2 = *(const u32x2*)(VV + R * 512 + cbase); \
      RW.au = *(const u32x2*)&Aa[(R * 2 + (d_)) * 512 + cbase]; RW.om = *(const u32x2*)&OM[(R * 2 + (d_)) * 512 + cbase]; } while (0)
#define SC_PROC(buf_, d_, RW) do { float* sd = L + (buf_) * SC_BUF + (d_) * SC_DIR; \
      const float rc[4] = {bflo(RW.c0[0]), bfhi(RW.c0[0]), bflo(RW.c0[1]), bfhi(RW.c0[1])}; \
      const float kc[4] = {bflo(RW.c1[0]), bfhi(RW.c1[0]), bflo(RW.c1[1]), bfhi(RW.c1[1])}; \
      const float a4[4] = {bflo(RW.au[0]), bfhi(RW.au[0]), bflo(RW.au[1]), bfhi(RW.au[1])}; \
      typedef _Float16 h4 __attribute__((ext_vector_type(4))); const h4 om = __builtin_bit_cast(h4, RW.om); \
      float kq[4], ssq = 0.f; \
      _Pragma("unroll") for (int j = 0; j < 4; ++j) { kq[j] = kc[j] * kk4[j]; ssq += kq[j] * kq[j]; } \
      ssq = red16(ssq); \
      const float inv = rsqrtf(fmaxf(ssq, 1e-24f)); \
      f32x4 w4, k4, b4, kd4, r4; \
      _Pragma("unroll") for (int j = 0; j < 4; ++j) { const float kap = kq[j] * inv; \
        w4[j] = 1.f - (float)om[j]; k4[j] = kap; b4[j] = kap * a4[j]; kd4[j] = kc[j] * (1.f + (a4[j] - 1.f) * ka4[j]); r4[j] = rc[j]; } \
      const int o = si * 64 + sn; \
      *(f32x4*)&sd[o] = w4; *(f32x4*)&sd[SC_T * 64 + o] = k4; *(f32x4*)&sd[2 * SC_T * 64 + o] = b4; \
      *(f32x4*)&sd[3 * SC_T * 64 + o] = kd4; *(f32x4*)&sd[4 * SC_T * 64 + o] = r4; \
      if ((sn >> 3) == q8) { f32x4 v4 = {bflo(RW.c2[0]), bfhi(RW.c2[0]), bflo(RW.c2[1]), bfhi(RW.c2[1])}; *(f32x4*)&sd[5 * SC_T * 64 + si * 8 + (sn & 7)] = v4; } } while (0)
#define SC_WRITEOUT2(chk_, sb_) do { const int e = stid >> 7, u = stid & 127, i = u >> 3, rl = u & 7; \
      const float* sy = L + SC_SY + (sb_) * (2 * SC_T * 128) + e * (SC_T * 128) + (i * 8 + rl) * 16; \
      const f32x4 q0 = *(const f32x4*)&sy[0], q1 = *(const f32x4*)&sy[4], q2 = *(const f32x4*)&sy[8], q3 = *(const f32x4*)&sy[12]; \
      const float tot = ((q0[0] + q0[1]) + (q0[2] + q0[3])) + ((q1[0] + q1[1]) + (q1[2] + q1[3])) + ((q2[0] + q2[1]) + (q2[2] + q2[3])) + ((q3[0] + q3[1]) + (q3[2] + q3[3])); \
      const int s = (chk_) * SC_T + i; const int pos = e ? (SEQ - 1 - s) : s; \
      YH[((size_t)e * NTOK + (size_t)b * SEQ + pos) * 512 + h * 64 + q8 * 8 + rl] = (_Float16)(tot * 0.0625f); } while (0)
#define SC_WRITEOUT(chk_) SC_WRITEOUT2(chk_, (chk_) & 1)
    if (producer) {
      SC_LOAD(0, 0, xa0); SC_LOAD(0, 1, xb0); SC_PROC(0, 0, xa0); SC_PROC(0, 1, xb0);
      SC_LOAD(1, 0, xa0); SC_LOAD(1, 1, xb0); SC_LOAD(2, 0, xa1); SC_LOAD(2, 1, xb1);
      SC_BAR();
#pragma unroll 1
      for (int chk = 0; chk < NCH; chk += 2) {
        if (MODE != 2) {
        SC_PROC(1, 0, xa0); SC_PROC(1, 1, xb0);
        { const int cw_ = chk > 0 ? chk - 1 : 0; SC_WRITEOUT2(cw_, (chk + 1) & 1); }
        { const int cl_ = chk + 3 < NCH ? chk + 3 : NCH - 1; SC_LOAD(cl_, 0, xa0); SC_LOAD(cl_, 1, xb0); }
        }
        SC_BAR();
        if (MODE != 2) {
        SC_PROC(0, 0, xa1); SC_PROC(0, 1, xb1);
        SC_WRITEOUT2(chk, 0);
        { const int cl_ = chk + 4 < NCH ? chk + 4 : NCH - 1; SC_LOAD(cl_, 0, xa1); SC_LOAD(cl_, 1, xb1); }
        }
        SC_BAR();
      }
      SC_WRITEOUT(NCH - 1);
    } else {
      SC_BAR();
      __builtin_amdgcn_s_setprio(3);
#pragma unroll 1
      for (int chk = 0; chk < NCH; ++chk) {
        const float* cw = L + (chk & 1) * SC_BUF + wdir * SC_DIR;
        float* sy = L + SC_SY + (chk & 1) * (2 * SC_T * 128) + wdir * (SC_T * 128) + rowl * 16 + l16;
        const float* cl = cw + l16 * 4; const float* cv = cw + 5 * SC_T * 64 + rowl;
        f32x4 w4 = *(const f32x4*)&cl[0], k4 = *(const f32x4*)&cl[SC_T * 64], b4 = *(const f32x4*)&cl[2 * SC_T * 64],
              kd4 = *(const f32x4*)&cl[3 * SC_T * 64], r4 = *(const f32x4*)&cl[4 * SC_T * 64];
        float vv = cv[0], ylast = 0.f;
#pragma unroll 4
        for (int i = 0; i < (MODE == 1 ? 0 : SC_T); ++i) {
          if (i > 0) sy[(i - 1) * 128] = ylast;
          f32x4 w4n = w4, k4n = k4, b4n = b4, kd4n = kd4, r4n = r4; float vvn = vv;
          if (i + 1 < SC_T) {
            const int o = (i + 1) * 64;
            w4n = *(const f32x4*)&cl[o]; k4n = *(const f32x4*)&cl[SC_T * 64 + o]; b4n = *(const f32x4*)&cl[2 * SC_T * 64 + o];
            kd4n = *(const f32x4*)&cl[3 * SC_T * 64 + o]; r4n = *(const f32x4*)&cl[4 * SC_T * 64 + o]; vvn = cv[(i + 1) * 8];
          }
          __builtin_amdgcn_sched_barrier(0);
          const f32x2 ka = {k4[0], k4[1]}, kb = {k4[2], k4[3]}, wa = {w4[0], w4[1]}, wb = {w4[2], w4[3]}, ba = {b4[0], b4[1]}, bb = {b4[2], b4[3]};
          const f32x2 kda = {kd4[0], kd4[1]}, kdb = {kd4[2], kd4[3]}, ra = {r4[0], r4[1]}, rb = {r4[2], r4[3]};
          f32x2 t = Sa * ka; t = Sb * kb + t;
          const float sa = red16(t[0] + t[1]);
          const f32x2 ua = kda * vv - ba * sa, ub = kdb * vv - bb * sa;
          Sa = Sa * wa + ua; Sb = Sb * wb + ub;
          f32x2 yy = Sa * ra; yy = Sb * rb + yy;
          ylast = yy[0] + yy[1];
          w4 = w4n; k4 = k4n; b4 = b4n; kd4 = kd4n; r4 = r4n; vv = vvn;
          __builtin_amdgcn_sched_barrier(0);
        }
        sy[(SC_T - 1) * 128] = ylast;
        SC_BAR();
      }
      __builtin_amdgcn_s_setprio(0);
    }
    __syncthreads();
#undef SC_LOAD
#undef SC_PROC
#undef SC_WRITEOUT
#undef SC_WRITEOUT2
  }
}

DEVI void phase_post(const Params& p, int l) {
  bf16* PJ = (bf16*)(WSV(p) + OFF_U);
  const bf16* Aa = (const bf16*)(WSV(p) + OFF_A);
  const bf16* G = (const bf16*)(WSV(p) + OFF_G);
  const _Float16* YH = (const _Float16*)(WSV(p) + OFF_H);
  const int tid = tid_opaque(), wid = tid >> 6, lane = tid & 63, c0 = lane * 8;
  const bf16* VV = (const bf16*)(WSV(p) + OFF_ZL);
  float ka[8], rk[8], lw[8], lb[8];
#pragma unroll
  for (int j = 0; j < 8; ++j) {
    ka[j] = p.k_a[l * 512 + c0 + j]; rk[j] = p.r_k[l * 512 + c0 + j]; lw[j] = p.lnx_w[l * 512 + c0 + j]; lb[j] = p.lnx_b[l * 512 + c0 + j];
  }
  for (int R = blockIdx.x * 8 + wid; R < NTOK; R += gridDim.x * 8) {
    const int pos = R & (SEQ - 1);
    float y[8];
    { typedef _Float16 h8 __attribute__((ext_vector_type(8)));
      const h8 yf = *(const h8*)&YH[(size_t)R * 512 + c0], yb = *(const h8*)&YH[((size_t)NTOK + R) * 512 + c0];
#pragma unroll
      for (int j = 0; j < 8; ++j) y[j] = ((float)yf[j] + (float)yb[j]) * 16.f; }
    float s1 = 0;
#pragma unroll
    for (int j = 0; j < 8; ++j) s1 += y[j];
    const float mean = red8(s1) * (1.f / 64.f);
    float s2 = 0;
#pragma unroll
    for (int j = 0; j < 8; ++j) { y[j] -= mean; s2 += y[j] * y[j]; }
    const float rstd = rsqrtf(red8(s2) * (1.f / 64.f) + 64e-5f);
    float rr[8], kk[8], vv[8], a0[8], a1[8], g8[8];
    unpack8(*(const u32x4*)&PJ[(size_t)R * LDP + 512 + c0], rr);
    unpack8(*(const u32x4*)&PJ[(size_t)R * LDP + 1024 + c0], kk);
    unpack8(*(const u32x4*)&VV[(size_t)R * 512 + c0], vv);
    unpack8(*(const u32x4*)&Aa[((size_t)R * 2 + 0) * 512 + c0], a0);
    unpack8(*(const u32x4*)&Aa[((size_t)R * 2 + 1) * 512 + c0], a1);
    unpack8(*(const u32x4*)&G[(size_t)R * 512 + c0], g8);
#ifdef NAIVE_G
    { const bf16* ZLp = (const bf16*)(WSV(p) + OFF_ZL) + (size_t)R * 384 + 256; const float* g2 = p.gate_g2 + (size_t)l * 128 * 512 + c0;
      for (int j = 0; j < 8; ++j) g8[j] = 0.f;
      for (int k = 0; k < 128; ++k) { const float sv = bf2f(*(const unsigned short*)&ZLp[k]);
        for (int j = 0; j < 8; ++j) g8[j] += sv * g2[(size_t)k * 512 + j]; } }
#endif
#ifdef NAIVE_G2T
    { const bf16* ZLp = (const bf16*)(WSV(p) + OFF_ZL) + (size_t)R * 384 + 256; const bf16* g2t = (const bf16*)(WSV(p) + OFF_G2T) + (size_t)c0 * 128;
      for (int j = 0; j < 8; ++j) g8[j] = 0.f;
      for (int k = 0; k < 128; ++k) { const float sv = bf2f(*(const unsigned short*)&ZLp[k]);
        for (int j = 0; j < 8; ++j) g8[j] += sv * bf2f(*(const unsigned short*)&g2t[(size_t)j * 128 + k]); } }
#endif
#define FIN(x) (fabsf(x) < 1e30f)
#ifdef IGN_Y
    for (int j = 0; j < 8; ++j) y[j] = 0.01f * j;
#endif
#ifdef IGN_A
    for (int j = 0; j < 8; ++j) { a0[j] = 0.5f; a1[j] = 0.5f; }
#endif
#ifdef IGN_G
    for (int j = 0; j < 8; ++j) { g8[j] = 1.f; }
#endif
#ifdef IGN_RKV
    for (int j = 0; j < 8; ++j) { rr[j] = 0.1f; kk[j] = 0.1f; vv[j] = 0.1f; }
#endif
#ifdef SAN_Y
    for (int j = 0; j < 8; ++j) if (!FIN(y[j])) y[j] = 0.f;
#endif
#ifdef SAN_A
    for (int j = 0; j < 8; ++j) { if (!FIN(a0[j])) a0[j] = 0.f; if (!FIN(a1[j])) a1[j] = 0.f; }
#endif
#ifdef SAN_G
    for (int j = 0; j < 8; ++j) if (!FIN(g8[j])) g8[j] = 0.f;
#endif
#ifdef SAN_RKV
    for (int j = 0; j < 8; ++j) { if (!FIN(rr[j])) rr[j] = 0.f; if (!FIN(kk[j])) kk[j] = 0.f; if (!FIN(vv[j])) vv[j] = 0.f; }
#endif
    float bs = 0;
#pragma unroll
    for (int j = 0; j < 8; ++j) {
      const float kds = kk[j] * ((1.f + (a0[j] - 1.f) * ka[j]) + (1.f + (a1[j] - 1.f) * ka[j]));
      bs += rr[j] * kds * rk[j];
    }
    bs = red8(bs);
    float o[8];
#pragma unroll
    for (int j = 0; j < 8; ++j) o[j] = (y[j] * rstd * lw[j] + lb[j] + bs * vv[j]) * g8[j];
    *(u32x4*)&PJ[(size_t)R * LDP + 512 + c0] = pack8(o);
  }
}

DEVI bool tile_map(int round, int bid, int nb, int nM, int nN, int SM, int SN, int& mt, int& nt) {
  if (nb == 256) {
    const int xcd = bid & 7, j = bid >> 3, nsn = nN / SN, st = round * 8 + xcd;
    if (st >= (nM / SM) * nsn) return false;
    mt = (st / nsn) * SM + j / SN; nt = (st % nsn) * SN + j % SN; return true;
  }
  const int it = round * nb + bid; if (it >= nM * nN) return false;
  mt = it / nN; nt = it % nN; return true;
}

#define WT_IN ((bf16*)(WSV(p) + OFF_WT_IN))
#define WT_OUT ((bf16*)(WSV(p) + OFF_WT_OUT))
#define WT_UP ((bf16*)(WSV(p) + OFF_WT_UP))
#define WT_DOWN ((bf16*)(WSV(p) + OFF_WT_DOWN))
#define W2T ((bf16*)(WSV(p) + OFF_W2T))
#define A2T ((bf16*)(WSV(p) + OFF_A2T))
#define G2T ((bf16*)(WSV(p) + OFF_G2T))
#define PJ ((bf16*)(WSV(p) + OFF_U))
#define U PJ
#define ZL ((bf16*)(WSV(p) + OFF_ZL))
#define H ((bf16*)(WSV(p) + OFF_H))
#define OMW ((_Float16*)(WSV(p) + OFF_OMW))
#define AA ((bf16*)(WSV(p) + OFF_A))
#define GG ((bf16*)(WSV(p) + OFF_G))
#define MODP ((const float*)(WSV(p) + OFF_MOD))
#define cosT ((const float*)(WSV(p) + OFF_COS))
#define sinT ((const float*)(WSV(p) + OFF_SIN))
__global__ void __launch_bounds__(NTHR) fwd_megakernel(Params p) {
  extern __shared__ __attribute__((aligned(16))) char lds[];
  cg::grid_group grid = cg::this_grid();
  const int nb = gridDim.x, bid = blockIdx.x;
  unsigned* gbar = (unsigned*)(p.ws + OFF_BAR); unsigned gtarget = 0;
  grid.sync();
  phase_mod(p, lds);
  phase_rope(p);
  phase_conv(p, 0, lds);
  GSYNC();

  for (int l = 0; l < 2; ++l) {
    const float* xin = (l == 0) ? p.x : p.out;
    const float* modl = launder(MODP + (size_t)l * 4 * 6144);
    if (l > 0) phase_conv(p, l, lds);
    phase_norm(xin, p.norm1 + l * DM, modl, 0, 1024, H);
#ifdef REP_EW
    phase_norm(xin, p.norm1 + l * DM, modl, 0, 1024, H);
#endif
    GSYNC();
#ifdef REP_G1
    for (int rep = 0; rep < 2; ++rep)
#endif
    for (int rnd = 0;; ++rnd) {
      int mt, nt; if (!tile_map(rnd, bid, nb, 128, 14, 16, 2, mt, nt)) break;
      gemm_tile(H, DM, WT_IN, DM, DM, mt * 256, nt * 256, lds,
        [&](EPI_ARGS) {
          if (nw >= LDP) return;
          bf16* dst = PJ + (size_t)m * LDP + nw + 4 * q;
          if (nw < 1024) {
            const int pos = m & (SEQ - 1);
            const float* ct = cosT + pos * 32 + 4 * q; const float* st = sinT + pos * 32 + 4 * q;
#define ROPE(T1, T2, IDX, OFF) do { const f32x4 cs = *(const f32x4*)(ct + (IDX)), sn = *(const f32x4*)(st + (IDX)); \
              *(u32x2*)(dst + (OFF)) = pk4(T1[0] * cs[0] - T2[0] * sn[0], T1[1] * cs[1] - T2[1] * sn[1], T1[2] * cs[2] - T2[2] * sn[2], T1[3] * cs[3] - T2[3] * sn[3]); \
              *(u32x2*)(dst + (OFF) + 32) = pk4(T1[0] * sn[0] + T2[0] * cs[0], T1[1] * sn[1] + T2[1] * cs[1], T1[2] * sn[2] + T2[2] * cs[2], T1[3] * sn[3] + T2[3] * cs[3]); } while (0)
            ROPE(c0, c2, 0, 0); ROPE(c1, c3, 16, 16); ROPE(c4, c6, 0, 64); ROPE(c5, c7, 16, 80);
#undef ROPE
          } else {
#define PLAIN(C, J) *(u32x2*)(dst + 16 * (J)) = pk4(C[0], C[1], C[2], C[3])
            EPI_TILES(PLAIN);
#undef PLAIN
          }
        });
    }
    GSYNC();
    phase_zl(p, l);
#ifdef REP_EW
    phase_zl(p, l);
#endif
    {
      float s1 = 0, s2 = 0;
      for (int i = 0; i < 64; ++i) { s1 += p.lam_q1[l * 64 + i] * p.lam_k1[l * 64 + i]; s2 += p.lam_q2[l * 64 + i] * p.lam_k2[l * 64 + i]; }
      const float lam_init = 0.8f - 0.6f * expf(-0.3f * (float)l);
      const float lam = expf(s1) - expf(s2) + lam_init;
#ifndef SKIP_ATT
#ifdef REP_ATT
      for (int rep = 0; rep < 2; ++rep) {
      const bool dst_ = rep == 1;
#else
      { const bool dst_ = true;
#endif
      if (nb == 256) {
        const int xcd = bid & 7, jj = bid >> 3;
#pragma unroll 1
        for (int i4 = 0; i4 < 4; ++i4) {
          {
            const int bh = xcd + 8 * (i4 >> 1), qb = jj + 32 * (i4 & 1);
            attn_item(PJ, bh >> 2, bh & 3, qb, lam, 1.f - lam_init, p.subln_w + l * 128, lds, dst_);
          }
        }
      } else {
#pragma unroll 1
        for (int it = bid; it < 1024; it += nb) attn_item(PJ, it >> 8, (it >> 6) & 3, it & 63, lam, 1.f - lam_init, p.subln_w + l * 128, lds, dst_);
      }
      }
#endif
    }
    GSYNC();
#ifdef REP_LORA
    for (int rep = 0; rep < 2; ++rep)
#endif
    for (int it = bid; it < 5 * 256; it += nb) {
      const int g = it / 256, t = it % 256, d = g & 1;
      const int mt = (nb == 256) ? ((t & 7) * 16 + (t >> 4)) : (t >> 1), nt = (nb == 256) ? ((t >> 3) & 1) : (t & 1);
      const bf16* Ap; const bf16* Bp; int ldb, KK;
      if (g < 2) { Ap = ZL + d * 64; Bp = W2T + d * 512 * 64; ldb = 64; KK = 64; }
      else if (g < 4) { Ap = ZL + 128 + d * 64; Bp = A2T + d * 512 * 64; ldb = 64; KK = 64; }
      else { Ap = ZL + 256; Bp = G2T; ldb = 128; KK = 128; }
      const float* w0 = p.decay_w0 + (size_t)(l * 2 + d) * 512; const float* a0 = p.icl_a0 + (size_t)(l * 2 + d) * 512;
      gemm_tile(Ap, 384, Bp, ldb, KK, mt * 256, nt * 256, lds,
        [&](EPI_ARGS) {
          auto tile_ = [&](const f32x4v c, const int j) {
            const int col = nw + 16 * j + 4 * q;
            float o[4];
            if (g < 2) {
              const f32x4 w0c = *(const f32x4*)&w0[col];
#pragma unroll
              for (int e = 0; e < 4; ++e) {
                const float ee = 0.60653065971263342f * __builtin_amdgcn_rcpf(1.f + __expf(-(c[e] + w0c[e])));
                o[e] = ee < 0.03125f ? ee * (1.f - ee * (0.5f - ee * (1.f / 6.f - ee * (1.f / 24.f)))) : 1.f - __expf(-ee);
              }
              typedef _Float16 h4 __attribute__((ext_vector_type(4)));
              h4 hv = {(_Float16)o[0], (_Float16)o[1], (_Float16)o[2], (_Float16)o[3]};
              *(h4*)&OMW[((size_t)m * 2 + d) * 512 + col] = hv;
            } else if (g < 4) {
              const f32x4 a0c = *(const f32x4*)&a0[col];
#pragma unroll
              for (int e = 0; e < 4; ++e) o[e] = __builtin_amdgcn_rcpf(1.f + __expf(-(c[e] + a0c[e])));
              *(u32x2*)&AA[((size_t)m * 2 + d) * 512 + col] = pk4(o[0], o[1], o[2], o[3]);
            } else {
              *(u32x2*)&GG[(size_t)m * 512 + col] = pk4(c[0], c[1], c[2], c[3]);
            }
          };
          EPI_TILES(tile_);
        });
    }
    GSYNC();
    phase_mix(p, l);
#ifdef REP_EW
    phase_mix(p, l);
#endif
    GSYNC();
#ifndef SKIP_SCAN
#ifdef REP_SCAN
    phase_scan<REP_SCAN>(p, l, lds);
#endif
    phase_scan<0>(p, l, lds);
#endif
    GSYNC();
#ifndef SKIP_POST
    phase_post(p, l);
#endif
    GSYNC();
    for (int rnd = 0;; ++rnd) {
      int mt, nt; if (!tile_map(rnd, bid, nb, 128, 4, 8, 4, mt, nt)) break;
      gemm_tile(PJ, LDP, WT_OUT, DM, DM, mt * 256, nt * 256, lds,
        [&](EPI_ARGS) {
          const int b = m >> 13; const float* gt = modl + b * 6144 + 2048 + nw + 4 * q;
          const float* xi = xin + (size_t)m * DM + nw + 4 * q; float* xo = p.out + (size_t)m * DM + nw + 4 * q;
          auto tile_ = [&](const f32x4v c, const int j) {
            const f32x4 x4 = *(const f32x4*)(xi + 16 * j), g4 = *(const f32x4*)(gt + 16 * j);
            f32x4 o = {x4[0] + g4[0] * c[0], x4[1] + g4[1] * c[1], x4[2] + g4[2] * c[2], x4[3] + g4[3] * c[3]};
            *(f32x4*)(xo + 16 * j) = o;
          };
          EPI_TILES(tile_);
        });
    }
    GSYNC();
    phase_norm(p.out, p.norm2 + l * DM, modl, 3072, 4096, H);
#ifdef REP_EW
    phase_norm(p.out, p.norm2 + l * DM, modl, 3072, 4096, H);
#endif
    GSYNC();
#ifdef REP_UP
    for (int rep = 0; rep < 2; ++rep)
#endif
    for (int rnd = 0;; ++rnd) {
      int mt, nt; if (!tile_map(rnd, bid, nb, 128, 16, 4, 8, mt, nt)) break;
      gemm_tile(H, DM, WT_UP, DM, DM, mt * 256, nt * 256, lds,
        [&](EPI_ARGS) {
          bf16* dst = U + (size_t)m * DFF + nw + 4 * q;
          auto tile_ = [&](const f32x4v c, const int j) {
            const float u0 = fmaxf(c[0], 0.f), u1 = fmaxf(c[1], 0.f), u2 = fmaxf(c[2], 0.f), u3 = fmaxf(c[3], 0.f);
            *(u32x2*)(dst + 16 * j) = pk4(u0 * u0, u1 * u1, u2 * u2, u3 * u3);
          };
          EPI_TILES(tile_);
        });
    }
    GSYNC();
    for (int rnd = 0;; ++rnd) {
      int mt, nt; if (!tile_map(rnd, bid, nb, 128, 4, 8, 4, mt, nt)) break;
      gemm_tile(U, DFF, WT_DOWN, DFF, DFF, mt * 256, nt * 256, lds,
        [&](EPI_ARGS) {
          const int b = m >> 13; const float* gt = modl + b * 6144 + 5120 + nw + 4 * q;
          float* xo = p.out + (size_t)m * DM + nw + 4 * q;
          auto tile_ = [&](const f32x4v c, const int j) {
            const f32x4 x4 = *(const f32x4*)(xo + 16 * j), g4 = *(const f32x4*)(gt + 16 * j);
            f32x4 o = {x4[0] + g4[0] * c[0], x4[1] + g4[1] * c[1], x4[2] + g4[2] * c[2], x4[3] + g4[3] * c[3]};
            *(f32x4*)(xo + 16 * j) = o;
          };
          EPI_TILES(tile_);
        });
    }
    GSYNC();
  }
#ifdef REP_BAR
  for (int i = 0; i < 20; ++i) GSYNC();
#endif
  phase_final_norm(p.out, p.norm_f);
}

extern "C" void kernel_launch(void* const* d_in, const int* in_sizes, int n_in, void* d_out, int out_size, void* d_ws, size_t ws_size,
                              hipStream_t stream) {
  static int grid_blocks = 0;
  if (n_in != 27 || ws_size < WS_NEED) { fprintf(stderr, "kernel_launch: bad n_in %d or ws_size %zu (< %zu)\n", n_in, ws_size, (size_t)WS_NEED); return; }
  if (!grid_blocks) {
    int dev = 0, cus = 0, per_cu = 0;
    hipGetDevice(&dev);
    hipDeviceGetAttribute(&cus, hipDeviceAttributeMultiprocessorCount, dev);
    hipFuncSetAttribute((const void*)fwd_megakernel, hipFuncAttributeMaxDynamicSharedMemorySize, LDS_BYTES);
    hipOccupancyMaxActiveBlocksPerMultiprocessor(&per_cu, fwd_megakernel, NTHR, LDS_BYTES);
    if (per_cu < 1) per_cu = 1;
    if (per_cu > 1) per_cu = 1;
    grid_blocks = cus * per_cu;
  }
  Params p{};
  const float** pp = (const float**)&p;
  for (int i = 0; i < 27; ++i) pp[i] = (const float*)d_in[i];
  p.out = (float*)d_out; p.ws = (char*)d_ws;
  for (int i = 0; i < 32; ++i) p.inv_freq[i] = 1.0f / powf(10000.0f, (float)(2 * i) / 64.0f);
  hipMemsetAsync((char*)d_ws + OFF_BAR, 0, 256, stream);
  void* args[] = {&p};
  hipError_t e = hipLaunchCooperativeKernel((void*)fwd_megakernel, dim3(grid_blocks), dim3(NTHR), args, LDS_BYTES, stream);
  if (e != hipSuccess) fprintf(stderr, "cooperative launch failed: %s (grid %d)\n", hipGetErrorString(e), grid_blocks);
}
```
